# Optimizing an MI355X kernel written in HIP

```python
import math
import jax
import jax.numpy as jnp
from jax import lax
import numpy as np

D_MODEL = 2048
BATCH = 2
SEQ = 16384
DEPTH = 4

GRID_W = 64
CTX_LEN = 256
N_MIXERS = 3
HEAD_DIM = 128
N_HEADS = D_MODEL // HEAD_DIM
N_KV_HEADS = 4
GQA_GROUP = N_HEADS // N_KV_HEADS
Q_BLOCK = 128
ROPE_THETA = 10000.0
D_FF = -(-8 * D_MODEL // (3 * 256)) * 256
HYENA_EMB = 33
HYENA_ORDER = 64
HYENA_FAST_DECAY = 0.3
HYENA_SLOW_DECAY = 1.5
HYENA_TARGET = 1e-2
N_MOD = 6
NORM_EPS = 1e-6
F32 = jnp.float32

kernel_name = 'hybrid_hyena_shortconv_gqa_dit_trunk'


def rmsnorm(x, g):
    xf = x.astype(F32)
    y = xf * lax.rsqrt(jnp.mean(xf * xf, axis=-1, keepdims=True) + NORM_EPS)
    return (y * g.astype(F32)).astype(x.dtype)


def modulate(h, shift, scale):
    return h * (1 + scale) + shift


def adaln(cond, w_mod, b_mod):
    m = jax.nn.silu(cond) @ w_mod + b_mod
    return jnp.split(m[..., None, :], N_MOD, axis=-1)


def dwconv3(u, w):
    up = jnp.pad(u, ((0, 0), (1, 1), (0, 0)))
    return up[:, :-2] * w[0] + up[:, 1:-1] * w[1] + up[:, 2:] * w[2]


def swiglu(h, w_gate, w_up, w_down):
    return (jax.nn.silu(h @ w_gate) * (h @ w_up)) @ w_down


def hyena_filters(L, w1, b1, w2, b2, w3, b3, w4, freq):
    t = jnp.linspace(0.0, 1.0, L, dtype=F32)[:, None]
    bands = (HYENA_EMB - 1) // 2
    omega = 2.0 * math.pi * jnp.arange(L, dtype=F32)[:, None] / L
    fb = jnp.linspace(1e-4, bands - 1, bands, dtype=F32)[None, :]
    z = jnp.concatenate([t, jnp.cos(fb * omega), -jnp.sin(fb * omega)], axis=-1)
    fr = freq.astype(F32)
    hdn = jnp.sin(fr * (z @ w1.astype(F32) + b1.astype(F32)))
    hdn = jnp.sin(fr * (hdn @ w2.astype(F32) + b2.astype(F32)))
    hdn = jnp.sin(fr * (hdn @ w3.astype(F32) + b3.astype(F32)))
    h = hdn @ w4.astype(F32)
    max_decay = math.log(HYENA_TARGET) / HYENA_FAST_DECAY
    min_decay = math.log(HYENA_TARGET) / HYENA_SLOW_DECAY
    deltas = jnp.linspace(min_decay, max_decay, D_MODEL, dtype=F32)
    decay = jnp.exp(-t * jnp.abs(deltas)[None, :])
    h = h.reshape(L, 2, D_MODEL) * decay[:, None, :]
    return h[:, 0], h[:, 1]


def bidir_longconv(u, k_fwd, k_bwd):
    _, L, C = u.shape
    n = 2 * L
    k = jnp.concatenate([k_fwd, jnp.zeros((1, C), F32), k_bwd[:0:-1]], axis=0)
    U = jnp.fft.rfft(u.astype(F32), n=n, axis=1)
    K = jnp.fft.rfft(k, n=n, axis=0)
    y = jnp.fft.irfft(U * K[None], n=n, axis=1)[:, :L]
    return y.astype(u.dtype)


def hyena_mixer(h, w_in, b_in, short_w, short_b, f_w1, f_b1, f_w2, f_b2, f_w3, f_b3,
                f_w4, f_freq, skip_d, w_out, b_out):
    L = h.shape[1]
    u = dwconv3(h @ w_in + b_in, short_w) + short_b
    x0, x1, v = jnp.split(u, 3, axis=-1)
    k_fwd, k_bwd = hyena_filters(L, f_w1, f_b1, f_w2, f_b2, f_w3, f_b3, f_w4, f_freq)
    v = v * x1
    v = bidir_longconv(v, k_fwd, k_bwd) + v * skip_d
    return (v * x0) @ w_out + b_out


def shortconv_mixer(h, w_in, conv_w, w_out):
    gb, gc, xv = jnp.split(h @ w_in, 3, axis=-1)
    return (gb * dwconv3(gc * xv, conv_w)) @ w_out


def axial_rope_angles(L):
    rows = L // GRID_W
    d_axis = HEAD_DIM // 2
    inv_freq = ROPE_THETA ** (-jnp.arange(0, d_axis, 2, dtype=F32) / d_axis)
    ang_r = jnp.arange(rows, dtype=F32)[:, None] * inv_freq
    ang_c = jnp.arange(GRID_W, dtype=F32)[:, None] * inv_freq
    half = d_axis // 2
    ang = jnp.concatenate([jnp.broadcast_to(ang_r[:, None, :], (rows, GRID_W, half)),
                           jnp.broadcast_to(ang_c[None, :, :], (rows, GRID_W, half))], axis=-1)
    ang = ang.reshape(rows * GRID_W, d_axis)
    return jnp.cos(ang), jnp.sin(ang)


def apply_rope(x, cos, sin):
    xf = x.astype(F32).reshape(*x.shape[:-1], HEAD_DIM // 2, 2)
    x1, x2 = xf[..., 0], xf[..., 1]
    cs, sn = cos[None, :, None, :], sin[None, :, None, :]
    out = jnp.stack([x1 * cs - x2 * sn, x1 * sn + x2 * cs], axis=-1).reshape(x.shape)
    return out.astype(x.dtype)


def project_q(h, w_q, q_g):
    b, L, _ = h.shape
    return rmsnorm((h @ w_q).reshape(b, L, N_HEADS, HEAD_DIM), q_g)


def project_kv(h, w_kv, k_g):
    b, L, _ = h.shape
    k, v = jnp.split((h @ w_kv).reshape(b, L, 2 * N_KV_HEADS, HEAD_DIM), 2, axis=2)
    return rmsnorm(k, k_g), v


def gqa_attend(q, k, v):
    s = jnp.einsum('bqkgd,bskd->bkgqs', q, k).astype(F32) * (HEAD_DIM ** -0.5)
    p = jax.nn.softmax(s, axis=-1).astype(v.dtype)
    return jnp.einsum('bkgqs,bskd->bqkgd', p, v)


def attention_mixer(a, ac, w_qkv, q_g, k_g, w_o, ctx_out):
    b, L, _ = a.shape
    w_q, w_kv = w_qkv[:, :N_HEADS * HEAD_DIM], w_qkv[:, N_HEADS * HEAD_DIM:]
    cos, sin = axial_rope_angles(L)
    q = apply_rope(project_q(a, w_q, q_g), cos, sin)
    k, v = project_kv(a, w_kv, k_g)
    k = apply_rope(k, cos, sin)
    kc, vc = project_kv(ac, w_kv, k_g)
    k_all = jnp.concatenate([k, kc], axis=1)
    v_all = jnp.concatenate([v, vc], axis=1)
    n_blk = L // Q_BLOCK
    qb = q.reshape(b, n_blk, Q_BLOCK, N_KV_HEADS, GQA_GROUP, HEAD_DIM).swapaxes(0, 1)
    o = lax.map(lambda q_blk: gqa_attend(q_blk, k_all, v_all), qb)
    y = o.swapaxes(0, 1).reshape(b, L, N_HEADS * HEAD_DIM) @ w_o
    if not ctx_out:
        return y, None
    lc = ac.shape[1]
    qc = project_q(ac, w_q, q_g).reshape(b, lc, N_KV_HEADS, GQA_GROUP, HEAD_DIM)
    yc = gqa_attend(qc, kc, vc).reshape(b, lc, N_HEADS * HEAD_DIM) @ w_o
    return y, yc


def setup_inputs(seed: int = 0) -> dict:
    key = jax.random.key(seed)
    n_a = len(range(0, DEPTH, N_MIXERS))
    n_b = len(range(1, DEPTH, N_MIXERS))
    n_c = len(range(2, DEPTH, N_MIXERS))
    keys = iter(jax.random.split(key, 40))

    def nrm(shape, scale):
        return jax.random.normal(next(keys), shape, F32) * scale

    d, f = D_MODEL, D_FF
    qkv_cols = (N_HEADS + 2 * N_KV_HEADS) * HEAD_DIM
    return {
        'x': nrm((BATCH, SEQ, d), 1.0),
        'c': nrm((BATCH, d), 1.0),
        'ctx': nrm((BATCH, CTX_LEN, d), 1.0),
        'c_ctx': nrm((d,), 1.0),
        'norm1_g': 1.0 + nrm((DEPTH, d), 0.02),
        'norm2_g': 1.0 + nrm((DEPTH, d), 0.02),
        'w_mod': nrm((DEPTH, d, N_MOD * d), 0.5 * d ** -0.5),
        'b_mod': nrm((DEPTH, N_MOD * d), 0.02),
        'ffn_w_gate': nrm((DEPTH, d, f), d ** -0.5),
        'ffn_w_up': nrm((DEPTH, d, f), d ** -0.5),
        'ffn_w_down': nrm((DEPTH, f, d), f ** -0.5),
        'hy_w_in': nrm((n_a, d, 3 * d), d ** -0.5),
        'hy_b_in': nrm((n_a, 3 * d), 0.02),
        'hy_short_w': nrm((n_a, 3, 3 * d), 3 ** -0.5),
        'hy_short_b': nrm((n_a, 3 * d), 0.02),
        'hy_f_w1': nrm((n_a, HYENA_EMB, HYENA_ORDER), HYENA_EMB ** -0.5),
        'hy_f_b1': nrm((n_a, HYENA_ORDER), 0.1),
        'hy_f_w2': nrm((n_a, HYENA_ORDER, HYENA_ORDER), HYENA_ORDER ** -0.5),
        'hy_f_b2': nrm((n_a, HYENA_ORDER), 0.1),
        'hy_f_w3': nrm((n_a, HYENA_ORDER, HYENA_ORDER), HYENA_ORDER ** -0.5),
        'hy_f_b3': nrm((n_a, HYENA_ORDER), 0.1),
        'hy_f_w4': nrm((n_a, HYENA_ORDER, 2 * d), 0.01),
        'hy_f_freq': 1.0 + nrm((n_a, HYENA_ORDER), 0.02),
        'hy_skip': nrm((n_a, d), 1.0),
        'hy_w_out': nrm((n_a, d, d), d ** -0.5),
        'hy_b_out': nrm((n_a, d), 0.02),
        'sc_w_in': nrm((n_b, d, 3 * d), d ** -0.5),
        'sc_conv_w': nrm((n_b, 3, d), 3 ** -0.5),
        'sc_w_out': nrm((n_b, d, d), d ** -0.5),
        'at_w_qkv': nrm((n_c, d, qkv_cols), d ** -0.5),
        'at_q_g': 1.0 + nrm((n_c, HEAD_DIM), 0.02),
        'at_k_g': 1.0 + nrm((n_c, HEAD_DIM), 0.02),
        'at_w_o': nrm((n_c, d, d), d ** -0.5),
        'final_g': 1.0 + nrm((d,), 0.02),
    }


def reference(x, c, ctx, c_ctx, norm1_g, norm2_g, w_mod, b_mod, ffn_w_gate, ffn_w_up,
              ffn_w_down, hy_w_in, hy_b_in, hy_short_w, hy_short_b, hy_f_w1, hy_f_b1,
              hy_f_w2, hy_f_b2, hy_f_w3, hy_f_b3, hy_f_w4, hy_f_freq, hy_skip, hy_w_out,
              hy_b_out, sc_w_in, sc_conv_w, sc_w_out, at_w_qkv, at_q_g, at_k_g, at_w_o,
              final_g):
    attn_layers = [i for i in range(DEPTH) if i % N_MIXERS == 2]
    last_ctx_reader = attn_layers[-1] if attn_layers else -1
    xc = ctx
    for i in range(DEPTH):
        kind, j = i % N_MIXERS, i // N_MIXERS
        ctx_in = i <= last_ctx_reader
        ctx_out = i < last_ctx_reader
        sh1, sc1, g1, sh2, sc2, g2 = adaln(c, w_mod[i], b_mod[i])
        a = modulate(rmsnorm(x, norm1_g[i]), sh1, sc1)
        if ctx_in:
            csh1, csc1, cg1, csh2, csc2, cg2 = adaln(c_ctx, w_mod[i], b_mod[i])
            ac = modulate(rmsnorm(xc, norm1_g[i]), csh1, csc1)
        yc = None
        if kind == 0:
            hyp = (hy_w_in[j], hy_b_in[j], hy_short_w[j], hy_short_b[j], hy_f_w1[j], hy_f_b1[j],
                   hy_f_w2[j], hy_f_b2[j], hy_f_w3[j], hy_f_b3[j], hy_f_w4[j], hy_f_freq[j],
                   hy_skip[j], hy_w_out[j], hy_b_out[j])
            y = hyena_mixer(a, *hyp)
            if ctx_out:
                yc = hyena_mixer(ac, *hyp)
        elif kind == 1:
            scp = (sc_w_in[j], sc_conv_w[j], sc_w_out[j])
            y = shortconv_mixer(a, *scp)
            if ctx_out:
                yc = shortconv_mixer(ac, *scp)
        else:
            y, yc = attention_mixer(a, ac, at_w_qkv[j], at_q_g[j], at_k_g[j], at_w_o[j], ctx_out)
        ffn = (ffn_w_gate[i], ffn_w_up[i], ffn_w_down[i])
        x = x + g1 * y
        x = x + g2 * swiglu(modulate(rmsnorm(x, norm2_g[i]), sh2, sc2), *ffn)
        if ctx_out:
            xc = xc + cg1 * yc
            xc = xc + cg2 * swiglu(modulate(rmsnorm(xc, norm2_g[i]), csh2, csc2), *ffn)
    return rmsnorm(x, final_g)
```

```cpp
#include <hip/hip_runtime.h>
#include <cstdio>
#include <cstdint>
#include <cstddef>

#ifndef MK_PER_PHASE_LAUNCH
#define MK_PER_PHASE_LAUNCH 0
#endif

#define LAS __attribute__((address_space(3)))
#define GAS __attribute__((address_space(1)))
typedef unsigned short bf16_t;
typedef short bf16x8 __attribute__((ext_vector_type(8)));
typedef float f32x4 __attribute__((ext_vector_type(4)));
typedef float f32x2 __attribute__((ext_vector_type(2)));
typedef unsigned u32x4 __attribute__((ext_vector_type(4)));
typedef unsigned u32x2 __attribute__((ext_vector_type(2)));

constexpr int D = 2048, NB = 2, SEQ = 16384, CTXL = 256, DFF = 5632, HD = 128, NH = 16, NKV = 4;
constexpr int M_LAT = NB * SEQ, M_CTX = NB * CTXL, M_ALL = M_LAT + M_CTX;
constexpr int NMOD = 6 * D;
constexpr int LK = SEQ + CTXL;
constexpr float NORM_EPS = 1e-6f;
constexpr int NWAVES = 8, NTHREADS = 512;
constexpr int N_PHASES = 1 + 9 + 7 + 8 + 9 + 1;

constexpr size_t MiB = 1u << 20;
constexpr size_t WS_CTL = 0, CTL_ZERO_BYTES = 1 * MiB;
constexpr size_t WS_MOD = 1 * MiB;
constexpr size_t WS_HDN = 2 * MiB;
constexpr size_t WS_KFC = 11 * MiB;
constexpr size_t WS_VTC = 15 * MiB;
constexpr size_t WS_XRES = 17 * MiB;
constexpr size_t WS_A = 277 * MiB;
constexpr size_t WS_Z = 407 * MiB;
constexpr size_t WS_W = 797 * MiB;
constexpr size_t WS_WGU = WS_W, WS_WD = WS_W + 44 * MiB, WS_WIN = WS_W + 66 * MiB, WS_WOUT = WS_W + 90 * MiB;
constexpr size_t WS_VT = 895 * MiB;
constexpr size_t WS_KF = 1023 * MiB;
constexpr size_t WS_KALL = WS_KF, WS_VALL = WS_KF + 40 * MiB;
constexpr size_t WS_KSP = 1279 * MiB;
constexpr size_t WS_END = 1319 * MiB;
constexpr int CW_BAR = 1024;

__device__ __forceinline__ float bf2f(unsigned short b) { return __uint_as_float(((unsigned)b) << 16); }
__device__ __forceinline__ float bflo(unsigned w) { return __uint_as_float(w << 16); }
__device__ __forceinline__ float bfhi(unsigned w) { return __uint_as_float(w & 0xffff0000u); }
__device__ __forceinline__ unsigned cvt_pk_bf16(float lo, float hi) { unsigned r; asm volatile("v_cvt_pk_bf16_f32 %0, %1, %2" : "=v"(r) : "v"(lo), "v"(hi)); return r; }
__device__ __forceinline__ float wave_sum(float v) {
    v += __int_as_float(__builtin_amdgcn_update_dpp(0, __float_as_int(v), 0xB1, 0xf, 0xf, true));
    v += __int_as_float(__builtin_amdgcn_update_dpp(0, __float_as_int(v), 0x4E, 0xf, 0xf, true));
    v += __int_as_float(__builtin_amdgcn_update_dpp(0, __float_as_int(v), 0x124, 0xf, 0xf, true));
    v += __int_as_float(__builtin_amdgcn_update_dpp(0, __float_as_int(v), 0x128, 0xf, 0xf, true));
    const int i = __float_as_int(v);
    return (__int_as_float(__builtin_amdgcn_readlane(i, 0)) + __int_as_float(__builtin_amdgcn_readlane(i, 16))) + (__int_as_float(__builtin_amdgcn_readlane(i, 32)) + __int_as_float(__builtin_amdgcn_readlane(i, 48)));
}
__device__ __forceinline__ float lane_bcast(float v, int k) { return __int_as_float(__builtin_amdgcn_readlane(__float_as_int(v), k)); }
#define LDS_WAIT() asm volatile("s_waitcnt lgkmcnt(0)" ::: "memory")
#define VM_WAIT() asm volatile("s_waitcnt vmcnt(0)" ::: "memory")
#define XB_TMO      128
#define XB_XCNT(j)  (256  + 64 * (j))
#define XB_XSUB(j)  (1280 + 64 * (j))
#define XB_XGEN(j)  (2304 + 64 * (j))
#define XB_TOP      3328
#define XB_TOPGEN   3392
#define XCD_BAR_WORDS 3456
#define XB_SPIN_CAP (1u << 18)

__device__ __forceinline__ unsigned xb_ld(unsigned* p)              { return __hip_atomic_load(p, __ATOMIC_RELAXED, __HIP_MEMORY_SCOPE_AGENT); }
__device__ __forceinline__ unsigned xb_add(unsigned* p, unsigned v) { return __hip_atomic_fetch_add(p, v, __ATOMIC_RELAXED, __HIP_MEMORY_SCOPE_AGENT); }
__device__ __forceinline__ unsigned xb_xcc_id() { return (unsigned)__builtin_amdgcn_s_getreg((3 << 11) | 20) & 0xFu; }
#define XB_SPIN(cond, bar) do { unsigned _sp = 0; while (cond) { __builtin_amdgcn_s_sleep(1); \
    if ((++_sp & 255u) == 0u) { if (xb_ld(&(bar)[XB_TMO])) break; if (_sp > XB_SPIN_CAP) { atomicAdd(&(bar)[XB_TMO], 1u); break; } } } } while (0)

struct XcdBarrier {
    unsigned* bar; unsigned x;
    volatile LAS unsigned* st;
};

__device__ __forceinline__ XcdBarrier xcd_barrier_post(unsigned* bar, volatile LAS unsigned* st) {
    XcdBarrier b; b.bar = bar; b.x = xb_xcc_id(); b.st = st;
    if (threadIdx.x == 0) (void)xb_add(&bar[XB_XCNT(b.x)], 1u);
    return b;
}
__device__ __forceinline__ void xcd_barrier_complete(unsigned* bar, unsigned x, unsigned& nloc, unsigned& nx) {
    const unsigned G = gridDim.x * gridDim.y * gridDim.z;
    unsigned sum, cnt, mine, sp = 0u;
    for (;;) {
        sum = 0u; cnt = 0u; mine = 0u;
#pragma unroll
        for (unsigned j = 0; j < 16; ++j) { const unsigned c = xb_ld(&bar[XB_XCNT(j)]); sum += c; cnt += (c > 0u) ? 1u : 0u; mine = (j == x) ? c : mine; }
        if (sum == G) break;
        __builtin_amdgcn_s_sleep(1);
        if ((++sp & 255u) == 0u) { if (xb_ld(&bar[XB_TMO])) break; if (sp > XB_SPIN_CAP) { atomicAdd(&bar[XB_TMO], 1u); break; } }
    }
    nloc = mine > 0u ? mine : 1u; nx = cnt > 0u ? cnt : 1u;
}

__device__ __forceinline__ void xcd_barrier(const XcdBarrier& b) {
    asm volatile("s_waitcnt vmcnt(0)" ::: "memory");
    __syncthreads();
    if (threadIdx.x == 0) {
        unsigned* bar = b.bar;
        __builtin_amdgcn_s_waitcnt(0);
        unsigned nloc = b.st[0], nx = b.st[1];
        if (nloc == 0u) { xcd_barrier_complete(bar, b.x, nloc, nx); b.st[0] = nloc; b.st[1] = nx; }
        const unsigned old = xb_add(&bar[XB_XSUB(b.x)], 1u);
        const unsigned gen = old / nloc;
        if (old + 1u == (gen + 1u) * nloc) {
            __builtin_amdgcn_fence(__ATOMIC_RELEASE, "agent");
            asm volatile("s_waitcnt vmcnt(0)" ::: "memory");
            const unsigned og = xb_add(&bar[XB_TOP], 1u);
            const unsigned tg = og / nx;
            if (og + 1u == (tg + 1u) * nx) xb_add(&bar[XB_TOPGEN], 1u);
            else XB_SPIN(xb_ld(&bar[XB_TOPGEN]) == tg, bar);
            __builtin_amdgcn_fence(__ATOMIC_ACQUIRE, "agent");
            xb_add(&bar[XB_XGEN(b.x)], 1u);
            asm volatile("s_waitcnt vmcnt(0)" ::: "memory");
        } else {
            XB_SPIN(xb_ld(&bar[XB_XGEN(b.x)]) == gen, bar);
            __builtin_amdgcn_fence(__ATOMIC_ACQUIRE, "agent");
            asm volatile("s_waitcnt vmcnt(0)" ::: "memory");
        }
    }
    __syncthreads();
}
namespace pg8 {
#define PG8_LAS __attribute__((address_space(3)))
typedef unsigned short bf16_t;
typedef short bf16x8 __attribute__((ext_vector_type(8)));
typedef float f32x4 __attribute__((ext_vector_type(4)));
typedef unsigned u32x4 __attribute__((ext_vector_type(4)));
constexpr int BM = 256, BK = 64, HALF = 128, HTB = HALF * BK * 2  , STAGE_BYTES = 8 * HTB, NXCD = 8, WGM = 8;

__host__ __device__ __forceinline__ int lds_byte(int r, int c) { const int st = (r >> 4) * 2 + (c >> 5), rr = r & 15, cc = c & 31, ob = rr * 64 + cc * 2; return st * 1024 + (ob ^ (((ob >> 9) & 1) << 5)); }
__host__ __device__ __forceinline__ void stage_rc(int b, int& R, int& C) { const int st = b / 1024, sb = b % 1024, swz = sb ^ (((sb >> 9) & 1) << 5); R = (st >> 1) * 16 + swz / 64; C = (st & 1) * 32 + (swz % 64) / 2; }
__host__ __device__ __forceinline__ int perm32(int rho) { const int n = rho >> 4, i = rho & 15; return 8 * (i >> 2) + 4 * n + (i & 3); }

struct Unit { int pm, pn; };
struct Gemm { const bf16_t* A; const bf16_t* Bt; int M, N, K; };

struct StaticOrder {
    int nM, nN, nwg, G, c;
    __host__ __device__ void init(int M, int N, int G_, int c_) { nM = M / BM; nN = N / BM; nwg = nM * nN; G = G_; c = c_; }
    __host__ __device__ bool next(int i, Unit& u) const {
        const long L = (long)i * G + c; if (L >= nwg) return false;
        int wgid = (int)L; { const int q = nwg / NXCD, r = nwg % NXCD, xcd = wgid % NXCD, off = wgid / NXCD; wgid = (xcd < r ? xcd * (q + 1) : r * (q + 1) + (xcd - r) * q) + off; }
        const int nig = WGM * nN, gid = wgid / nig, fm = gid * WGM, gsz = (nM - fm) < WGM ? (nM - fm) : WGM;
        u.pm = fm + ((wgid % nig) % gsz); u.pn = (wgid % nig) / gsz; return true;
    }
    __device__ __forceinline__ void a_ready(const Unit&) const {}
    __device__ __forceinline__ void done(const Unit&) const {}
};
struct EpiStoreBf16 {
    static constexpr bool PERM = true, AFTER_DRAIN = false;
    bf16_t* O; int ldc; const float* bias;
    __device__ __forceinline__ void operator()(const f32x4 (&acc)[2][2][4][2], const Unit& u, int wr, int wc, int fr, int fq) const {
        const int row0 = u.pm * BM + wr * 64 + fr, col0 = u.pn * BM + wc * 32 + 8 * fq;
        f32x4 bv[2][2];
#pragma unroll
        for (int bj = 0; bj < 2; ++bj)
#pragma unroll
            for (int n = 0; n < 2; ++n) bv[bj][n] = bias ? *(const f32x4*)(bias + col0 + bj * HALF + 4 * n) : (f32x4){0.f, 0.f, 0.f, 0.f};
#pragma unroll
        for (int ai = 0; ai < 2; ++ai)
#pragma unroll
            for (int m = 0; m < 4; ++m) { bf16_t* rowp = O + (size_t)(row0 + ai * HALF + m * 16) * ldc + col0;
#pragma unroll
                for (int bj = 0; bj < 2; ++bj) { const f32x4 v0 = acc[ai][bj][m][0] + bv[bj][0], v1 = acc[ai][bj][m][1] + bv[bj][1];
                    u32x4 w; w.x = cvt_pk_bf16(v0[0], v0[1]); w.y = cvt_pk_bf16(v0[2], v0[3]); w.z = cvt_pk_bf16(v1[0], v1[1]); w.w = cvt_pk_bf16(v1[2], v1[3]);
                    *(u32x4*)(rowp + bj * HALF) = w; } }
    }
};
__device__ __forceinline__ float silu_mul(float g, float u) { return g * u * __builtin_amdgcn_rcpf(1.0f + __builtin_amdgcn_exp2f(-1.4426950408889634f * g)); }
struct EpiSwiGLU {
    static constexpr bool PERM = true, AFTER_DRAIN = false;
    bf16_t* O; int ldc;
    __device__ __forceinline__ void operator()(const f32x4 (&acc)[2][2][4][2], const Unit& u, int wr, int wc, int fr, int fq) const {
        const int row0 = u.pm * BM + wr * 64 + fr, col0 = u.pn * HALF + wc * 32 + 8 * fq;
#pragma unroll
        for (int ai = 0; ai < 2; ++ai)
#pragma unroll
            for (int m = 0; m < 4; ++m) {
                const f32x4 g0 = acc[ai][0][m][0], g1 = acc[ai][0][m][1], u0 = acc[ai][1][m][0], u1 = acc[ai][1][m][1];
                u32x4 w;
                w.x = cvt_pk_bf16(silu_mul(g0[0], u0[0]), silu_mul(g0[1], u0[1])); w.y = cvt_pk_bf16(silu_mul(g0[2], u0[2]), silu_mul(g0[3], u0[3]));
                w.z = cvt_pk_bf16(silu_mul(g1[0], u1[0]), silu_mul(g1[1], u1[1])); w.w = cvt_pk_bf16(silu_mul(g1[2], u1[2]), silu_mul(g1[3], u1[3]));
                *(u32x4*)(O + (size_t)(row0 + ai * HALF + m * 16) * ldc + col0) = w; }
    }
};
struct EpiResid {
    static constexpr bool PERM = false, AFTER_DRAIN = false;
    const float* base_lat; const float* base_ctx; float* out; const float* bias; const float* gate;
    __device__ __forceinline__ void operator()(const f32x4 (&acc)[2][2][4][2], const Unit& u, int wr, int wc, int fr, int fq) const {
        const int rin0 = wr * 64 + fr, col0 = u.pn * BM + wc * 32 + 4 * fq;
        const int cond = u.pm < 64 ? 0 : (u.pm < 128 ? 1 : 2);
        const float* bp = (u.pm < 128 ? base_lat + (size_t)u.pm * BM * 2048 : base_ctx + (size_t)(u.pm - 128) * BM * 2048) + col0;
        float* op = out + (size_t)u.pm * BM * 2048 + col0;
        const float* gp = gate + cond * 12288 + col0;
        f32x4 gv[2][2], bv[2][2];
#pragma unroll
        for (int bj = 0; bj < 2; ++bj)
#pragma unroll
            for (int n = 0; n < 2; ++n) { gv[bj][n] = *(const f32x4*)(gp + bj * HALF + n * 16); bv[bj][n] = bias ? *(const f32x4*)(bias + col0 + bj * HALF + n * 16) : (f32x4){0.f, 0.f, 0.f, 0.f}; }
#pragma unroll
        for (int ai = 0; ai < 2; ++ai)
#pragma unroll
            for (int m = 0; m < 4; ++m) { const size_t ro = (size_t)(rin0 + ai * HALF + m * 16) * 2048;
#pragma unroll
                for (int bj = 0; bj < 2; ++bj)
#pragma unroll
                    for (int n = 0; n < 2; ++n) { const f32x4 b = *(const f32x4*)(bp + ro + bj * HALF + n * 16);
                        *(f32x4*)(op + ro + bj * HALF + n * 16) = b + gv[bj][n] * (acc[ai][bj][m][n] + bv[bj][n]); }
                asm volatile("" ::: "memory"); }
    }
};
template <class Epi, class Sched, bool STAMP = false>
__device__ __forceinline__ void gemm_phase(PG8_LAS unsigned char* lds, const Gemm g, const Sched& S, const Epi& E, unsigned long long* stamps) {
    int tid_ = threadIdx.x; asm volatile("" : "+v"(tid_));
    const int tid = tid_, wid = __builtin_amdgcn_readfirstlane(tid >> 6), lane = tid & 63, wr = wid >> 2, wc = wid & 3, fr = lane & 15, fq = lane >> 4;
    const int K = g.K, nt = K / BK;
    int ts_lo = 0, ts_hi = 0, nts = 0; const unsigned long long rt_entry = STAMP ? (unsigned long long)wall_clock64() : 0ull;
#define PG8_STAMP() do { if (STAMP && wid == 0 && nts < 64) { const unsigned long long _c = (unsigned long long)clock64(); \
        ts_lo = (lane == nts) ? (int)(unsigned)_c : ts_lo; ts_hi = (lane == nts) ? (int)(unsigned)(_c >> 32) : ts_hi; ++nts; } } while (0)
    PG8_STAMP();
    unsigned voffA[2], voffB[2];
#pragma unroll
    for (int i = 0; i < 2; ++i) { int R, C; stage_rc(tid * 16 + i * 8192, R, C); const int Rb = Epi::PERM ? ((R & ~31) + perm32(R & 31)) : R;
        voffA[i] = (unsigned)(R * K + C) * 2u; voffB[i] = (unsigned)(Rb * K + C) * 2u; }
    const size_t kstep = (size_t)(BK * 2);
    const size_t hstep = (size_t)HALF * K * 2;
    const size_t tstep = 2 * hstep;
    const unsigned ldsw = (unsigned)wid * 1024u;
    const int aoff = lds_byte(wr * 64 + fr, fq * 8), boff = lds_byte(wc * 32 + fr, fq * 8);
#define PG8_SA(b, h) (((b) * 2 + (h)) * HTB)
#define PG8_SB(b, h) ((4 + (b) * 2 + (h)) * HTB)
#define PG8_STAGE(bufoff, gbase, voff) do { _Pragma("unroll") for (int _i = 0; _i < 2; ++_i) \
        __builtin_amdgcn_global_load_lds((const unsigned*)((const char*)(gbase) + (voff)[_i]), (PG8_LAS unsigned*)(lds + (bufoff) + ldsw + _i * 8192), 16, 0, 0); } while (0)
#define PG8_LDA(dst, b, h) do { _Pragma("unroll") for (int m = 0; m < 4; ++m) _Pragma("unroll") for (int k = 0; k < 2; ++k) dst[m][k] = *(const PG8_LAS bf16x8*)(lds + PG8_SA(b, h) + aoff + m * 2048 + k * 1024); } while (0)
#define PG8_LDB(dst, b, h) do { _Pragma("unroll") for (int n = 0; n < 2; ++n) _Pragma("unroll") for (int k = 0; k < 2; ++k) dst[n][k] = *(const PG8_LAS bf16x8*)(lds + PG8_SB(b, h) + boff + n * 2048 + k * 1024); } while (0)
#define PG8_MMA(ai, bj, At, Bt) do { __builtin_amdgcn_s_setprio(1); _Pragma("unroll") for (int m = 0; m < 4; ++m) _Pragma("unroll") for (int n = 0; n < 2; ++n) _Pragma("unroll") for (int k = 0; k < 2; ++k) \
        acc[ai][bj][m][n] = __builtin_amdgcn_mfma_f32_16x16x32_bf16(Bt[n][k], At[m][k], acc[ai][bj][m][n], 0, 0, 0); __builtin_amdgcn_s_setprio(0); } while (0)
#define PG8_WAIT_V(n) asm volatile("s_waitcnt vmcnt(" #n ")" ::: "memory")
#define PG8_WAIT_L(n) asm volatile("s_waitcnt lgkmcnt(" #n ")" ::: "memory")
#define PG8_BAR __builtin_amdgcn_s_barrier()
#define PG8_SCHED __builtin_amdgcn_sched_barrier(0)
    Unit cur, nxt; int ui = 0;
    if (!S.next(0, cur)) return;
    f32x4 acc[2][2][4][2];
#pragma unroll
    for (int a = 0; a < 2; ++a)
#pragma unroll
        for (int b = 0; b < 2; ++b)
#pragma unroll
            for (int m = 0; m < 4; ++m)
#pragma unroll
                for (int n = 0; n < 2; ++n) acc[a][b][m][n] = (f32x4){0.f, 0.f, 0.f, 0.f};
    bf16x8 At[4][2], B0[2][2], B1[2][2];
    const char* cA = (const char*)g.A + (size_t)cur.pm * tstep; const char* cB = (const char*)g.Bt + (size_t)cur.pn * tstep;
    S.a_ready(cur);
    PG8_STAGE(PG8_SB(0, 0), cB, voffB); PG8_STAGE(PG8_SA(0, 0), cA, voffA); PG8_STAGE(PG8_SB(0, 1), cB + hstep, voffB); PG8_STAGE(PG8_SA(0, 1), cA + hstep, voffA);
    if (wr == 1) PG8_BAR;
    PG8_WAIT_V(4); PG8_BAR;
    PG8_STAGE(PG8_SB(1, 0), cB + kstep, voffB); PG8_STAGE(PG8_SA(1, 0), cA + kstep, voffA); PG8_STAGE(PG8_SB(1, 1), cB + hstep + kstep, voffB);
    PG8_WAIT_V(6); PG8_BAR;
    PG8_STAMP();
    for (;;) {
        const bool has_next = S.next(ui + 1, nxt);
        const char* nA = has_next ? (const char*)g.A + (size_t)nxt.pm * tstep : cA; const char* nB = has_next ? (const char*)g.Bt + (size_t)nxt.pn * tstep : cB;
        for (int t = 0; t < nt; t += 2) {
            const bool last = (t == nt - 2);
            const char* a1 = cA + (size_t)(t + 1) * kstep;
            const char* a2 = last ? nA : cA + (size_t)(t + 2) * kstep; const char* b2 = last ? nB : cB + (size_t)(t + 2) * kstep;
            const char* a3 = a2 + kstep; const char* b3 = b2 + kstep;
            if (last && has_next) S.a_ready(nxt);
            PG8_LDB(B0, 0, 0); PG8_SCHED; PG8_LDA(At, 0, 0); PG8_STAGE(PG8_SA(1, 1), a1 + hstep, voffA);
            PG8_WAIT_L(8); PG8_BAR; PG8_WAIT_L(0); PG8_MMA(0, 0, At, B0); PG8_BAR; PG8_SCHED;
            PG8_LDB(B1, 0, 1); PG8_STAGE(PG8_SB(0, 0), b2, voffB);
            PG8_BAR; PG8_WAIT_L(0); PG8_MMA(0, 1, At, B1); PG8_BAR;
            PG8_LDA(At, 0, 1); PG8_STAGE(PG8_SA(0, 0), a2, voffA);
            PG8_BAR; PG8_WAIT_L(0); PG8_MMA(1, 0, At, B0); PG8_BAR; PG8_SCHED;
            PG8_STAGE(PG8_SB(0, 1), b2 + hstep, voffB);
            PG8_WAIT_V(6); PG8_BAR; PG8_MMA(1, 1, At, B1); PG8_BAR;
            PG8_LDB(B0, 1, 0); PG8_SCHED; PG8_LDA(At, 1, 0); PG8_STAGE(PG8_SA(0, 1), a2 + hstep, voffA);
            PG8_WAIT_L(8); PG8_BAR; PG8_WAIT_L(0); PG8_MMA(0, 0, At, B0); PG8_BAR; PG8_SCHED;
            PG8_LDB(B1, 1, 1); PG8_STAGE(PG8_SB(1, 0), b3, voffB);
            PG8_BAR; PG8_WAIT_L(0); PG8_MMA(0, 1, At, B1); PG8_BAR;
            PG8_LDA(At, 1, 1); PG8_STAGE(PG8_SA(1, 0), a3, voffA);
            PG8_BAR; PG8_WAIT_L(0); PG8_MMA(1, 0, At, B0); PG8_BAR; PG8_SCHED;
            PG8_STAGE(PG8_SB(1, 1), b3 + hstep, voffB);
            PG8_WAIT_V(6); PG8_BAR; PG8_MMA(1, 1, At, B1); PG8_BAR;
        }
        PG8_STAMP();
        if constexpr (!Epi::AFTER_DRAIN) { E(acc, cur, wr, wc, fr, fq); S.done(cur); }
        PG8_STAMP();
        if (!has_next) break;
#pragma unroll
        for (int a = 0; a < 2; ++a)
#pragma unroll
            for (int b = 0; b < 2; ++b)
#pragma unroll
                for (int m = 0; m < 4; ++m)
#pragma unroll
                    for (int n = 0; n < 2; ++n) acc[a][b][m][n] = (f32x4){0.f, 0.f, 0.f, 0.f};
        cur = nxt; cA = nA; cB = nB; ++ui;
    }
    PG8_WAIT_V(0);
    if (wr == 0) PG8_BAR;
    PG8_BAR;
    if constexpr (Epi::AFTER_DRAIN) { E.fused(acc, cur, wr, wc, fr, fq, lds, wid, lane); S.done(cur); }
    PG8_STAMP();
    if (STAMP && wid == 0) { stamps[lane] = lane < nts ? (((unsigned long long)(unsigned)ts_hi << 32) | (unsigned)ts_lo) : 0ull;
        if (lane == 62) stamps[62] = rt_entry; if (lane == 63) stamps[63] = (unsigned long long)wall_clock64(); }
#undef PG8_STAMP
#undef PG8_SA
#undef PG8_SB
#undef PG8_STAGE
#undef PG8_LDA
#undef PG8_LDB
#undef PG8_MMA
#undef PG8_WAIT_V
#undef PG8_WAIT_L
#undef PG8_BAR
#undef PG8_SCHED
}
}
namespace att {
using bf16 = unsigned short;
constexpr int D = 128, NW = 8, QBLK = 32, KVBLK = 64;
constexpr float SCALE = 0.088388347648318440f;
constexpr float THR = 8.f;
constexpr int SDEPTH = 2;
constexpr int LDQ = 2048, LDK = 512, LDO = 2048;
constexpr size_t SHM_V = KVBLK * D * 2, SHM_K = KVBLK * D * 2, SHM_ATTN = 2 * SHM_V + 2 * SHM_K + NW * 64 * 4;
using bf16x8 = __attribute__((ext_vector_type(8))) short;
using s16x4  = __attribute__((ext_vector_type(4))) short;
using f32x16 = __attribute__((ext_vector_type(16))) float;
using f32x8  = __attribute__((ext_vector_type(8))) float;
using u32x4  = __attribute__((ext_vector_type(4))) unsigned;
#define KSWZ(row, colB) ((row) * 256 + ((colB) ^ (((row) & 7) << 4)))
#define SBAR() __builtin_amdgcn_sched_barrier(0)
__device__ __forceinline__ int crow(int r, int hi) { return (r & 3) + 8 * (r >> 2) + 4 * hi; }
__device__ __forceinline__ unsigned cvtpk(float lo, float hi) {
  unsigned r; asm volatile("v_cvt_pk_bf16_f32 %0, %1, %2" : "=v"(r) : "v"(lo), "v"(hi)); return r;
}
template <typename TIn> struct Stage;
template <> struct Stage<bf16>  { using T = bf16x8;
  __device__ static __forceinline__ T ld8(const bf16* p) { return *reinterpret_cast<const bf16x8*>(p); }
  __device__ static __forceinline__ bf16x8 tobf(T x) { return x; } };
template <> struct Stage<float> { using T = f32x8;
  __device__ static __forceinline__ T ld8(const float* p) { return *reinterpret_cast<const f32x8*>(p); }
  __device__ static __forceinline__ bf16x8 tobf(T x) {
    u32x4 w = {cvtpk(x[0], x[1]), cvtpk(x[2], x[3]), cvtpk(x[4], x[5]), cvtpk(x[6], x[7])}; return *reinterpret_cast<bf16x8*>(&w); } };

__device__ __forceinline__ void partialSM(f32x16& p0, f32x16& p1, float& m_reg, float& mn, float& alpha) {
  constexpr float C = SCALE * 1.4426950408889634f;
  float pmax = p0[0]; for (int r = 1; r < 16; ++r) pmax = fmaxf(pmax, p0[r]); for (int r = 0; r < 16; ++r) pmax = fmaxf(pmax, p1[r]);
  { auto rr = __builtin_amdgcn_permlane32_swap(__float_as_uint(pmax), __float_as_uint(pmax), false, false);
    pmax = fmaxf(__uint_as_float(rr[0]), __uint_as_float(rr[1])); }
  if (__builtin_expect(__all(pmax - m_reg <= THR / SCALE), 1)) { mn = m_reg; alpha = 1.f; }
  else { mn = fmaxf(m_reg, pmax); alpha = __builtin_amdgcn_exp2f((m_reg - mn) * C); m_reg = mn; }
  float mnC = -mn * C;
  for (int r = 0; r < 16; ++r) p0[r] = fmaf(p0[r], C, mnC); for (int r = 0; r < 16; ++r) p1[r] = fmaf(p1[r], C, mnC);
  for (int r = 0; r < 16; ++r) p0[r] = __builtin_amdgcn_exp2f(p0[r]);
}
__device__ __forceinline__ void finishSM(f32x16& p0, f32x16& p1, float alpha, float& l_reg, bf16x8& pa0, bf16x8& pa1, bf16x8& pa2, bf16x8& pa3) {
  for (int r = 0; r < 16; ++r) p1[r] = __builtin_amdgcn_exp2f(p1[r]);
  float ps = 0; for (int r = 0; r < 16; ++r) ps += p0[r]; for (int r = 0; r < 16; ++r) ps += p1[r];
  { auto rr = __builtin_amdgcn_permlane32_swap(__float_as_uint(ps), __float_as_uint(ps), false, false);
    ps = __uint_as_float(rr[0]) + __uint_as_float(rr[1]); }
  l_reg = l_reg * alpha + ps;
#define PK4(P, BASE, OUT) do { unsigned a0 = cvtpk(P[BASE + 0], P[BASE + 1]), a1 = cvtpk(P[BASE + 2], P[BASE + 3]);   \
    unsigned b0 = cvtpk(P[BASE + 4], P[BASE + 5]), b1 = cvtpk(P[BASE + 6], P[BASE + 7]);                              \
    auto r0 = __builtin_amdgcn_permlane32_swap(a0, b0, false, false); auto r1 = __builtin_amdgcn_permlane32_swap(a1, b1, false, false); \
    u32x4 w = {r0[0], r1[0], r0[1], r1[1]}; OUT = *reinterpret_cast<bf16x8*>(&w); } while (0)
  PK4(p0, 0, pa0); PK4(p0, 8, pa1); PK4(p1, 0, pa2); PK4(p1, 8, pa3);
#undef PK4
}
__device__ __forceinline__ void qkt(f32x16& p0, f32x16& p1, const bf16* Ks, const bf16x8* qr, int r32, int hi) {
  p0 = f32x16{}; p1 = f32x16{};
  for (int d0 = 0; d0 < 8; ++d0) { int cb = (d0 * 16 + hi * 8) * 2;
    bf16x8 b0 = *reinterpret_cast<const bf16x8*>((const char*)Ks + KSWZ(r32, cb));
    bf16x8 b1 = *reinterpret_cast<const bf16x8*>((const char*)Ks + KSWZ(32 + r32, cb));
    p0 = __builtin_amdgcn_mfma_f32_32x32x16_bf16(b0, qr[d0], p0, 0, 0, 0);
    p1 = __builtin_amdgcn_mfma_f32_32x32x16_bf16(b1, qr[d0], p1, 0, 0, 0); }
}
__device__ __forceinline__ int v_st(int k, int c) { const int kk = (k & ~0xC) | ((k & 4) << 1) | ((k & 8) >> 1); return ((kk >> 3) * 4 + (c >> 5)) * 512 + ((kk & 7) * 32 + (c & 31)) * 2; }
__device__ __forceinline__ int v_rd_base(int lane) { return ((lane & 3) << 3) | (((lane >> 2) & 3) << 6) | (((lane >> 4) & 1) << 5) | (((lane >> 5) & 1) << 8); }
constexpr int v_rd_off(int d0, int ks, int half) { return d0 * 512 + ks * 4096 + half * 2048; }
template <int OFF> __device__ __forceinline__ s16x4 tr_read(int vb) {
  s16x4 r; asm volatile("ds_read_b64_tr_b16 %0, %1 offset:%2" : "=&v"(r) : "v"(vb), "i"(OFF) : "memory"); return r;
}
template <int D0> __device__ __forceinline__ void pv_one(f32x16& od, int vb, bf16x8 pa0, bf16x8 pa1, bf16x8 pa2, bf16x8 pa3) {
  const s16x4 l0 = tr_read<v_rd_off(D0, 0, 0)>(vb), h0 = tr_read<v_rd_off(D0, 0, 1)>(vb), l1 = tr_read<v_rd_off(D0, 1, 0)>(vb), h1 = tr_read<v_rd_off(D0, 1, 1)>(vb);
  const s16x4 l2 = tr_read<v_rd_off(D0, 2, 0)>(vb), h2 = tr_read<v_rd_off(D0, 2, 1)>(vb), l3 = tr_read<v_rd_off(D0, 3, 0)>(vb), h3 = tr_read<v_rd_off(D0, 3, 1)>(vb);
  asm volatile("s_waitcnt lgkmcnt(0)" ::: "memory"); SBAR();
#define PK(L, H) (bf16x8){L[0], L[1], L[2], L[3], H[0], H[1], H[2], H[3]}
  od = __builtin_amdgcn_mfma_f32_32x32x16_bf16(pa0, PK(l0, h0), od, 0, 0, 0);
  od = __builtin_amdgcn_mfma_f32_32x32x16_bf16(pa1, PK(l1, h1), od, 0, 0, 0);
  od = __builtin_amdgcn_mfma_f32_32x32x16_bf16(pa2, PK(l2, h2), od, 0, 0, 0);
  od = __builtin_amdgcn_mfma_f32_32x32x16_bf16(pa3, PK(l3, h3), od, 0, 0, 0);
#undef PK
}
__device__ __forceinline__ void pv_d0(f32x16* o, int vb, bf16x8 pa0, bf16x8 pa1, bf16x8 pa2, bf16x8 pa3) {
  pv_one<0>(o[0], vb, pa0, pa1, pa2, pa3); pv_one<1>(o[1], vb, pa0, pa1, pa2, pa3); pv_one<2>(o[2], vb, pa0, pa1, pa2, pa3); pv_one<3>(o[3], vb, pa0, pa1, pa2, pa3);
}
template <typename TQ>
__device__ __forceinline__ void attn_dense_body(const TQ* __restrict__ Qb, const bf16* __restrict__ Kh, const bf16* __restrict__ Vh,
                                                bf16* __restrict__ Ob, int seq, char* lds) {
  using St = Stage<bf16>; using SQ = Stage<TQ>;
  int tid_ = threadIdx.x; asm volatile("" : "+v"(tid_));
  const int tid = tid_, wid = tid >> 6, lane = tid & 63, r32 = lane & 31, hi = lane >> 5;
  bf16* V_lds = (bf16*)lds; bf16* K_lds = (bf16*)(lds + 2 * SHM_V);
  float* ws = (float*)(lds + 2 * SHM_V + 2 * SHM_K) + wid * 64; float* li_l = ws; float* al_l = ws + 32;
  float m_reg = -1e30f, l_reg = 0; f32x16 o[4] = {}; bf16x8 qr[8];
  const TQ* Qw = Qb + (long)(wid * QBLK + r32) * LDQ + hi * 8;
#pragma unroll
  for (int d0 = 0; d0 < 8; ++d0) qr[d0] = SQ::tobf(SQ::ld8(Qw + d0 * 16));
  const int sr = tid >> 4, sc = (tid & 15) * 8, vst0 = v_st(sr, sc), vst1 = v_st(32 + sr, sc);
  const int vb0 = (int)(uintptr_t)V_lds + v_rd_base(lane);
  struct { typename St::T vs0, vs1, ks0, ks1; } sr_[SDEPTH];
#define SLOAD(i, k0) do { sr_[i].vs0 = St::ld8(&Vh[(long)((k0) + sr) * LDK + sc]); sr_[i].vs1 = St::ld8(&Vh[(long)((k0) + 32 + sr) * LDK + sc]); \
    sr_[i].ks0 = St::ld8(&Kh[(long)((k0) + sr) * LDK + sc]); sr_[i].ks1 = St::ld8(&Kh[(long)((k0) + 32 + sr) * LDK + sc]); } while (0)
#define SWRITE(b, i) do { *(bf16x8*)((char*)V_lds + (b) * SHM_V + vst0) = St::tobf(sr_[i].vs0);          \
    *(bf16x8*)((char*)V_lds + (b) * SHM_V + vst1) = St::tobf(sr_[i].vs1); int kc = sc * 2;               \
    *(bf16x8*)((char*)K_lds + (b) * SHM_K + KSWZ(sr, kc)) = St::tobf(sr_[i].ks0);                       \
    *(bf16x8*)((char*)K_lds + (b) * SHM_K + KSWZ(32 + sr, kc)) = St::tobf(sr_[i].ks1); } while (0)
#define SWAIT() do { if constexpr (SDEPTH == 2) asm volatile("s_waitcnt vmcnt(4)" ::: "memory"); else asm volatile("s_waitcnt vmcnt(0)" ::: "memory"); } while (0)
#define RESC(a) do { if (__any((a) < 1.f)) { if (hi == 0) al_l[r32] = (a); asm volatile("s_waitcnt lgkmcnt(0)" ::: "memory"); \
    for (int d = 0; d < 4; ++d) for (int r = 0; r < 16; ++r) o[d][r] *= al_l[crow(r, hi)]; } } while (0)
  f32x16 pA0, pA1, pB0, pB1; float mnA, mnB, alA, alB; bf16x8 pa0, pa1, pa2, pa3; const int NT = seq / KVBLK;
  constexpr int SE = 0, SO = SDEPTH - 1;
  SLOAD(SE, 0); asm volatile("s_waitcnt vmcnt(0)" ::: "memory"); SWRITE(0, SE); __syncthreads();
  qkt(pA0, pA1, K_lds, qr, r32, hi); partialSM(pA0, pA1, m_reg, mnA, alA);
  SLOAD(SO, KVBLK); if constexpr (SDEPTH == 2) { if (2 < NT) SLOAD(SE, 2 * KVBLK); }
  SWAIT(); SWRITE(1, SO); __syncthreads();
  for (int j = 1; j + 1 < NT; j += 2) {
    SBAR(); qkt(pB0, pB1, (bf16*)((char*)K_lds + SHM_K), qr, r32, hi);
    finishSM(pA0, pA1, alA, l_reg, pa0, pa1, pa2, pa3); SBAR();
    SLOAD(SO, (j + SDEPTH) * KVBLK); SBAR();
    pv_d0(o, vb0, pa0, pa1, pa2, pa3); partialSM(pB0, pB1, m_reg, mnB, alB);
    __syncthreads(); SWAIT(); SWRITE(0, SE);
    RESC(alB); __syncthreads();
    SBAR(); qkt(pA0, pA1, K_lds, qr, r32, hi);
    finishSM(pB0, pB1, alB, l_reg, pa0, pa1, pa2, pa3); SBAR();
    if (SDEPTH == 1 || j + 3 < NT) SLOAD(SE, (j + 1 + SDEPTH) * KVBLK); SBAR();
    pv_d0(o, vb0 + (int)SHM_V, pa0, pa1, pa2, pa3); partialSM(pA0, pA1, m_reg, mnA, alA);
    __syncthreads(); SWAIT(); SWRITE(1, SO);
    RESC(alA); __syncthreads();
  }
  SBAR(); qkt(pB0, pB1, (bf16*)((char*)K_lds + SHM_K), qr, r32, hi);
  finishSM(pA0, pA1, alA, l_reg, pa0, pa1, pa2, pa3); SBAR();
  pv_d0(o, vb0, pa0, pa1, pa2, pa3); partialSM(pB0, pB1, m_reg, mnB, alB);
  __syncthreads(); RESC(alB);
  finishSM(pB0, pB1, alB, l_reg, pa0, pa1, pa2, pa3); SBAR();
  pv_d0(o, vb0 + (int)SHM_V, pa0, pa1, pa2, pa3);
  if (hi == 0) li_l[r32] = l_reg; asm volatile("s_waitcnt lgkmcnt(0)" ::: "memory");
  float rli[16];
#pragma unroll
  for (int r = 0; r < 16; ++r) rli[r] = __builtin_amdgcn_rcpf(li_l[crow(r, hi)]);
  bf16* Ow = Ob + (long)(wid * QBLK) * LDO;
#pragma unroll
  for (int r = 0; r < 16; ++r) { int orow = crow(r, hi);
    for (int d0 = 0; d0 < 4; ++d0) Ow[(long)orow * LDO + d0 * 32 + r32] = (bf16)(cvtpk(o[d0][r] * rli[r], 0.f) & 0xffffu); }
#undef SLOAD
#undef SWRITE
#undef SWAIT
#undef RESC
}
}
#define FFT_HD __device__ __forceinline__
#define FFT_LD(p, i) ({ const f32x2 _w = (p)[i]; cf{_w.x, _w.y}; })
#define FFT_ST(p, i, v) do { const cf _v = (v); (p)[i] = (f32x2){_v.x, _v.y}; } while (0)
#ifndef FFT_HD
#define FFT_HD __device__ __forceinline__
#endif
#ifndef FFT_SCHED_DEFINED_EARLY
#define FFT_SCHED_DEFINED_EARLY
#ifndef FFT_SCHED
#define FFT_SCHED() __builtin_amdgcn_sched_barrier(0)
#endif
#endif
#ifndef FFT_LD
#define FFT_LD(p, i) ((p)[i])
#define FFT_ST(p, i, v) ((p)[i] = (v))
#endif
struct __attribute__((aligned(8))) cf { float x, y; };
FFT_HD cf cf_add(cf a, cf b) { return cf{a.x + b.x, a.y + b.y}; }
FFT_HD cf cf_sub(cf a, cf b) { return cf{a.x - b.x, a.y - b.y}; }
FFT_HD cf cf_mul(cf a, cf b) { return cf{a.x * b.x - a.y * b.y, a.x * b.y + a.y * b.x}; }
FFT_HD cf cf_mulc(cf a, cf b) { return cf{a.x * b.x + a.y * b.y, a.y * b.x - a.x * b.y}; }
FFT_HD cf cf_conj(cf a) { return cf{a.x, -a.y}; }
constexpr int FFT_N = 16384;
constexpr int FFT_LDS_CF = 17904;
constexpr int FFT_LDS_BYTES = FFT_LDS_CF * 8;
FFT_HD int fft_phys(int p) { return p + (p >> 4) + ((p >> 9) << 4); }
#define FFT_C32(k) ((k) == 0 ? 1.0f : (k) == 1 ? 0.98078528040323043f : (k) == 2 ? 0.92387953251128674f : (k) == 3 ? 0.83146961230254524f : (k) == 4 ? 0.70710678118654752f : \
    (k) == 5 ? 0.55557023301960218f : (k) == 6 ? 0.38268343236508978f : (k) == 7 ? 0.19509032201612825f : (k) == 8 ? 0.0f : (k) == 9 ? -0.19509032201612825f : \
    (k) == 10 ? -0.38268343236508978f : (k) == 11 ? -0.55557023301960218f : (k) == 12 ? -0.70710678118654752f : (k) == 13 ? -0.83146961230254524f : (k) == 14 ? -0.92387953251128674f : -0.98078528040323043f)
#define FFT_S32(k) ((k) == 0 ? 0.0f : (k) == 1 ? 0.19509032201612825f : (k) == 2 ? 0.38268343236508978f : (k) == 3 ? 0.55557023301960218f : (k) == 4 ? 0.70710678118654752f : \
    (k) == 5 ? 0.83146961230254524f : (k) == 6 ? 0.92387953251128674f : (k) == 7 ? 0.98078528040323043f : (k) == 8 ? 1.0f : (k) == 9 ? 0.98078528040323043f : \
    (k) == 10 ? 0.92387953251128674f : (k) == 11 ? 0.83146961230254524f : (k) == 12 ? 0.70710678118654752f : (k) == 13 ? 0.55557023301960218f : (k) == 14 ? 0.38268343236508978f : 0.19509032201612825f)

template <int R, bool INV> FFT_HD void dft_reg(cf (&v)[R]) {
#pragma unroll
    for (int half = R / 2; half >= 1; half >>= 1) {
#pragma unroll
        for (int g = 0; g < R; g += 2 * half) {
#pragma unroll
            for (int i = 0; i < half; ++i) {
                const cf a = v[g + i], b = v[g + i + half];
                v[g + i] = cf_add(a, b);
                const cf d = cf_sub(a, b);
                const int ti = i * (16 / half);
                if (ti == 0) v[g + i + half] = d;
                else if (ti == 8) v[g + i + half] = INV ? cf{-d.y, d.x} : cf{d.y, -d.x};
                else { const float c = FFT_C32(ti), s = INV ? FFT_S32(ti) : -FFT_S32(ti); v[g + i + half] = cf{d.x * c - d.y * s, d.x * s + d.y * c}; }
            }
        }
        FFT_SCHED();
    }
    cf t[R];
#pragma unroll
    for (int k = 0; k < R; ++k) t[k] = v[k];
#pragma unroll
    for (int k = 0; k < R; ++k) {
        const int r = R == 32 ? (((k & 1) << 4) | ((k & 2) << 2) | (k & 4) | ((k & 8) >> 2) | ((k & 16) >> 4)) : (((k & 1) << 3) | ((k & 2) << 1) | ((k & 4) >> 1) | ((k & 8) >> 3));
        v[k] = t[r];
    }
}
#ifndef FFT_OPAQUE
#define FFT_OPAQUE(x) asm volatile("" : "+v"(x))
#endif
#ifndef FFT_SCHED
#define FFT_SCHED() __builtin_amdgcn_sched_barrier(0)
#endif
#ifndef FFT_SINCOS2PI
#define FFT_SINCOS2PI(frac, s, c) do { (s) = __builtin_amdgcn_sinf(frac); (c) = __builtin_amdgcn_cosf(frac); } while (0)
#endif
template <int R> FFT_HD void twiddle_chain(cf (&v)[R], float frac  ) {
    FFT_OPAQUE(frac);
    float s, c; FFT_SINCOS2PI(frac, s, c);
    const cf w{c, s}; cf p = w;
#pragma unroll
    for (int k = 1; k < R; ++k) { v[k] = cf_mul(v[k], p); if (k + 1 < R) p = cf_mul(p, w); if ((k & 7) == 7) FFT_SCHED(); }
}
template <class LP> FFT_HD void fft_f1(LP lds, int t, cf (&v)[32]) {
    dft_reg<32, false>(v);
    twiddle_chain<32>(v, -(float)t * (1.0f / 16384.0f));
    int P1 = t + (t >> 4); FFT_OPAQUE(P1);
#pragma unroll
    for (int k = 0; k < 32; ++k) FFT_ST(lds, P1 + 560 * k, v[k]);
}
template <class LP> FFT_HD void fft_f2(LP lds, int t) {
    int P2 = 560 * (t >> 4) + (t & 15); FFT_OPAQUE(P2);
    cf v[32];
#pragma unroll
    for (int j = 0; j < 32; ++j) v[j] = FFT_LD(lds, P2 + 17 * j);
    dft_reg<32, false>(v);
    twiddle_chain<32>(v, -(float)(t & 15) * (1.0f / 512.0f));
#pragma unroll
    for (int k = 0; k < 32; ++k) FFT_ST(lds, P2 + 17 * k, v[k]);
}
template <class LP, bool INV> FFT_HD void fft_p3(LP lds, int t) {
#pragma unroll
    for (int q = 0; q < 2; ++q) {
        int P3 = 17 * t + 16 * (t >> 5) + 8960 * q; FFT_OPAQUE(P3);
        cf v[16];
#pragma unroll
        for (int j = 0; j < 16; ++j) v[j] = FFT_LD(lds, P3 + j);
        dft_reg<16, INV>(v);
#pragma unroll
        for (int k = 0; k < 16; ++k) FFT_ST(lds, P3 + k, v[k]);
    }
}
FFT_HD int fft_pos(int k) { return 512 * (k & 31) + 16 * ((k >> 5) & 31) + (k >> 10); }
template <class LP, int MODE> FFT_HD void fft_pair(LP lds, int t, float* K  ) {
    const int m = t & 31, alo = t >> 5; unsigned ut = (unsigned)t; FFT_OPAQUE(ut);
    float fr0 = -(float)(alo + 32 * m) * (1.0f / 32768.0f); FFT_OPAQUE(fr0);
    float s, c; FFT_SINCOS2PI(fr0, s, c);
    cf wh{c, s};
    const cf c1024{0.98078528040323043f, -0.19509032201612825f};
    const cf c16{0.99999529380957619f, -0.0030679567629659761f};
#pragma unroll
    for (int h = 0; h < 8; ++h) {
#pragma unroll
        for (int e = 0; e < 2; ++e) {
            const int j = 2 * h + e;
            const cf w = e ? cf_mul(wh, c16) : wh;
            const int k = alo + 16 * e + 32 * m + 1024 * h;
            const int a = alo + 16 * e, an = (32 - a) & 31, b1 = a != 0 ? 1 : 0, mn = (32 - m - b1) & 31, b2 = (m + b1) != 0 ? 1 : 0;
            const int pk = 560 * a + 17 * m + h, pn = 560 * an + 17 * mn + 16 - b2 - h;
            const cf zk = FFT_LD(lds, pk), zn = FFT_LD(lds, pn);
            cf xk, xn;
            if (k == 0) { xk = cf{zk.x + zk.y, 0.f}; xn = cf{zk.x - zk.y, 0.f}; }
            else {
                const cf E{0.5f * (zk.x + zn.x), 0.5f * (zk.y - zn.y)};
                const cf O{0.5f * (zk.y + zn.y), -0.5f * (zk.x - zn.x)};
                const cf wo = cf_mul(w, O);
                xk = cf_add(E, wo); xn = cf_conj(cf_sub(E, wo));
            }
            if (MODE == 0) { K[512 * (4 * j + 0) + ut] = xk.x; K[512 * (4 * j + 1) + ut] = xk.y; K[512 * (4 * j + 2) + ut] = xn.x; K[512 * (4 * j + 3) + ut] = xn.y; }
            else {
                const float k0 = K[512 * (4 * j + 0) + ut], k1 = K[512 * (4 * j + 1) + ut], k2 = K[512 * (4 * j + 2) + ut], k3 = K[512 * (4 * j + 3) + ut];
                const cf yk = cf_mul(xk, cf{k0, k1}), yn = cf_mul(xn, cf{k2, k3});
                cf ok, on;
                if (k == 0) { ok = cf{0.5f * (yk.x + yn.x), 0.5f * (yk.x - yn.x)}; on = ok; }
                else {
                    const cf E{0.5f * (yk.x + yn.x), 0.5f * (yk.y - yn.y)};
                    const cf D{0.5f * (yk.x - yn.x), 0.5f * (yk.y + yn.y)};
                    const cf O = cf_mulc(D, w);
                    ok = cf{E.x - O.y, E.y + O.x};
                    on = cf{E.x + O.y, -E.y + O.x};
                }
                FFT_ST(lds, pk, ok); if (k != 0) FFT_ST(lds, pn, on);
            }
        }
        wh = cf_mul(wh, c1024);
    }
    if (t == 0) {
        const int pk = 8;
        const cf z = FFT_LD(lds, pk);
        if (MODE == 0) { K[512 * 64 + ut] = z.x; K[512 * 65 + ut] = -z.y; }
        else FFT_ST(lds, pk, cf_mulc(z, cf{K[512 * 64 + ut], K[512 * 65 + ut]}));
    }
}
template <class LP> FFT_HD void fft_i2(LP lds, int t) {
    int P2 = 560 * (t >> 4) + (t & 15); FFT_OPAQUE(P2);
    cf v[32];
#pragma unroll
    for (int k = 0; k < 32; ++k) v[k] = FFT_LD(lds, P2 + 17 * k);
    twiddle_chain<32>(v, (float)(t & 15) * (1.0f / 512.0f));
    dft_reg<32, true>(v);
#pragma unroll
    for (int j = 0; j < 32; ++j) FFT_ST(lds, P2 + 17 * j, v[j]);
}
template <class LP> FFT_HD void fft_i1(LP lds, int t, cf (&v)[32]) {
    int P1 = t + (t >> 4); FFT_OPAQUE(P1);
#pragma unroll
    for (int k = 0; k < 32; ++k) v[k] = FFT_LD(lds, P1 + 560 * k);
    twiddle_chain<32>(v, (float)t * (1.0f / 16384.0f));
    dft_reg<32, true>(v);
}
constexpr int LDS_BYTES = 147456;
constexpr int LDS_BARW = LDS_BYTES - 64;

struct Fr {
    LAS unsigned char* lds; unsigned char* ldsg;
    int tid, lane, wave, blk, nblk, gw, ngw;
    const __attribute__((address_space(4))) unsigned long long* ka;
    unsigned char* ws;
};
#define BFE(v, e) (((e) & 1) ? bfhi((v)[(e) >> 1]) : bflo((v)[(e) >> 1]))

__device__ __forceinline__ void wconv_item(const float* W, int K, int N, bf16_t* WT, int mode, int row_off, LAS float* scr, int item, int lane) {
    const int nblk = N / 32, kb = item / nblk, nb = item % nblk, k0 = 64 * kb, n0 = 32 * nb;
#pragma unroll 8
    for (int i = 0; i < 32; ++i) { const int kk = 2 * i + (lane >> 5); scr[kk * 33 + (lane & 31)] = W[(size_t)(k0 + kk) * N + n0 + (lane & 31)]; }
    LDS_WAIT(); asm volatile("" ::: "memory");
    const int rbase = mode ? 256 * (n0 >> 7) + (n0 & 127) + row_off : row_off + n0;
    const int c = lane & 7;
#pragma unroll
    for (int j = 0; j < 4; ++j) { const int n = (lane >> 3) + 8 * j; const LAS float* s = scr + (8 * c) * 33 + n;
        u32x4 o; o.x = cvt_pk_bf16(s[0 * 33], s[1 * 33]); o.y = cvt_pk_bf16(s[2 * 33], s[3 * 33]); o.z = cvt_pk_bf16(s[4 * 33], s[5 * 33]); o.w = cvt_pk_bf16(s[6 * 33], s[7 * 33]);
        *(u32x4*)(WT + (size_t)(rbase + n) * K + k0 + 8 * c) = o; }
    LDS_WAIT(); asm volatile("" ::: "memory");
}
struct WSet { const float *gate, *up, *down, *win, *wout; int nin; };
__device__ __forceinline__ void wconv_layer(const Fr& F, const WSet& w, unsigned char* ws) {
    LAS float* scr = (LAS float*)(F.lds + F.wave * 16384);
    bf16_t* WGU = (bf16_t*)(ws + WS_WGU); bf16_t* WD = (bf16_t*)(ws + WS_WD); bf16_t* WIN = (bf16_t*)(ws + WS_WIN); bf16_t* WOUT = (bf16_t*)(ws + WS_WOUT);
    const int I_G = 32 * (DFF / 32), I_D = (DFF / 64) * (D / 32), I_IN = 32 * (w.nin / 32), I_OUT = 32 * (D / 32);
    const int total = 2 * I_G + I_D + I_IN + I_OUT;
    for (int it = F.gw; it < total; it += F.ngw) {
        int r = it;
        if (r < I_G) { wconv_item(w.gate, D, DFF, WGU, 1, 0, scr, r, F.lane); continue; } r -= I_G;
        if (r < I_G) { wconv_item(w.up, D, DFF, WGU, 1, 128, scr, r, F.lane); continue; } r -= I_G;
        if (r < I_D) { wconv_item(w.down, DFF, D, WD, 0, 0, scr, r, F.lane); continue; } r -= I_D;
        if (r < I_IN) { wconv_item(w.win, D, w.nin, WIN, 0, 0, scr, r, F.lane); continue; } r -= I_IN;
        wconv_item(w.wout, D, D, WOUT, 0, 0, scr, r, F.lane);
    }
}

__device__ __forceinline__ void adaln_phase(const Fr& F, const float* c, const float* c_ctx, const float* w_mod, const float* b_mod, float* mod) {
    LAS float* sl = (LAS float*)F.lds;
    LAS float* red = sl + 3 * D;
    for (int i = F.tid; i < 3 * D; i += NTHREADS) { const int cnd = i / D, k = i % D; const float x = cnd < 2 ? c[cnd * D + k] : c_ctx[k]; sl[i] = x / (1.0f + __expf(-x)); }
    __syncthreads();
    for (int g = F.blk; g < 192; g += F.nblk) {
        const int layer = g / 48, colg = (g % 48) * 256, col = colg + 4 * F.lane;
        const float* wp = w_mod + (size_t)layer * D * NMOD + col;
        f32x4 a0 = {0.f, 0.f, 0.f, 0.f}, a1 = a0, a2 = a0;
#pragma unroll 8
        for (int kk = 0; kk < 256; ++kk) { const int k = F.wave * 256 + kk; const f32x4 w = *(const f32x4*)(wp + (size_t)k * NMOD);
            a0 += w * sl[k]; a1 += w * sl[D + k]; a2 += w * sl[2 * D + k]; }
        *(LAS f32x4*)(red + (F.wave * 3 + 0) * 256 + 4 * F.lane) = a0; *(LAS f32x4*)(red + (F.wave * 3 + 1) * 256 + 4 * F.lane) = a1; *(LAS f32x4*)(red + (F.wave * 3 + 2) * 256 + 4 * F.lane) = a2;
        __syncthreads();
        for (int o = F.tid; o < 768; o += NTHREADS) { const int cnd = o >> 8, cc = o & 255; float s = 0.f;
#pragma unroll
            for (int w = 0; w < 8; ++w) s += red[(w * 3 + cnd) * 256 + cc];
            mod[((size_t)layer * 3 + cnd) * NMOD + colg + cc] = s + b_mod[layer * NMOD + colg + cc]; }
        __syncthreads();
    }
}

__device__ __forceinline__ void hdn_phase(const Fr& F, const float* w1, const float* b1, const float* w2, const float* b2, const float* w3, const float* b3, const float* freq, float* hdn) {
    for (int idx = F.gw; idx < 2 * (SEQ + CTXL); idx += F.ngw) {
        const int j = idx / (SEQ + CTXL), tt = idx % (SEQ + CTXL); const bool ctx = tt >= SEQ; const int t = ctx ? tt - SEQ : tt, L = ctx ? CTXL : SEQ;
        const float tn = (float)t / (float)(L - 1), rev = (float)t / (float)L;
        const int k = F.lane; float z = 0.f;
        if (k == 0) z = tn;
        else if (k <= 32) { const int i = (k - 1) & 15; const float fb = 1e-4f + (float)i * ((15.0f - 1e-4f) / 15.0f); const float a = 6.283185307179586f * (fb * rev);
            z = k <= 16 ? cosf(a) : -sinf(a); }
        const float fr = freq[j * 64 + F.lane];
        float acc = b1[j * 64 + F.lane];
#pragma unroll
        for (int q = 0; q < 33; ++q) acc += lane_bcast(z, q) * w1[(j * 33 + q) * 64 + F.lane];
        float h = sinf(fr * acc);
        acc = b2[j * 64 + F.lane];
#pragma unroll
        for (int q = 0; q < 64; ++q) acc += lane_bcast(h, q) * w2[(j * 64 + q) * 64 + F.lane];
        h = sinf(fr * acc);
        acc = b3[j * 64 + F.lane];
#pragma unroll
        for (int q = 0; q < 64; ++q) acc += lane_bcast(h, q) * w3[(j * 64 + q) * 64 + F.lane];
        hdn[(size_t)idx * 64 + F.lane] = sinf(fr * acc);
    }
}

__device__ __forceinline__ void hy_filt_tiles(const Fr& F, const float* hdn  , const float* w4  , float* KF, int L, int first, int stride) {
    LAS float* hT = (LAS float*)F.lds;
    LAS float* wS = hT + 64 * 257;
    const int ntiles = (L / 256) * 32;
    for (int tile = first; tile < ntiles; tile += stride) {
        const int t0 = (tile >> 5) * 256, c0 = (tile & 31) * 64;
        __syncthreads();
#pragma unroll 4
        for (int i = 0; i < 32; ++i) { const int idx = F.tid + 512 * i, tl = idx >> 6, j = idx & 63; hT[j * 257 + tl] = hdn[(size_t)(t0 + tl) * 64 + j]; }
#pragma unroll 4
        for (int i = 0; i < 16; ++i) { const int idx = F.tid + 512 * i, j = idx >> 7, cc = idx & 127; wS[idx] = w4[j * 4096 + (cc < 64 ? c0 + cc : 2048 + c0 + cc - 64)]; }
        __syncthreads();
        const int tl = F.tid & 255, half = F.tid >> 8;
        float acc[64];
#pragma unroll
        for (int q = 0; q < 64; ++q) acc[q] = 0.f;
        for (int j = 0; j < 64; ++j) { const float a = hT[j * 257 + tl];
#pragma unroll
            for (int q = 0; q < 16; ++q) { const f32x4 w = *(const LAS f32x4*)(wS + j * 128 + half * 64 + 4 * q);
                acc[4 * q + 0] += a * w[0]; acc[4 * q + 1] += a * w[1]; acc[4 * q + 2] += a * w[2]; acc[4 * q + 3] += a * w[3]; } }
        const int t = t0 + tl; const float tn = (float)t / (float)(L - 1);
        float* dst = KF + (size_t)c0 * (2 * L) + (half ? (t > 0 ? 2 * L - t : L) : t);
#pragma unroll
        for (int q = 0; q < 64; ++q) { const float dl = 3.0701134573253946f + 12.280453829301578f * ((float)(c0 + q) * (1.0f / 2047.0f));
            const float v = acc[q] * __expf(-tn * dl);
            dst[(size_t)q * (2 * L)] = (half && t == 0) ? 0.f : v; }
    }
}

__device__ __forceinline__ void norm_rows(const Fr& F, const float* src_lat, const float* src_ctx, int nrows, const float* g, const float* modl, int sh_off, int sc_off, bf16_t* A) {
    for (int r = F.gw; r < nrows; r += F.ngw) {
        const float* xr = r < M_LAT ? src_lat + (size_t)r * D : src_ctx + (size_t)(r - M_LAT) * D;
        const int cond = r < M_LAT ? (r >> 14) : 2;
        const float* sh = modl + cond * NMOD + sh_off; const float* sc = modl + cond * NMOD + sc_off;
        f32x4 v[8]; float ss = 0.f;
#pragma unroll
        for (int j = 0; j < 8; ++j) { v[j] = *(const f32x4*)(xr + 4 * F.lane + 256 * j); ss += (v[j].x * v[j].x + v[j].y * v[j].y) + (v[j].z * v[j].z + v[j].w * v[j].w); }
        const float rstd = 1.0f / sqrtf(wave_sum(ss) * (1.0f / D) + NORM_EPS);
#pragma unroll
        for (int j = 0; j < 8; ++j) { const int c = 4 * F.lane + 256 * j;
            const f32x4 gv = *(const f32x4*)(g + c), sv = *(const f32x4*)(sh + c), cv = *(const f32x4*)(sc + c);
            const f32x4 y = (v[j] * rstd) * gv * (cv + 1.0f) + sv;
            u32x2 o; o.x = cvt_pk_bf16(y.x, y.y); o.y = cvt_pk_bf16(y.z, y.w);
            *(u32x2*)(A + (size_t)r * D + c) = o; }
    }
}
__device__ __forceinline__ void final_norm(const Fr& F, const float* X, const float* g, float* out) {
    for (int r = F.gw; r < M_LAT; r += F.ngw) {
        const float* xr = X + (size_t)r * D;
        f32x4 v[8]; float ss = 0.f;
#pragma unroll
        for (int j = 0; j < 8; ++j) { v[j] = *(const f32x4*)(xr + 4 * F.lane + 256 * j); ss += (v[j].x * v[j].x + v[j].y * v[j].y) + (v[j].z * v[j].z + v[j].w * v[j].w); }
        const float rstd = 1.0f / sqrtf(wave_sum(ss) * (1.0f / D) + NORM_EPS);
#pragma unroll
        for (int j = 0; j < 8; ++j) { const int c = 4 * F.lane + 256 * j; *(f32x4*)(out + (size_t)r * D + c) = (v[j] * rstd) * *(const f32x4*)(g + c); }
    }
}

__device__ __forceinline__ void conv3_8(const bf16_t* zr  , int ld, int col, bool hp, bool hn, const float* w, int wld, const float* b, float (&out)[8]) {
    const u32x4 z0 = {0u, 0u, 0u, 0u};
    const u32x4 zm = hp ? *(const u32x4*)(zr - ld + col) : z0, zc = *(const u32x4*)(zr + col), zp = hn ? *(const u32x4*)(zr + ld + col) : z0;
    const f32x4 w0a = *(const f32x4*)(w + col), w0b = *(const f32x4*)(w + col + 4), w1a = *(const f32x4*)(w + wld + col), w1b = *(const f32x4*)(w + wld + col + 4);
    const f32x4 w2a = *(const f32x4*)(w + 2 * wld + col), w2b = *(const f32x4*)(w + 2 * wld + col + 4);
    f32x4 ba = {0.f, 0.f, 0.f, 0.f}, bb = ba; if (b) { ba = *(const f32x4*)(b + col); bb = *(const f32x4*)(b + col + 4); }
#pragma unroll
    for (int e = 0; e < 8; ++e) { const float w0 = e < 4 ? w0a[e & 3] : w0b[e & 3], w1 = e < 4 ? w1a[e & 3] : w1b[e & 3], w2 = e < 4 ? w2a[e & 3] : w2b[e & 3], bv = e < 4 ? ba[e & 3] : bb[e & 3];
        out[e] = BFE(zm, e) * w0 + BFE(zc, e) * w1 + BFE(zp, e) * w2 + bv; }
}
__device__ __forceinline__ void row_pos(int r, int& tpos, int& Ls) { if (r < M_LAT) { Ls = SEQ; tpos = r & (SEQ - 1); } else { Ls = CTXL; tpos = (r - M_LAT) & (CTXL - 1); } }
__device__ __forceinline__ bf16_t* vt_addr(bf16_t* VT, bf16_t* VTC, int r0, int ch) {
    if (r0 < M_LAT) return VT + ((size_t)((r0 >> 14) * D + ch) * SEQ + (r0 & (SEQ - 1)));
    const int q = r0 - M_LAT; return VTC + ((size_t)((q >> 8) * D + ch) * CTXL + (q & (CTXL - 1)));
}

__device__ __forceinline__ void hy_elem_phase(const Fr& F, const bf16_t* Z, const float* sw, const float* sb, bf16_t* VT, bf16_t* VTC, int nrows) {
    LAS float* T = (LAS float*)F.lds;
    const int ntiles = (nrows / 64) * 32, tt = F.tid >> 3, cg = F.tid & 7;
    for (int tile = F.blk; tile < ntiles; tile += F.nblk) {
        const int r0 = (tile >> 5) * 64, c0 = (tile & 31) * 64, r = r0 + tt, c = c0 + 8 * cg;
        int tpos, Ls; row_pos(r, tpos, Ls);
        const bf16_t* zr = Z + (size_t)r * (3 * D);
        float x1[8], vv[8];
        conv3_8(zr, 3 * D, D + c, tpos > 0, tpos < Ls - 1, sw, 3 * D, sb, x1);
        conv3_8(zr, 3 * D, 2 * D + c, tpos > 0, tpos < Ls - 1, sw, 3 * D, sb, vv);
#pragma unroll
        for (int e = 0; e < 8; ++e) T[tt * 65 + 8 * cg + e] = vv[e] * x1[e];
        __syncthreads();
        { const int ch = F.tid >> 3, chunk = F.tid & 7; float y[8];
#pragma unroll
          for (int i = 0; i < 8; ++i) y[i] = T[(8 * chunk + i) * 65 + ch];
          u32x4 o; o.x = cvt_pk_bf16(y[0], y[1]); o.y = cvt_pk_bf16(y[2], y[3]); o.z = cvt_pk_bf16(y[4], y[5]); o.w = cvt_pk_bf16(y[6], y[7]);
          *(u32x4*)(vt_addr(VT, VTC, r0, c0 + ch) + 8 * chunk) = o; }
        __syncthreads();
    }
}
__device__ __forceinline__ void hy_post_phase(const Fr& F, const bf16_t* Z, const float* sw, const float* sb, bf16_t* VT, bf16_t* VTC, bf16_t* A, int nrows) {
    LAS float* T = (LAS float*)F.lds;
    const int ntiles = (nrows / 64) * 32, tt = F.tid >> 3, cg = F.tid & 7;
    for (int tile = F.blk; tile < ntiles; tile += F.nblk) {
        const int r0 = (tile >> 5) * 64, c0 = (tile & 31) * 64, r = r0 + tt, c = c0 + 8 * cg;
        { const int ch = F.tid >> 3, chunk = F.tid & 7; const u32x4 yv = *(const u32x4*)(vt_addr(VT, VTC, r0, c0 + ch) + 8 * chunk);
#pragma unroll
          for (int i = 0; i < 8; ++i) T[(8 * chunk + i) * 65 + ch] = BFE(yv, i); }
        __syncthreads();
        int tpos, Ls; row_pos(r, tpos, Ls);
        float x0[8];
        conv3_8(Z + (size_t)r * (3 * D), 3 * D, c, tpos > 0, tpos < Ls - 1, sw, 3 * D, sb, x0);
        float y[8];
#pragma unroll
        for (int e = 0; e < 8; ++e) y[e] = T[tt * 65 + 8 * cg + e] * x0[e];
        u32x4 o; o.x = cvt_pk_bf16(y[0], y[1]); o.y = cvt_pk_bf16(y[2], y[3]); o.z = cvt_pk_bf16(y[4], y[5]); o.w = cvt_pk_bf16(y[6], y[7]);
        *(u32x4*)(A + (size_t)r * D + c) = o;
        __syncthreads();
    }
}
__device__ __forceinline__ void sc_elem_phase(const Fr& F, const bf16_t* Z, const float* cw  , bf16_t* A, int nrows) {
    const size_t nitems = (size_t)nrows * 256;
    for (size_t idx = (size_t)F.blk * NTHREADS + F.tid; idx < nitems; idx += (size_t)F.nblk * NTHREADS) {
        const int r = (int)(idx >> 8), c = 8 * (int)(idx & 255);
        int tpos, Ls; row_pos(r, tpos, Ls);
        const bf16_t* zr = Z + (size_t)r * (3 * D);
        const u32x4 z0 = {0u, 0u, 0u, 0u};
        const u32x4 gb = *(const u32x4*)(zr + c);
        const bool hp = tpos > 0, hn = tpos < Ls - 1;
        const u32x4 gcm = hp ? *(const u32x4*)(zr - 3 * D + D + c) : z0, xvm = hp ? *(const u32x4*)(zr - 3 * D + 2 * D + c) : z0;
        const u32x4 gcc = *(const u32x4*)(zr + D + c), xvc = *(const u32x4*)(zr + 2 * D + c);
        const u32x4 gcp = hn ? *(const u32x4*)(zr + 3 * D + D + c) : z0, xvp = hn ? *(const u32x4*)(zr + 3 * D + 2 * D + c) : z0;
        const f32x4 w0a = *(const f32x4*)(cw + c), w0b = *(const f32x4*)(cw + c + 4), w1a = *(const f32x4*)(cw + D + c), w1b = *(const f32x4*)(cw + D + c + 4);
        const f32x4 w2a = *(const f32x4*)(cw + 2 * D + c), w2b = *(const f32x4*)(cw + 2 * D + c + 4);
        float y[8];
#pragma unroll
        for (int e = 0; e < 8; ++e) { const float w0 = e < 4 ? w0a[e & 3] : w0b[e & 3], w1 = e < 4 ? w1a[e & 3] : w1b[e & 3], w2 = e < 4 ? w2a[e & 3] : w2b[e & 3];
            const float pm = BFE(gcm, e) * BFE(xvm, e), pc = BFE(gcc, e) * BFE(xvc, e), pp = BFE(gcp, e) * BFE(xvp, e);
            y[e] = BFE(gb, e) * (pm * w0 + pc * w1 + pp * w2); }
        u32x4 o; o.x = cvt_pk_bf16(y[0], y[1]); o.y = cvt_pk_bf16(y[2], y[3]); o.z = cvt_pk_bf16(y[4], y[5]); o.w = cvt_pk_bf16(y[6], y[7]);
        *(u32x4*)(A + (size_t)r * D + c) = o;
    }
}
__device__ __forceinline__ void qk_prep_phase(const Fr& F, const bf16_t* Z  , const float* qg, const float* kg, bf16_t* Q, bf16_t* KALL, bf16_t* VALL) {
    const int p = F.lane;
    const float qg1 = qg[2 * p], qg2 = qg[2 * p + 1], kg1 = kg[2 * p], kg2 = kg[2 * p + 1];
    const float invf = exp2f(-(float)(p & 31) * (13.287712379549449f / 32.0f));
    for (int r = F.gw; r < M_ALL; r += F.ngw) {
        const bool lat = r < M_LAT; const int b = lat ? (r >> 14) : ((r - M_LAT) >> 8), t = lat ? (r & (SEQ - 1)) : ((r - M_LAT) & (CTXL - 1));
        const bf16_t* zr = Z + (size_t)r * 3072;
        float cs = 1.f, sn = 0.f;
        if (lat) { const float ang = (float)(p < 32 ? (t >> 6) : (t & 63)) * invf; sn = sinf(ang); cs = cosf(ang); }
        if (lat) {
#pragma unroll 4
            for (int h = 0; h < NH; ++h) { const unsigned w = *(const unsigned*)(zr + h * HD + 2 * p); const float x1 = bflo(w), x2 = bfhi(w);
                const float rstd = 1.0f / sqrtf(wave_sum(x1 * x1 + x2 * x2) * (1.0f / HD) + NORM_EPS);
                const float y1 = x1 * rstd * qg1, y2 = x2 * rstd * qg2;
                *(unsigned*)(Q + (size_t)r * D + h * HD + 2 * p) = cvt_pk_bf16(y1 * cs - y2 * sn, y1 * sn + y2 * cs); }
        }
        const size_t krow = (size_t)b * LK + (lat ? t : SEQ + t);
#pragma unroll
        for (int h = 0; h < NKV; ++h) { const unsigned w = *(const unsigned*)(zr + D + h * HD + 2 * p); const float x1 = bflo(w), x2 = bfhi(w);
            const float rstd = 1.0f / sqrtf(wave_sum(x1 * x1 + x2 * x2) * (1.0f / HD) + NORM_EPS);
            const float y1 = x1 * rstd * kg1, y2 = x2 * rstd * kg2;
            *(unsigned*)(KALL + krow * (NKV * HD) + h * HD + 2 * p) = cvt_pk_bf16(y1 * cs - y2 * sn, y1 * sn + y2 * cs);
            *(unsigned*)(VALL + krow * (NKV * HD) + h * HD + 2 * p) = *(const unsigned*)(zr + D + NKV * HD + h * HD + 2 * p); }
    }
}
__device__ __forceinline__ void hy_ctx_conv(const Fr& F, const float* KFC  , const float* skip, bf16_t* VTC  ) {
    LAS float* kp = (LAS float*)(F.lds + F.wave * 4096);
    LAS float* us = kp + 512;
    for (int pr = F.gw; pr < NB * D; pr += F.ngw) {
        const int c = pr & (D - 1);
        const float* kf = KFC + (size_t)c * 512; bf16_t* up = VTC + (size_t)pr * CTXL;
        *(LAS f32x4*)(kp + 4 * F.lane) = *(const f32x4*)(kf + 4 * F.lane); *(LAS f32x4*)(kp + 256 + 4 * F.lane) = *(const f32x4*)(kf + 256 + 4 * F.lane);
        const u32x2 uw = *(const u32x2*)(up + 4 * F.lane);
        *(LAS f32x4*)(us + 4 * F.lane) = (f32x4){bflo(uw.x), bfhi(uw.x), bflo(uw.y), bfhi(uw.y)};
        LDS_WAIT(); asm volatile("" ::: "memory");
        float acc[4] = {0.f, 0.f, 0.f, 0.f};
#pragma unroll 4
        for (int s = 0; s < CTXL; ++s) { const float u = us[s];
#pragma unroll
            for (int q = 0; q < 4; ++q) acc[q] += kp[(F.lane + 64 * q - s) & 511] * u; }
        const float sk = skip[c];
#pragma unroll
        for (int q = 0; q < 4; ++q) { const int t = F.lane + 64 * q; up[t] = (bf16_t)(cvt_pk_bf16(acc[q] + sk * us[t], 0.f) & 0xffffu); }
        LDS_WAIT(); asm volatile("" ::: "memory");
    }
}
__device__ __forceinline__ void hy_fft_phase(const Fr& F, const float* KF  , const float* skip, bf16_t* VT  , float* KSP  ) {
    LAS f32x2* L = (LAS f32x2*)F.lds;
    const int t = F.tid;
#pragma unroll 1
    for (int c = F.blk; c < D; c += F.nblk) {
        float* K = KSP + (size_t)F.blk * (66 * 512);
        {
            cf v[32]; const float* kf = KF + (size_t)c * (2 * SEQ); unsigned ut = (unsigned)t; FFT_OPAQUE(ut);
#pragma unroll
            for (int n1 = 0; n1 < 32; ++n1) { const f32x2 w = *(const f32x2*)(kf + (1024 * n1 + 2 * ut)); v[n1] = cf{w.x, w.y}; }
            fft_f1(L, t, v); __syncthreads(); fft_f2(L, t); __syncthreads(); fft_p3<LAS f32x2*, false>(L, t); __syncthreads();
            fft_pair<LAS f32x2*, 0>(L, t, K); __syncthreads();
        }
        const float sk = skip[c];
#pragma unroll 1
        for (int b = 0; b < NB; ++b) {
            bf16_t* up = VT + (size_t)(b * D + c) * SEQ;
            {   cf v[32]; unsigned ut = (unsigned)t; FFT_OPAQUE(ut);
#pragma unroll
                for (int n1 = 0; n1 < 16; ++n1) { const unsigned w = *(const unsigned*)(up + (1024 * n1 + 2 * ut)); v[n1] = cf{bflo(w), bfhi(w)}; }
#pragma unroll
                for (int n1 = 16; n1 < 32; ++n1) v[n1] = cf{0.f, 0.f};
                fft_f1(L, t, v); }
            __syncthreads(); fft_f2(L, t); __syncthreads(); fft_p3<LAS f32x2*, false>(L, t); __syncthreads();
            fft_pair<LAS f32x2*, 1>(L, t, K); __syncthreads();
            fft_p3<LAS f32x2*, true>(L, t); __syncthreads(); fft_i2(L, t); __syncthreads();
            {   cf v[32]; fft_i1(L, t, v); unsigned ut = (unsigned)t; FFT_OPAQUE(ut);
#pragma unroll
                for (int n1 = 0; n1 < 16; ++n1) { unsigned* p = (unsigned*)(up + (1024 * n1 + 2 * ut)); const unsigned w = *p;
                    *p = cvt_pk_bf16(v[n1].x * (1.0f / 16384.0f) + sk * bflo(w), v[n1].y * (1.0f / 16384.0f) + sk * bfhi(w)); } }
        }
    }
    __syncthreads();
}

__device__ __forceinline__ Fr fr_fresh(const Fr& F0) {
    Fr G = F0; int t = threadIdx.x; asm volatile("" : "+v"(t));
    G.tid = t; G.lane = t & 63; G.wave = __builtin_amdgcn_readfirstlane(t >> 6); G.gw = G.blk * NWAVES + G.wave;
    unsigned long long kv = (unsigned long long)__builtin_amdgcn_kernarg_segment_ptr(); asm volatile("" : "+s"(kv));
    G.ka = (const __attribute__((address_space(4))) unsigned long long*)kv; G.ws = (unsigned char*)G.ka[35];
    return G;
}
#ifndef EN_DEFAULT
#define EN_DEFAULT 1
#endif
#ifndef EN_PRO
#define EN_PRO EN_DEFAULT
#endif
#ifndef EN_NORM
#define EN_NORM EN_DEFAULT
#endif
#ifndef EN_FILT
#define EN_FILT EN_DEFAULT
#endif
#ifndef EN_G1
#define EN_G1 EN_DEFAULT
#endif
#ifndef EN_HYE
#define EN_HYE EN_DEFAULT
#endif
#ifndef EN_FFT
#define EN_FFT EN_DEFAULT
#endif
#ifndef EN_ATT
#define EN_ATT EN_DEFAULT
#endif
#ifndef EN_G2
#define EN_G2 EN_DEFAULT
#endif
#ifndef EN_G3
#define EN_G3 EN_DEFAULT
#endif
#ifndef EN_G4
#define EN_G4 EN_DEFAULT
#endif
struct Args { const float* in[34]; float* out; unsigned char* ws; int ph_lo, ph_hi; };
static_assert(offsetof(Args, out) == 34 * 8 && offsetof(Args, ws) == 35 * 8, "Args layout");
enum { I_X = 0, I_C, I_CTX, I_CCTX, I_N1G, I_N2G, I_WMOD, I_BMOD, I_FG, I_FU, I_FD, I_HWIN, I_HBIN, I_HSW, I_HSB, I_HFW1, I_HFB1, I_HFW2, I_HFB2, I_HFW3, I_HFB3, I_HFW4, I_HFREQ, I_HSKIP, I_HWOUT, I_HBOUT,
       I_SWIN, I_SCW, I_SWOUT, I_AQKV, I_AQG, I_AKG, I_AWO, I_FING };

__global__ void __launch_bounds__(NTHREADS, 2) dit_fwd(Args args) {
    extern __shared__ __attribute__((aligned(16))) unsigned char lds_raw[];
    Fr F0;
    F0.lds = (LAS unsigned char*)lds_raw; F0.ldsg = lds_raw;
    F0.tid = threadIdx.x; F0.lane = F0.tid & 63; F0.wave = __builtin_amdgcn_readfirstlane(F0.tid >> 6);
    F0.blk = blockIdx.x; F0.nblk = gridDim.x; F0.gw = F0.blk * NWAVES + F0.wave; F0.ngw = F0.nblk * NWAVES;
    F0.ka = nullptr; F0.ws = args.ws;
    const int lo = args.ph_lo, hi = args.ph_hi;
    if (F0.tid < 4) ((LAS unsigned*)(F0.lds + LDS_BARW))[F0.tid] = 0u;
    __syncthreads();
    XcdBarrier bar; bar.bar = (unsigned*)(args.ws + WS_CTL) + CW_BAR; bar.x = 0; bar.st = (volatile LAS unsigned*)(F0.lds + LDS_BARW);
    if (hi - lo > 1) bar = xcd_barrier_post((unsigned*)(args.ws + WS_CTL) + CW_BAR, (volatile LAS unsigned*)(F0.lds + LDS_BARW));
    int ph = 0;
#define PH_IF if (ph >= lo && ph < hi) if (Fr F = fr_fresh(F0); true)
#define PH_END do { if (ph >= lo && ph + 1 < hi) xcd_barrier(bar); ++ph; } while (0)
#define IN(i) ((const float*)F.ka[i])
#define MOD ((float*)(F.ws + WS_MOD))
#define HDN ((float*)(F.ws + WS_HDN))
#define KFC ((float*)(F.ws + WS_KFC))
#define VTC ((bf16_t*)(F.ws + WS_VTC))
#define XRES ((float*)(F.ws + WS_XRES))
#define XRES_CTX (XRES + (size_t)M_LAT * D)
#define ABUF ((bf16_t*)(F.ws + WS_A))
#define ZBUF ((bf16_t*)(F.ws + WS_Z))
#define WGU ((bf16_t*)(F.ws + WS_WGU))
#define WD ((bf16_t*)(F.ws + WS_WD))
#define WIN ((bf16_t*)(F.ws + WS_WIN))
#define WOUT ((bf16_t*)(F.ws + WS_WOUT))
#define VT ((bf16_t*)(F.ws + WS_VT))
#define KF ((float*)(F.ws + WS_KF))
#define KALL ((bf16_t*)(F.ws + WS_KALL))
#define VALL ((bf16_t*)(F.ws + WS_VALL))
#define MODL (MOD + (size_t)layer * 3 * NMOD)
#define SRC_LAT (layer == 0 ? IN(I_X) : (const float*)XRES)
#define SRC_CTX (layer == 0 ? IN(I_CTX) : (const float*)XRES_CTX)
#define HY_SW (IN(I_HSW) + (size_t)j * 3 * 3 * D)
#define HY_SB (IN(I_HSB) + (size_t)j * 3 * D)

    PH_IF {
#if EN_PRO
        adaln_phase(F, IN(I_C), IN(I_CCTX), IN(I_WMOD), IN(I_BMOD), MOD);
        hdn_phase(F, IN(I_HFW1), IN(I_HFB1), IN(I_HFW2), IN(I_HFB2), IN(I_HFW3), IN(I_HFB3), IN(I_HFREQ), HDN);
#endif
    }
    PH_END;

#pragma unroll 1
    for (int layer = 0; layer < 4; ++layer) {
        const int kind = layer % 3, j = layer / 3;
        const int rows_n1 = layer <= 2 ? M_ALL : M_LAT;
        const int rows_full = layer <= 1 ? M_ALL : M_LAT;
        const int nin = kind == 2 ? 3072 : 3 * D;
        PH_IF {
#if EN_NORM
            norm_rows(F, SRC_LAT, SRC_CTX, rows_n1, IN(I_N1G) + layer * D, MODL, 0, D, ABUF);
            WSet w; w.gate = IN(I_FG) + (size_t)layer * D * DFF; w.up = IN(I_FU) + (size_t)layer * D * DFF; w.down = IN(I_FD) + (size_t)layer * DFF * D; w.nin = nin;
            if (kind == 0) { w.win = IN(I_HWIN) + (size_t)j * D * 3 * D; w.wout = IN(I_HWOUT) + (size_t)j * D * D; }
            else if (kind == 1) { w.win = IN(I_SWIN); w.wout = IN(I_SWOUT); }
            else { w.win = IN(I_AQKV); w.wout = IN(I_AWO); }
            wconv_layer(F, w, F.ws);
#endif
#if EN_FILT
            if (kind == 0) {
                __syncthreads();
                hy_filt_tiles(F, HDN + (size_t)j * (SEQ + CTXL) * 64, IN(I_HFW4) + (size_t)j * 64 * 2 * D, KF, SEQ, F.blk, F.nblk);
                if (layer == 0) hy_filt_tiles(F, HDN + ((size_t)j * (SEQ + CTXL) + SEQ) * 64, IN(I_HFW4) + (size_t)j * 64 * 2 * D, KFC, CTXL, F.blk, F.nblk);
                __syncthreads();
            }
#endif
        }
        PH_END;
        PH_IF {
#if EN_G1
            pg8::Gemm g{ABUF, WIN, rows_n1, nin, D}; pg8::StaticOrder S; S.init(rows_n1, nin, F.nblk, F.blk);
            pg8::EpiStoreBf16 E{ZBUF, nin, kind == 0 ? IN(I_HBIN) + (size_t)j * 3 * D : nullptr};
            pg8::gemm_phase<pg8::EpiStoreBf16, pg8::StaticOrder>(F.lds, g, S, E, nullptr);
#endif
        }
        PH_END;
        if (kind == 0) {
            PH_IF {
#if EN_HYE
                hy_elem_phase(F, ZBUF, HY_SW, HY_SB, VT, VTC, rows_full);
#endif
            }
            PH_END;
            PH_IF {
#if EN_FFT
                hy_fft_phase(F, KF, IN(I_HSKIP) + j * D, VT, (float*)(F.ws + WS_KSP));
#endif
#if EN_HYE
                if (rows_full > M_LAT) hy_ctx_conv(F, KFC, IN(I_HSKIP) + j * D, VTC);
#endif
            }
            PH_END;
            PH_IF {
#if EN_HYE
                hy_post_phase(F, ZBUF, HY_SW, HY_SB, VT, VTC, ABUF, rows_full);
#endif
            }
            PH_END;
        } else if (kind == 1) {
            PH_IF {
#if EN_HYE
                sc_elem_phase(F, ZBUF, IN(I_SCW), ABUF, rows_full);
#endif
            }
            PH_END;
        } else {
            PH_IF {
#if EN_HYE
                qk_prep_phase(F, ZBUF, IN(I_AQG), IN(I_AKG), VT  , KALL, VALL);
#endif
            }
            PH_END;
            PH_IF {
#if EN_ATT
                for (int unit = F.blk; unit < NB * NH * (SEQ / 256); unit += F.nblk) {
                    const int bk = unit >> 8, b = bk >> 2, kvh = bk & 3, g = (unit >> 6) & 3, qb = unit & 63, h = kvh * 4 + g;
                    const size_t qo = ((size_t)(b * SEQ + qb * 256)) * D + h * HD, ko = (size_t)b * LK * (NKV * HD) + kvh * HD;
                    att::attn_dense_body<att::bf16>(VT + qo, KALL + ko, VALL + ko, ABUF + qo, LK, (char*)F.ldsg);
                    __syncthreads();
                }
#endif
            }
            PH_END;
        }
        PH_IF {
#if EN_G2
            pg8::Gemm g{ABUF, WOUT, rows_full, D, D}; pg8::StaticOrder S; S.init(rows_full, D, F.nblk, F.blk);
            const float* bias = kind == 0 ? IN(I_HBOUT) + j * D : nullptr;
            pg8::EpiResid E{SRC_LAT, SRC_CTX, XRES, bias, MODL + 2 * D};
            pg8::gemm_phase<pg8::EpiResid, pg8::StaticOrder>(F.lds, g, S, E, nullptr);
#endif
        }
        PH_END;
        PH_IF {
#if EN_NORM
            norm_rows(F, XRES, XRES_CTX, rows_full, IN(I_N2G) + layer * D, MODL, 3 * D, 4 * D, ABUF);
#endif
        }
        PH_END;
        PH_IF {
#if EN_G3
            pg8::Gemm g{ABUF, WGU, rows_full, 2 * DFF, D}; pg8::StaticOrder S; S.init(rows_full, 2 * DFF, F.nblk, F.blk);
            pg8::EpiSwiGLU E{ZBUF, DFF};
            pg8::gemm_phase<pg8::EpiSwiGLU, pg8::StaticOrder>(F.lds, g, S, E, nullptr);
#endif
        }
        PH_END;
        PH_IF {
#if EN_G4
            pg8::Gemm g{ZBUF, WD, rows_full, D, DFF}; pg8::StaticOrder S; S.init(rows_full, D, F.nblk, F.blk);
            pg8::EpiResid E{XRES, XRES_CTX, XRES, nullptr, MODL + 5 * D};
            pg8::gemm_phase<pg8::EpiResid, pg8::StaticOrder>(F.lds, g, S, E, nullptr);
#endif
        }
        PH_END;
    }
    PH_IF {
#if EN_NORM
        final_norm(F, XRES, IN(I_FING), (float*)IN(34));
#endif
    }
    PH_END;
#undef PH_IF
#undef PH_END
}

extern "C" void kernel_launch(void* const* d_in, const int* in_sizes, int n_in, void* d_out, int out_size, void* d_ws, size_t ws_size, hipStream_t stream) {
    static int grid = 0;
    if (grid == 0) {
        if (n_in != 34 || in_sizes[0] != M_LAT * D || out_size != M_LAT * D || ws_size < WS_END) {
            fprintf(stderr, "kernel_launch: shape mismatch: n_in %d in0 %d out %d ws %zu (need >= %zu); nothing launched\n", n_in, n_in > 0 ? in_sizes[0] : -1, out_size, ws_size, (size_t)WS_END); grid = -1; return; }
        int dev = 0, cus = 0, per_cu = 0;
        if (hipGetDevice(&dev) != hipSuccess || hipDeviceGetAttribute(&cus, hipDeviceAttributeMultiprocessorCount, dev) != hipSuccess) { fprintf(stderr, "kernel_launch: device query failed\n"); grid = -1; return; }
        if (hipFuncSetAttribute((const void*)dit_fwd, hipFuncAttributeMaxDynamicSharedMemorySize, LDS_BYTES) != hipSuccess) { fprintf(stderr, "kernel_launch: hipFuncSetAttribute failed\n"); grid = -1; return; }
        if (hipOccupancyMaxActiveBlocksPerMultiprocessor(&per_cu, (const void*)dit_fwd, NTHREADS, LDS_BYTES) != hipSuccess || per_cu < 1) {
            fprintf(stderr, "kernel_launch: occupancy query reports %d workgroups per CU; nothing launched\n", per_cu); (void)hipGetLastError(); grid = -1; return; }
        grid = cus;
    }
    if (grid < 0) return;
    if (hipMemsetAsync((char*)d_ws + WS_CTL, 0, CTL_ZERO_BYTES, stream) != hipSuccess) { fprintf(stderr, "kernel_launch: memset failed\n"); return; }
    Args a{};
    for (int i = 0; i < 34; ++i) a.in[i] = (const float*)d_in[i];
    a.out = (float*)d_out; a.ws = (unsigned char*)d_ws;
#if MK_PER_PHASE_LAUNCH
    for (int p = 0; p < N_PHASES; ++p) { a.ph_lo = p; a.ph_hi = p + 1; hipLaunchKernelGGL(dit_fwd, dim3(grid), dim3(NTHREADS), LDS_BYTES, stream, a); }
#else
    a.ph_lo = 0; a.ph_hi = N_PHASES;
    hipLaunchKernelGGL(dit_fwd, dim3(grid), dim3(NTHREADS), LDS_BYTES, stream, a);
#endif
    const hipError_t le = hipPeekAtLastError();
    if (le != hipSuccess) fprintf(stderr, "kernel_launch: launch failed: %s\n", hipGetErrorName(le));
}
```

```cpp
#include <hip/hip_runtime.h>
#include <cstdio>
#include <cstdint>
#include <cstddef>

#ifndef MK_PER_PHASE_LAUNCH
#define MK_PER_PHASE_LAUNCH 0
#endif

#ifndef EPI_TWICE
#define EPI_TWICE 0
#endif
#ifndef SEGPROBE
#define SEGPROBE 0
#define SEG_EPI 2
#define SEG_AMP 4
#endif
#ifndef RESID_NUP
#define RESID_NUP 0
#endif
#ifndef ATT_VPM
#define ATT_VPM 5
#define ATT_VMASK 0x402
#endif
#ifndef ATT_NOMAX_BOUND
#define ATT_NOMAX_BOUND 90.f
#endif
#ifndef ATT_SLSB
#define ATT_SLSB 0
#endif
#define LAS __attribute__((address_space(3)))
#define GAS __attribute__((address_space(1)))
typedef unsigned short bf16_t;
typedef short bf16x8 __attribute__((ext_vector_type(8)));
typedef float f32x4 __attribute__((ext_vector_type(4)));
typedef float f32x2 __attribute__((ext_vector_type(2)));
typedef unsigned u32x4 __attribute__((ext_vector_type(4)));
typedef unsigned u32x2 __attribute__((ext_vector_type(2)));

constexpr int D = 2048, NB = 2, SEQ = 16384, CTXL = 256, DFF = 5632, HD = 128, NH = 16, NKV = 4;
constexpr int M_LAT = NB * SEQ, M_CTX = NB * CTXL, M_ALL = M_LAT + M_CTX;
constexpr int NMOD = 6 * D;
constexpr int LK = SEQ + CTXL;
constexpr float NORM_EPS = 1e-6f;
constexpr int NWAVES = 8, NTHREADS = 512;
constexpr int N_PHASES = 1 + 9 + 7 + 8 + 9 + 1;

constexpr size_t MiB = 1u << 20;
constexpr size_t WS_CTL = 0, CTL_ZERO_BYTES = 1 * MiB;
constexpr size_t WS_MOD = 1 * MiB;
constexpr size_t WS_HDN = 2 * MiB;
constexpr size_t WS_KFC = 11 * MiB;
constexpr size_t WS_VTC = 15 * MiB;
constexpr size_t WS_XRES = 17 * MiB;
constexpr size_t WS_A = 277 * MiB;
constexpr size_t WS_Z = 407 * MiB;
constexpr size_t WS_W = 797 * MiB, W_SLOT = 98 * MiB;
constexpr size_t WO_GU = 0, WO_D = 44 * MiB, WO_IN = 66 * MiB, WO_OUT = 90 * MiB;
constexpr size_t WS_VT = 895 * MiB;
constexpr size_t WS_KF = 1023 * MiB;
constexpr size_t WS_KALL = WS_Z + 200 * MiB, WS_VALL = WS_Z + 240 * MiB;
constexpr size_t WS_SLAB = WS_KF + 128 * MiB;
constexpr size_t WS_KSP = 1279 * MiB;
constexpr size_t WS_W1 = 1319 * MiB;
constexpr size_t WS_END = 1515 * MiB;
__host__ __device__ constexpr size_t w_slot_off(int layer) { return layer == 1 ? WS_W1 : (layer == 2 ? WS_W1 + W_SLOT : WS_W); }
constexpr int CW_BAR = 1024;

__device__ __forceinline__ float bf2f(unsigned short b) { return __uint_as_float(((unsigned)b) << 16); }
__device__ __forceinline__ float bflo(unsigned w) { return __uint_as_float(w << 16); }
__device__ __forceinline__ float bfhi(unsigned w) { return __uint_as_float(w & 0xffff0000u); }
__device__ __forceinline__ unsigned cvt_pk_bf16(float lo, float hi) { unsigned r; asm volatile("v_cvt_pk_bf16_f32 %0, %1, %2" : "=v"(r) : "v"(lo), "v"(hi)); return r; }
__device__ __forceinline__ float wave_sum(float v) {
    v += __int_as_float(__builtin_amdgcn_update_dpp(0, __float_as_int(v), 0xB1, 0xf, 0xf, true));
    v += __int_as_float(__builtin_amdgcn_update_dpp(0, __float_as_int(v), 0x4E, 0xf, 0xf, true));
    v += __int_as_float(__builtin_amdgcn_update_dpp(0, __float_as_int(v), 0x124, 0xf, 0xf, true));
    v += __int_as_float(__builtin_amdgcn_update_dpp(0, __float_as_int(v), 0x128, 0xf, 0xf, true));
    const int i = __float_as_int(v);
    return (__int_as_float(__builtin_amdgcn_readlane(i, 0)) + __int_as_float(__builtin_amdgcn_readlane(i, 16))) + (__int_as_float(__builtin_amdgcn_readlane(i, 32)) + __int_as_float(__builtin_amdgcn_readlane(i, 48)));
}
__device__ __forceinline__ float wave_max(float v) {
    v = fmaxf(v, __int_as_float(__builtin_amdgcn_update_dpp(0, __float_as_int(v), 0xB1, 0xf, 0xf, true)));
    v = fmaxf(v, __int_as_float(__builtin_amdgcn_update_dpp(0, __float_as_int(v), 0x4E, 0xf, 0xf, true)));
    v = fmaxf(v, __int_as_float(__builtin_amdgcn_update_dpp(0, __float_as_int(v), 0x124, 0xf, 0xf, true)));
    v = fmaxf(v, __int_as_float(__builtin_amdgcn_update_dpp(0, __float_as_int(v), 0x128, 0xf, 0xf, true)));
    const int i = __float_as_int(v);
    return fmaxf(fmaxf(__int_as_float(__builtin_amdgcn_readlane(i, 0)), __int_as_float(__builtin_amdgcn_readlane(i, 16))), fmaxf(__int_as_float(__builtin_amdgcn_readlane(i, 32)), __int_as_float(__builtin_amdgcn_readlane(i, 48))));
}
__device__ __forceinline__ float lane_bcast(float v, int k) { return __int_as_float(__builtin_amdgcn_readlane(__float_as_int(v), k)); }
#define LDS_WAIT() asm volatile("s_waitcnt lgkmcnt(0)" ::: "memory")
#define VM_WAIT() asm volatile("s_waitcnt vmcnt(0)" ::: "memory")
#define XB_TMO      128
#define XB_XCNT(j)  (256  + 64 * (j))
#define XB_XSUB(j)  (1280 + 64 * (j))
#define XB_XGEN(j)  (2304 + 64 * (j))
#define XB_TOP      3328
#define XB_TOPGEN   3392
#define XCD_BAR_WORDS 3456
#define XB_SPIN_CAP (1u << 18)

__device__ __forceinline__ unsigned xb_ld(unsigned* p)              { return __hip_atomic_load(p, __ATOMIC_RELAXED, __HIP_MEMORY_SCOPE_AGENT); }
__device__ __forceinline__ unsigned xb_add(unsigned* p, unsigned v) { return __hip_atomic_fetch_add(p, v, __ATOMIC_RELAXED, __HIP_MEMORY_SCOPE_AGENT); }
__device__ __forceinline__ unsigned xb_xcc_id() { return (unsigned)__builtin_amdgcn_s_getreg((3 << 11) | 20) & 0xFu; }
#define XB_SPIN(cond, bar) do { unsigned _sp = 0; while (cond) { __builtin_amdgcn_s_sleep(1); \
    if ((++_sp & 255u) == 0u) { if (xb_ld(&(bar)[XB_TMO])) break; if (_sp > XB_SPIN_CAP) { atomicAdd(&(bar)[XB_TMO], 1u); break; } } } } while (0)

struct XcdBarrier {
    unsigned* bar; unsigned x;
    volatile LAS unsigned* st;
};

__device__ __forceinline__ XcdBarrier xcd_barrier_post(unsigned* bar, volatile LAS unsigned* st) {
    XcdBarrier b; b.bar = bar; b.x = xb_xcc_id(); b.st = st;
    if (threadIdx.x == 0) (void)xb_add(&bar[XB_XCNT(b.x)], 1u);
    return b;
}
__device__ __forceinline__ void xcd_barrier_complete(unsigned* bar, unsigned x, unsigned& nloc, unsigned& nx) {
    const unsigned G = gridDim.x * gridDim.y * gridDim.z;
    unsigned sum, cnt, mine, sp = 0u;
    for (;;) {
        sum = 0u; cnt = 0u; mine = 0u;
#pragma unroll
        for (unsigned j = 0; j < 16; ++j) { const unsigned c = xb_ld(&bar[XB_XCNT(j)]); sum += c; cnt += (c > 0u) ? 1u : 0u; mine = (j == x) ? c : mine; }
        if (sum == G) break;
        __builtin_amdgcn_s_sleep(1);
        if ((++sp & 255u) == 0u) { if (xb_ld(&bar[XB_TMO])) break; if (sp > XB_SPIN_CAP) { atomicAdd(&bar[XB_TMO], 1u); break; } }
    }
    nloc = mine > 0u ? mine : 1u; nx = cnt > 0u ? cnt : 1u;
}

__device__ __forceinline__ void xcd_barrier(const XcdBarrier& b) {
    asm volatile("s_waitcnt vmcnt(0)" ::: "memory");
    __syncthreads();
    if (threadIdx.x == 0) {
        unsigned* bar = b.bar;
        __builtin_amdgcn_s_waitcnt(0);
        unsigned nloc = b.st[0], nx = b.st[1];
        if (nloc == 0u) { xcd_barrier_complete(bar, b.x, nloc, nx); b.st[0] = nloc; b.st[1] = nx; }
        const unsigned old = xb_add(&bar[XB_XSUB(b.x)], 1u);
        const unsigned gen = old / nloc;
        if (old + 1u == (gen + 1u) * nloc) {
            __builtin_amdgcn_fence(__ATOMIC_RELEASE, "agent");
            asm volatile("s_waitcnt vmcnt(0)" ::: "memory");
            const unsigned og = xb_add(&bar[XB_TOP], 1u);
            const unsigned tg = og / nx;
            if (og + 1u == (tg + 1u) * nx) xb_add(&bar[XB_TOPGEN], 1u);
            else XB_SPIN(xb_ld(&bar[XB_TOPGEN]) == tg, bar);
            __builtin_amdgcn_fence(__ATOMIC_ACQUIRE, "agent");
            xb_add(&bar[XB_XGEN(b.x)], 1u);
            asm volatile("s_waitcnt vmcnt(0)" ::: "memory");
        } else {
            XB_SPIN(xb_ld(&bar[XB_XGEN(b.x)]) == gen, bar);
            __builtin_amdgcn_fence(__ATOMIC_ACQUIRE, "agent");
            asm volatile("s_waitcnt vmcnt(0)" ::: "memory");
        }
    }
    __syncthreads();
}
namespace pg8 {
#define PG8_LAS __attribute__((address_space(3)))
typedef unsigned short bf16_t;
typedef short bf16x8 __attribute__((ext_vector_type(8)));
typedef float f32x4 __attribute__((ext_vector_type(4)));
typedef unsigned u32x4 __attribute__((ext_vector_type(4)));
constexpr int BM = 256, BK = 64, HALF = 128, HTB = HALF * BK * 2  , STAGE_BYTES = 8 * HTB, NXCD = 8, WGM = 8;

__host__ __device__ __forceinline__ int lds_byte(int r, int c) { const int st = (r >> 4) * 2 + (c >> 5), rr = r & 15, cc = c & 31, ob = rr * 64 + cc * 2; return st * 1024 + (ob ^ (((ob >> 9) & 1) << 5)); }
__host__ __device__ __forceinline__ void stage_rc(int b, int& R, int& C) { const int st = b / 1024, sb = b % 1024, swz = sb ^ (((sb >> 9) & 1) << 5); R = (st >> 1) * 16 + swz / 64; C = (st & 1) * 32 + (swz % 64) / 2; }
__host__ __device__ __forceinline__ int perm32(int rho) { const int n = rho >> 4, i = rho & 15; return 8 * (i >> 2) + 4 * n + (i & 3); }

struct Unit { int pm, pn, kc; };
struct Gemm { const bf16_t* A; const bf16_t* Bt; int M, N, K, ldk; };

struct StaticOrder {
    int nM, nN, nwg, G, c; float inv_nig;
    __host__ __device__ void init(int M, int N, int G_, int c_) { nM = M / BM; nN = N / BM; nwg = nM * nN; G = G_; c = c_; inv_nig = 1.0f / (float)(WGM * nN); }
    __host__ __device__ bool next(int i, Unit& u) const {
        const int L = i * G + c; if (L >= nwg) return false;
        int wgid = L; { const int q = nwg >> 3, r = nwg & 7, xcd = wgid & 7, off = wgid >> 3; wgid = (xcd < r ? xcd * (q + 1) : r * (q + 1) + (xcd - r) * q) + off; }
        const int nig = WGM * nN, gid = (int)(((float)wgid + 0.5f) * inv_nig), rem = wgid - gid * nig, fm = gid * WGM, gsz = (nM - fm) < WGM ? (nM - fm) : WGM;
        if (gsz == WGM) { u.pm = fm + (rem & 7); u.pn = rem >> 3; }
        else { const int pn = (int)(((float)rem + 0.5f) / (float)gsz); u.pm = fm + rem - pn * gsz; u.pn = pn; }
        u.kc = 0; return true;
    }
    __device__ __forceinline__ void a_ready(const Unit&) const {}
    __device__ __forceinline__ void done(const Unit&) const {}
};
struct CtxSplitOrder {
    int nN, ks, G, c;
    __host__ __device__ void init(int N, int ks_, int G_, int c_) { nN = N / BM; ks = ks_; G = G_; c = c_; }
    __host__ __device__ bool next(int i, Unit& u) const { const int l = i * G + c; if (l >= 2 * nN * ks) return false;
        const int kc = (int)(((float)l + 0.5f) / (float)(2 * nN)), rem = l - kc * 2 * nN, hi = rem >= nN ? 1 : 0; u.kc = kc; u.pm = 128 + hi; u.pn = rem - hi * nN; return true; }
    __device__ __forceinline__ void a_ready(const Unit&) const {}
    __device__ __forceinline__ void done(const Unit&) const {}
};
struct EpiStoreBf16 {
    static constexpr bool PERM = true, AFTER_DRAIN = false; static constexpr int TW = 1;
    bf16_t* O; int ldc; const float* bias;
    __device__ __forceinline__ void operator()(const f32x4 (&acc)[2][2][4][2], const Unit& u, int wr, int wc, int fr, int fq) const {
        const int row0 = u.pm * BM + wr * 64 + fr, col0 = u.pn * BM + wc * 32 + 8 * fq;
        f32x4 bv[2][2];
#pragma unroll
        for (int bj = 0; bj < 2; ++bj)
#pragma unroll
            for (int n = 0; n < 2; ++n) bv[bj][n] = bias ? *(const f32x4*)(bias + col0 + bj * HALF + 4 * n) : (f32x4){0.f, 0.f, 0.f, 0.f};
#pragma unroll
        for (int ai = 0; ai < 2; ++ai)
#pragma unroll
            for (int m = 0; m < 4; ++m) { bf16_t* rowp = O + (size_t)(row0 + ai * HALF + m * 16) * ldc + col0;
#pragma unroll
                for (int bj = 0; bj < 2; ++bj) { const f32x4 v0 = acc[ai][bj][m][0] + bv[bj][0], v1 = acc[ai][bj][m][1] + bv[bj][1];
                    u32x4 w; w.x = cvt_pk_bf16(v0[0], v0[1]); w.y = cvt_pk_bf16(v0[2], v0[3]); w.z = cvt_pk_bf16(v1[0], v1[1]); w.w = cvt_pk_bf16(v1[2], v1[3]);
                    *(u32x4*)(rowp + bj * HALF) = w; } }
    }
};
__device__ __forceinline__ float silu_mul(float g, float u) { return g * u * __builtin_amdgcn_rcpf(1.0f + __builtin_amdgcn_exp2f(-1.4426950408889634f * g)); }
struct EpiSwiGLU {
    static constexpr bool PERM = true, AFTER_DRAIN = false; static constexpr int TW = 2;
    bf16_t* O; int ldc;
    __device__ __forceinline__ void operator()(const f32x4 (&acc)[2][2][4][2], const Unit& u, int wr, int wc, int fr, int fq) const {
        const int row0 = u.pm * BM + wr * 64 + fr, col0 = u.pn * HALF + wc * 32 + 8 * fq;
#pragma unroll
        for (int ai = 0; ai < 2; ++ai)
#pragma unroll
            for (int m = 0; m < 4; ++m) {
                const f32x4 g0 = acc[ai][0][m][0], g1 = acc[ai][0][m][1], u0 = acc[ai][1][m][0], u1 = acc[ai][1][m][1];
                u32x4 w;
                w.x = cvt_pk_bf16(silu_mul(g0[0], u0[0]), silu_mul(g0[1], u0[1])); w.y = cvt_pk_bf16(silu_mul(g0[2], u0[2]), silu_mul(g0[3], u0[3]));
                w.z = cvt_pk_bf16(silu_mul(g1[0], u1[0]), silu_mul(g1[1], u1[1])); w.w = cvt_pk_bf16(silu_mul(g1[2], u1[2]), silu_mul(g1[3], u1[3]));
                *(u32x4*)(O + (size_t)(row0 + ai * HALF + m * 16) * ldc + col0) = w; }
    }
};
struct EpiResid {
    static constexpr bool PERM = true, AFTER_DRAIN = false; static constexpr int TW = 3;
    const float* base32_lat; const float* base32_ctx; bf16_t* xres; const float* bias; const float* gate;
    __device__ __forceinline__ void operator()(const f32x4 (&acc)[2][2][4][2], const Unit& u, int wr, int wc, int fr, int fq) const {
        int rin0 = wr * 64 + fr; asm volatile("" : "+v"(rin0));
        const int col0 = u.pn * BM + wc * 32 + 8 * fq;
        const int cond = u.pm < 64 ? 0 : (u.pm < 128 ? 1 : 2);
        bf16_t* op = xres + (size_t)u.pm * BM * 2048 + col0;
        const float* gp = gate + cond * 12288 + col0;
        if (RESID_NUP && !base32_lat && !bias) {
            constexpr int NUP = RESID_NUP ? RESID_NUP : 1;
            u32x4 b[NUP][2];
#pragma unroll
            for (int am = 0; am < NUP; ++am)
#pragma unroll
                for (int bj = 0; bj < 2; ++bj) b[am][bj] = *(const u32x4*)(op + (size_t)(rin0 + (am >> 2) * HALF + (am & 3) * 16) * 2048 + bj * HALF);
            f32x4 gv[2][2];
#pragma unroll
            for (int bj = 0; bj < 2; ++bj)
#pragma unroll
                for (int n = 0; n < 2; ++n) gv[bj][n] = *(const f32x4*)(gp + bj * HALF + 4 * n);
            asm volatile("" ::: "memory");
#pragma unroll
            for (int am = 0; am < 8; ++am) { const int ai = am >> 2, m = am & 3, sl = am < NUP ? am : am - NUP;
#pragma unroll
                for (int bj = 0; bj < 2; ++bj) { const u32x4 bb = b[sl][bj];
                    const f32x4 b0 = {bflo(bb.x), bfhi(bb.x), bflo(bb.y), bfhi(bb.y)}, b1 = {bflo(bb.z), bfhi(bb.z), bflo(bb.w), bfhi(bb.w)};
                    const f32x4 v0 = b0 + gv[bj][0] * acc[ai][bj][m][0], v1 = b1 + gv[bj][1] * acc[ai][bj][m][1];
                    u32x4 w; w.x = cvt_pk_bf16(v0[0], v0[1]); w.y = cvt_pk_bf16(v0[2], v0[3]); w.z = cvt_pk_bf16(v1[0], v1[1]); w.w = cvt_pk_bf16(v1[2], v1[3]);
                    *(u32x4*)(op + (size_t)(rin0 + ai * HALF + m * 16) * 2048 + bj * HALF) = w; }
                if (am + NUP < 8) { const int an = am + NUP; asm volatile("" ::: "memory");
#pragma unroll
                    for (int bj = 0; bj < 2; ++bj) b[am][bj] = *(const u32x4*)(op + (size_t)(rin0 + (an >> 2) * HALF + (an & 3) * 16) * 2048 + bj * HALF); }
            }
            return;
        }
        f32x4 gv[2][2], bv[2][2];
#pragma unroll
        for (int bj = 0; bj < 2; ++bj)
#pragma unroll
            for (int n = 0; n < 2; ++n) { gv[bj][n] = *(const f32x4*)(gp + bj * HALF + 4 * n); bv[bj][n] = bias ? *(const f32x4*)(bias + col0 + bj * HALF + 4 * n) : (f32x4){0.f, 0.f, 0.f, 0.f}; }
        if (base32_lat) {
            const float* bp = (u.pm < 128 ? base32_lat + (size_t)u.pm * BM * 2048 : base32_ctx + (size_t)(u.pm - 128) * BM * 2048) + col0;
#pragma unroll
            for (int am = 0; am < 8; ++am) { const int ai = am >> 2, m = am & 3; const size_t ro = (size_t)(rin0 + ai * HALF + m * 16) * 2048;
                f32x4 b[2][2];
#pragma unroll
                for (int bj = 0; bj < 2; ++bj)
#pragma unroll
                    for (int n = 0; n < 2; ++n) b[bj][n] = *(const f32x4*)(bp + ro + bj * HALF + 4 * n);
#pragma unroll
                for (int bj = 0; bj < 2; ++bj) { const f32x4 v0 = b[bj][0] + gv[bj][0] * (acc[ai][bj][m][0] + bv[bj][0]), v1 = b[bj][1] + gv[bj][1] * (acc[ai][bj][m][1] + bv[bj][1]);
                    u32x4 w; w.x = cvt_pk_bf16(v0[0], v0[1]); w.y = cvt_pk_bf16(v0[2], v0[3]); w.z = cvt_pk_bf16(v1[0], v1[1]); w.w = cvt_pk_bf16(v1[2], v1[3]);
                    *(u32x4*)(op + ro + bj * HALF) = w; }
                asm volatile("" ::: "memory"); }
        } else {
            u32x4 b[2][2], bn[2][2];
#pragma unroll
            for (int mm = 0; mm < 2; ++mm)
#pragma unroll
                for (int bj = 0; bj < 2; ++bj) b[mm][bj] = *(const u32x4*)(op + (size_t)(rin0 + mm * 16) * 2048 + bj * HALF);
#pragma unroll
            for (int am = 0; am < 4; ++am) { const int ai = am >> 1, m0 = (am & 1) * 2;
                if (am < 3) { const int ain = (am + 1) >> 1, m0n = ((am + 1) & 1) * 2;
#pragma unroll
                    for (int mm = 0; mm < 2; ++mm)
#pragma unroll
                        for (int bj = 0; bj < 2; ++bj) bn[mm][bj] = *(const u32x4*)(op + (size_t)(rin0 + ain * HALF + (m0n + mm) * 16) * 2048 + bj * HALF); }
#pragma unroll
                for (int mm = 0; mm < 2; ++mm)
#pragma unroll
                    for (int bj = 0; bj < 2; ++bj) { const u32x4 bb = b[mm][bj]; const int m = m0 + mm;
                        const f32x4 b0 = {bflo(bb.x), bfhi(bb.x), bflo(bb.y), bfhi(bb.y)}, b1 = {bflo(bb.z), bfhi(bb.z), bflo(bb.w), bfhi(bb.w)};
                        const f32x4 v0 = b0 + gv[bj][0] * (acc[ai][bj][m][0] + bv[bj][0]), v1 = b1 + gv[bj][1] * (acc[ai][bj][m][1] + bv[bj][1]);
                        u32x4 w; w.x = cvt_pk_bf16(v0[0], v0[1]); w.y = cvt_pk_bf16(v0[2], v0[3]); w.z = cvt_pk_bf16(v1[0], v1[1]); w.w = cvt_pk_bf16(v1[2], v1[3]);
                        *(u32x4*)(op + (size_t)(rin0 + ai * HALF + m * 16) * 2048 + bj * HALF) = w; }
                asm volatile("" ::: "memory");
#pragma unroll
                for (int mm = 0; mm < 2; ++mm)
#pragma unroll
                    for (int bj = 0; bj < 2; ++bj) b[mm][bj] = bn[mm][bj];
            }
        }
    }
};
struct EpiSlab {
    static constexpr bool PERM = false, AFTER_DRAIN = false; static constexpr int TW = 4;
    float* slab;
    __device__ __forceinline__ void operator()(const f32x4 (&acc)[2][2][4][2], const Unit& u, int wr, int wc, int fr, int fq) const {
        float* op = slab + ((size_t)u.kc * 512 + (u.pm - 128) * BM + wr * 64 + fr) * 2048 + u.pn * BM + wc * 32 + 4 * fq;
#pragma unroll
        for (int ai = 0; ai < 2; ++ai)
#pragma unroll
            for (int m = 0; m < 4; ++m)
#pragma unroll
                for (int bj = 0; bj < 2; ++bj)
#pragma unroll
                    for (int n = 0; n < 2; ++n) *(f32x4*)(op + (size_t)(ai * HALF + m * 16) * 2048 + bj * HALF + n * 16) = acc[ai][bj][m][n];
    }
};
template <class Epi, class Sched, bool STAMP = false>
__device__ __forceinline__ void gemm_phase(PG8_LAS unsigned char* lds, const Gemm g, const Sched& S, const Epi& E, unsigned long long* stamps) {
    int tid_ = threadIdx.x; asm volatile("" : "+v"(tid_));
    const int tid = tid_, wid = __builtin_amdgcn_readfirstlane(tid >> 6), lane = tid & 63, wr = wid >> 2, wc = wid & 3, fr = lane & 15, fq = lane >> 4;
    const int K = g.ldk  , nt = g.K / BK; const size_t kchunk = (size_t)g.K * 2;
    int ts_lo = 0, ts_hi = 0, nts = 0; const unsigned long long rt_entry = STAMP ? (unsigned long long)wall_clock64() : 0ull;
#define PG8_STAMP() do { if (STAMP && wid == 0 && nts < 64) { const unsigned long long _c = (unsigned long long)clock64(); \
        ts_lo = (lane == nts) ? (int)(unsigned)_c : ts_lo; ts_hi = (lane == nts) ? (int)(unsigned)(_c >> 32) : ts_hi; ++nts; } } while (0)
    PG8_STAMP();
    unsigned voffA[2], voffB[2];
#pragma unroll
    for (int i = 0; i < 2; ++i) { int R, C; stage_rc(tid * 16 + i * 8192, R, C); const int Rb = Epi::PERM ? ((R & ~31) + perm32(R & 31)) : R;
        voffA[i] = (unsigned)(R * K + C) * 2u; voffB[i] = (unsigned)(Rb * K + C) * 2u; }
    const size_t kstep = (size_t)(BK * 2);
    const size_t hstep = (size_t)HALF * K * 2;
    const size_t tstep = 2 * hstep;
    const unsigned ldsw = (unsigned)wid * 1024u;
    const int aoff = lds_byte(wr * 64 + fr, fq * 8), boff = lds_byte(wc * 32 + fr, fq * 8);
#define PG8_SA(b, h) (((b) * 2 + (h)) * HTB)
#define PG8_SB(b, h) ((4 + (b) * 2 + (h)) * HTB)
#define PG8_STAGE(bufoff, gbase, voff) do { _Pragma("unroll") for (int _i = 0; _i < 2; ++_i) \
        __builtin_amdgcn_global_load_lds((const unsigned*)((const char*)(gbase) + (voff)[_i]), (PG8_LAS unsigned*)(lds + (bufoff) + ldsw + _i * 8192), 16, 0, 0); } while (0)
#define PG8_LDA(dst, b, h) do { _Pragma("unroll") for (int m = 0; m < 4; ++m) _Pragma("unroll") for (int k = 0; k < 2; ++k) dst[m][k] = *(const PG8_LAS bf16x8*)(lds + PG8_SA(b, h) + aoff + m * 2048 + k * 1024); } while (0)
#define PG8_LDB(dst, b, h) do { _Pragma("unroll") for (int n = 0; n < 2; ++n) _Pragma("unroll") for (int k = 0; k < 2; ++k) dst[n][k] = *(const PG8_LAS bf16x8*)(lds + PG8_SB(b, h) + boff + n * 2048 + k * 1024); } while (0)
#define PG8_MMA(ai, bj, At, Bt) do { __builtin_amdgcn_s_setprio(1); _Pragma("unroll") for (int m = 0; m < 4; ++m) _Pragma("unroll") for (int n = 0; n < 2; ++n) _Pragma("unroll") for (int k = 0; k < 2; ++k) \
        acc[ai][bj][m][n] = __builtin_amdgcn_mfma_f32_16x16x32_bf16(Bt[n][k], At[m][k], acc[ai][bj][m][n], 0, 0, 0); __builtin_amdgcn_s_setprio(0); } while (0)
#define PG8_WAIT_V(n) asm volatile("s_waitcnt vmcnt(" #n ")" ::: "memory")
#define PG8_WAIT_L(n) asm volatile("s_waitcnt lgkmcnt(" #n ")" ::: "memory")
#define PG8_BAR __builtin_amdgcn_s_barrier()
#define PG8_SCHED __builtin_amdgcn_sched_barrier(0)
    Unit cur, nxt; int ui = 0;
    if (!S.next(0, cur)) return;
#if SEGPROBE
    unsigned sp_acc = 0, sp_t0 = 0; constexpr bool SPON = (Epi::TW == SEG_EPI);
#define SP_BEGIN(seg) do { if (SPON && SEGPROBE == (seg)) sp_t0 = __builtin_amdgcn_readfirstlane((unsigned)__builtin_amdgcn_s_memrealtime()); } while (0)
#define SP_END(seg) do { if (SPON && SEGPROBE == (seg)) sp_acc = __builtin_amdgcn_readfirstlane(sp_acc + ((unsigned)__builtin_amdgcn_s_memrealtime() - sp_t0)); } while (0)
#else
#define SP_BEGIN(seg) do {} while (0)
#define SP_END(seg) do {} while (0)
#endif
    SP_BEGIN(7); SP_BEGIN(9);
    f32x4 acc[2][2][4][2];
#pragma unroll
    for (int a = 0; a < 2; ++a)
#pragma unroll
        for (int b = 0; b < 2; ++b)
#pragma unroll
            for (int m = 0; m < 4; ++m)
#pragma unroll
                for (int n = 0; n < 2; ++n) acc[a][b][m][n] = (f32x4){0.f, 0.f, 0.f, 0.f};
    bf16x8 At[4][2], B0[2][2], B1[2][2];
    const char* cA = (const char*)g.A + (size_t)cur.pm * tstep + cur.kc * kchunk; const char* cB = (const char*)g.Bt + (size_t)cur.pn * tstep + cur.kc * kchunk;
    S.a_ready(cur);
    PG8_STAGE(PG8_SB(0, 0), cB, voffB); PG8_STAGE(PG8_SA(0, 0), cA, voffA); PG8_STAGE(PG8_SB(0, 1), cB + hstep, voffB); PG8_STAGE(PG8_SA(0, 1), cA + hstep, voffA);
    if (wr == 1) PG8_BAR;
    PG8_WAIT_V(4); PG8_BAR;
    PG8_STAGE(PG8_SB(1, 0), cB + kstep, voffB); PG8_STAGE(PG8_SA(1, 0), cA + kstep, voffA); PG8_STAGE(PG8_SB(1, 1), cB + hstep + kstep, voffB);
    PG8_WAIT_V(6); PG8_BAR;
    PG8_STAMP(); SP_END(7);
    for (;;) {
        const bool has_next = S.next(ui + 1, nxt);
        const char* nA = has_next ? (const char*)g.A + (size_t)nxt.pm * tstep + nxt.kc * kchunk : cA; const char* nB = has_next ? (const char*)g.Bt + (size_t)nxt.pn * tstep + nxt.kc * kchunk : cB;
        if (ui > 0) SP_END(6);
        SP_BEGIN(5);
        for (int t = 0; t < nt; t += 2) {
            const bool last = (t == nt - 2);
            const char* a1 = cA + (size_t)(t + 1) * kstep;
            const char* a2 = last ? nA : cA + (size_t)(t + 2) * kstep; const char* b2 = last ? nB : cB + (size_t)(t + 2) * kstep;
            const char* a3 = a2 + kstep; const char* b3 = b2 + kstep;
            if (last && has_next) S.a_ready(nxt);
            if (last) SP_BEGIN(4);
            PG8_LDB(B0, 0, 0); PG8_SCHED; PG8_LDA(At, 0, 0); PG8_STAGE(PG8_SA(1, 1), a1 + hstep, voffA);
            PG8_WAIT_L(8); PG8_BAR; PG8_WAIT_L(0); PG8_MMA(0, 0, At, B0); PG8_BAR; PG8_SCHED;
            PG8_LDB(B1, 0, 1); PG8_STAGE(PG8_SB(0, 0), b2, voffB);
            PG8_BAR; PG8_WAIT_L(0); PG8_MMA(0, 1, At, B1); PG8_BAR;
            PG8_LDA(At, 0, 1); PG8_STAGE(PG8_SA(0, 0), a2, voffA);
            PG8_BAR; PG8_WAIT_L(0); PG8_MMA(1, 0, At, B0); PG8_BAR; PG8_SCHED;
            PG8_STAGE(PG8_SB(0, 1), b2 + hstep, voffB);
            PG8_WAIT_V(6); PG8_BAR; PG8_MMA(1, 1, At, B1); PG8_BAR;
            PG8_LDB(B0, 1, 0); PG8_SCHED; PG8_LDA(At, 1, 0); PG8_STAGE(PG8_SA(0, 1), a2 + hstep, voffA);
            PG8_WAIT_L(8); PG8_BAR; PG8_WAIT_L(0); PG8_MMA(0, 0, At, B0); PG8_BAR; PG8_SCHED;
            PG8_LDB(B1, 1, 1); PG8_STAGE(PG8_SB(1, 0), b3, voffB);
            PG8_BAR; PG8_WAIT_L(0); PG8_MMA(0, 1, At, B1); PG8_BAR;
            PG8_LDA(At, 1, 1); PG8_STAGE(PG8_SA(1, 0), a3, voffA);
            PG8_BAR; PG8_WAIT_L(0); PG8_MMA(1, 0, At, B0); PG8_BAR; PG8_SCHED;
            PG8_STAGE(PG8_SB(1, 1), b3 + hstep, voffB);
            PG8_WAIT_V(6); PG8_BAR; PG8_MMA(1, 1, At, B1); PG8_BAR;
            if (last) SP_END(4);
        }
        PG8_STAMP(); SP_END(5); SP_BEGIN(1);
        if constexpr (!Epi::AFTER_DRAIN) { E(acc, cur, wr, wc, fr, fq); S.done(cur); }
#if EPI_TWICE
        if constexpr ((EPI_TWICE >> Epi::TW) & 1) { asm volatile("" ::: "memory"); E(acc, cur, wr, wc, fr, fq); }
#endif
        PG8_STAMP(); SP_END(1); SP_BEGIN(6);
        if (!has_next) { SP_BEGIN(8); break; }
#pragma unroll
        for (int a = 0; a < 2; ++a)
#pragma unroll
            for (int b = 0; b < 2; ++b)
#pragma unroll
                for (int m = 0; m < 4; ++m)
#pragma unroll
                    for (int n = 0; n < 2; ++n) acc[a][b][m][n] = (f32x4){0.f, 0.f, 0.f, 0.f};
        cur = nxt; cA = nA; cB = nB; ++ui;
    }
    PG8_WAIT_V(0);
    if (wr == 0) PG8_BAR;
    PG8_BAR;
#if SEGPROBE
    SP_END(8); SP_END(9);
    if (SPON) { const unsigned long long t1 = __builtin_amdgcn_s_memrealtime(); while (__builtin_amdgcn_s_memrealtime() - t1 < (unsigned long long)SEG_AMP * sp_acc) __builtin_amdgcn_s_sleep(8); }
#endif
#undef SP_BEGIN
#undef SP_END
    if constexpr (Epi::AFTER_DRAIN) { E.fused(acc, cur, wr, wc, fr, fq, lds, wid, lane); S.done(cur); }
    PG8_STAMP();
    if (STAMP && wid == 0) { stamps[lane] = lane < nts ? (((unsigned long long)(unsigned)ts_hi << 32) | (unsigned)ts_lo) : 0ull;
        if (lane == 62) stamps[62] = rt_entry; if (lane == 63) stamps[63] = (unsigned long long)wall_clock64(); }
#undef PG8_STAMP
#undef PG8_SA
#undef PG8_SB
#undef PG8_STAGE
#undef PG8_LDA
#undef PG8_LDB
#undef PG8_MMA
#undef PG8_WAIT_V
#undef PG8_WAIT_L
#undef PG8_BAR
#undef PG8_SCHED
}
}
namespace att {
using bf16 = unsigned short;
constexpr int D = 128, NW = 8, QBLK = 32, KVBLK = 64;
constexpr float SCALE = 0.088388347648318440f;
constexpr float THR = 8.f;
constexpr int SDEPTH = 2;
constexpr int LDQ = 2048, LDK = 128, LDO = 2048;
constexpr int NBUF = 3;
constexpr size_t SHM_V = KVBLK * D * 2, SHM_K = KVBLK * D * 2, SHM_ATTN = NBUF * SHM_V + NBUF * SHM_K + NW * 64 * 4;
using bf16x8 = __attribute__((ext_vector_type(8))) short;
using s16x4  = __attribute__((ext_vector_type(4))) short;
using f32x16 = __attribute__((ext_vector_type(16))) float;
using f32x8  = __attribute__((ext_vector_type(8))) float;
using u32x4  = __attribute__((ext_vector_type(4))) unsigned;
#define KSWZ(row, colB) ((row) * 256 + ((colB) ^ (((row) & 7) << 4)))
#define SBAR() __builtin_amdgcn_sched_barrier(0)
__device__ __forceinline__ int crow(int r, int hi) { return (r & 3) + 8 * (r >> 2) + 4 * hi; }
typedef __bf16 bf16x2_t __attribute__((ext_vector_type(2)));
typedef float f32x2_t __attribute__((ext_vector_type(2)));
__device__ __forceinline__ unsigned cvtpk(float lo, float hi) {
  return __builtin_bit_cast(unsigned, __builtin_convertvector((f32x2_t){lo, hi}, bf16x2_t));
}
template <typename TIn> struct Stage;
template <> struct Stage<bf16>  { using T = bf16x8;
  __device__ static __forceinline__ T ld8(const bf16* p) { return *reinterpret_cast<const bf16x8*>(p); }
  __device__ static __forceinline__ bf16x8 tobf(T x) { return x; } };
template <> struct Stage<float> { using T = f32x8;
  __device__ static __forceinline__ T ld8(const float* p) { return *reinterpret_cast<const f32x8*>(p); }
  __device__ static __forceinline__ bf16x8 tobf(T x) {
    u32x4 w = {cvtpk(x[0], x[1]), cvtpk(x[2], x[3]), cvtpk(x[4], x[5]), cvtpk(x[6], x[7])}; return *reinterpret_cast<bf16x8*>(&w); } };

template <bool NOMAX>
__device__ __forceinline__ void partialSM(f32x16& p0, f32x16& p1, float& m_reg, float& mn, float& alpha) {
  if constexpr (!NOMAX) {
    float pmax = p0[0]; for (int r = 1; r < 16; ++r) pmax = fmaxf(pmax, p0[r]); for (int r = 0; r < 16; ++r) pmax = fmaxf(pmax, p1[r]);
    { auto rr = __builtin_amdgcn_permlane32_swap(__float_as_uint(pmax), __float_as_uint(pmax), false, false);
      pmax = fmaxf(__uint_as_float(rr[0]), __uint_as_float(rr[1])); }
    if (__builtin_expect(__all(pmax - m_reg <= THR * 1.4426950408889634f), 1)) { mn = m_reg; alpha = 1.f; }
    else { mn = fmaxf(m_reg, pmax); alpha = __builtin_amdgcn_exp2f(m_reg - mn); m_reg = mn; }
    for (int r = 0; r < 16; ++r) p0[r] -= mn; for (int r = 0; r < 16; ++r) p1[r] -= mn;
  }
  for (int r = 0; r < 16; ++r) p0[r] = __builtin_amdgcn_exp2f(p0[r]);
}
template <bool NOMAX>
__device__ __forceinline__ void finishSM(f32x16& p0, f32x16& p1, float alpha, float& l_reg, bf16x8& pa0, bf16x8& pa1, bf16x8& pa2, bf16x8& pa3) {
  for (int r = 0; r < 16; ++r) p1[r] = __builtin_amdgcn_exp2f(p1[r]);
  float ps = 0; for (int r = 0; r < 16; ++r) ps += p0[r]; for (int r = 0; r < 16; ++r) ps += p1[r];
  { auto rr = __builtin_amdgcn_permlane32_swap(__float_as_uint(ps), __float_as_uint(ps), false, false);
    ps = __uint_as_float(rr[0]) + __uint_as_float(rr[1]); }
  if constexpr (NOMAX) l_reg += ps; else l_reg = l_reg * alpha + ps;
#define PK4(P, BASE, OUT) do { unsigned a0 = cvtpk(P[BASE + 0], P[BASE + 1]), a1 = cvtpk(P[BASE + 2], P[BASE + 3]);   \
    unsigned b0 = cvtpk(P[BASE + 4], P[BASE + 5]), b1 = cvtpk(P[BASE + 6], P[BASE + 7]);                              \
    auto r0 = __builtin_amdgcn_permlane32_swap(a0, b0, false, false); auto r1 = __builtin_amdgcn_permlane32_swap(a1, b1, false, false); \
    u32x4 w = {r0[0], r1[0], r0[1], r1[1]}; OUT = *reinterpret_cast<bf16x8*>(&w); } while (0)
  PK4(p0, 0, pa0); PK4(p0, 8, pa1); PK4(p1, 0, pa2); PK4(p1, 8, pa3);
#undef PK4
}
__device__ __forceinline__ void qkt(f32x16& p0, f32x16& p1, const bf16* Ks, const bf16x8* qr, int r32, int hi) {
  p0 = f32x16{}; p1 = f32x16{};
  for (int d0 = 0; d0 < 8; ++d0) { int cb = (d0 * 16 + hi * 8) * 2;
    bf16x8 b0 = *reinterpret_cast<const bf16x8*>((const char*)Ks + KSWZ(r32, cb));
    bf16x8 b1 = *reinterpret_cast<const bf16x8*>((const char*)Ks + KSWZ(32 + r32, cb));
    p0 = __builtin_amdgcn_mfma_f32_32x32x16_bf16(b0, qr[d0], p0, 0, 0, 0);
    p1 = __builtin_amdgcn_mfma_f32_32x32x16_bf16(b1, qr[d0], p1, 0, 0, 0); }
}
#define PK4S(P, BASE, OUT) do { unsigned a0 = cvtpk(P[BASE + 0], P[BASE + 1]), a1 = cvtpk(P[BASE + 2], P[BASE + 3]);   \
    unsigned b0 = cvtpk(P[BASE + 4], P[BASE + 5]), b1 = cvtpk(P[BASE + 6], P[BASE + 7]);                              \
    auto r0 = __builtin_amdgcn_permlane32_swap(a0, b0, false, false); auto r1 = __builtin_amdgcn_permlane32_swap(a1, b1, false, false); \
    u32x4 w = {r0[0], r1[0], r0[1], r1[1]}; OUT = *reinterpret_cast<bf16x8*>(&w); } while (0)
constexpr int QKPF = 1;
template <int I> __device__ __forceinline__ void sm_slice(f32x16& p0, f32x16& p1, float& psA, float& psB, bf16x8& pa0, bf16x8& pa1, bf16x8& pa2, bf16x8& pa3) {
  if constexpr (I < 8) { p1[2 * I] = __builtin_amdgcn_exp2f(p1[2 * I]); p1[2 * I + 1] = __builtin_amdgcn_exp2f(p1[2 * I + 1]); }
  else if constexpr (I < 10) { constexpr int b = (I - 8) * 8; psA += p0[b] + p0[b + 1]; psB += p0[b + 2] + p0[b + 3]; psA += p0[b + 4] + p0[b + 5]; psB += p0[b + 6] + p0[b + 7]; }
  else if constexpr (I < 12) { constexpr int b = (I - 10) * 8; psA += p1[b] + p1[b + 1]; psB += p1[b + 2] + p1[b + 3]; psA += p1[b + 4] + p1[b + 5]; psB += p1[b + 6] + p1[b + 7]; }
  else if constexpr (I == 12) PK4S(p0, 0, pa0);
  else if constexpr (I == 13) PK4S(p0, 8, pa1);
  else if constexpr (I == 14) PK4S(p1, 0, pa2);
  else PK4S(p1, 8, pa3);
}
template <int D0> __device__ __forceinline__ void qk_sm_step(f32x16& n0, f32x16& n1, const char* Kb, const bf16x8* qr, int r32, int hi, bf16x8 (&k0)[8], bf16x8 (&k1)[8],
                                                             f32x16& p0, f32x16& p1, float& psA, float& psB, bf16x8& pa0, bf16x8& pa1, bf16x8& pa2, bf16x8& pa3) {
  if constexpr (D0 + QKPF < 8) { const int cb = ((D0 + QKPF) * 16 + hi * 8) * 2;
    k0[D0 + QKPF] = *reinterpret_cast<const bf16x8*>(Kb + KSWZ(r32, cb)); k1[D0 + QKPF] = *reinterpret_cast<const bf16x8*>(Kb + KSWZ(32 + r32, cb)); }
  SBAR(); n0 = __builtin_amdgcn_mfma_f32_32x32x16_bf16(k0[D0], qr[D0], n0, 0, 0, 0); sm_slice<2 * D0>(p0, p1, psA, psB, pa0, pa1, pa2, pa3);
  SBAR(); n1 = __builtin_amdgcn_mfma_f32_32x32x16_bf16(k1[D0], qr[D0], n1, 0, 0, 0); sm_slice<2 * D0 + 1>(p0, p1, psA, psB, pa0, pa1, pa2, pa3);
  if constexpr (D0 + 1 < 8) qk_sm_step<D0 + 1>(n0, n1, Kb, qr, r32, hi, k0, k1, p0, p1, psA, psB, pa0, pa1, pa2, pa3);
}
__device__ __forceinline__ void qk_sm(f32x16& n0, f32x16& n1, const bf16* Ks, const bf16x8* qr, int r32, int hi, f32x16& p0, f32x16& p1, float& l_reg,
                                      bf16x8& pa0, bf16x8& pa1, bf16x8& pa2, bf16x8& pa3) {
  n0 = f32x16{}; n1 = f32x16{};
  bf16x8 k0[8], k1[8]; const char* Kb = (const char*)Ks; float psA = 0.f, psB = 0.f;
#pragma unroll
  for (int d0 = 0; d0 < QKPF; ++d0) { const int cb = (d0 * 16 + hi * 8) * 2;
    k0[d0] = *reinterpret_cast<const bf16x8*>(Kb + KSWZ(r32, cb)); k1[d0] = *reinterpret_cast<const bf16x8*>(Kb + KSWZ(32 + r32, cb)); }
  qk_sm_step<0>(n0, n1, Kb, qr, r32, hi, k0, k1, p0, p1, psA, psB, pa0, pa1, pa2, pa3);
  SBAR();
  float ps = psA + psB;
  { auto rr = __builtin_amdgcn_permlane32_swap(__float_as_uint(ps), __float_as_uint(ps), false, false); ps = __uint_as_float(rr[0]) + __uint_as_float(rr[1]); }
  l_reg += ps;
}
#undef PK4S
__device__ __forceinline__ int v_st(int k, int c) { const int kk = (k & ~0xC) | ((k & 4) << 1) | ((k & 8) >> 1); return ((kk >> 3) * 4 + (c >> 5)) * 512 + ((kk & 7) * 32 + (c & 31)) * 2; }
__device__ __forceinline__ int v_rd_base(int lane) { return ((lane & 3) << 3) | (((lane >> 2) & 3) << 6) | (((lane >> 4) & 1) << 5) | (((lane >> 5) & 1) << 8); }
constexpr int v_rd_off(int d0, int ks, int half) { return d0 * 512 + ks * 4096 + half * 2048; }
template <int OFF> __device__ __forceinline__ s16x4 tr_read(int vb) {
  s16x4 r; asm volatile("ds_read_b64_tr_b16 %0, %1 offset:%2" : "=&v"(r) : "v"(vb), "i"(OFF) : "memory"); return r;
}
template <int D0> __device__ __forceinline__ void pv_one(f32x16& od, int vb, bf16x8 pa0, bf16x8 pa1, bf16x8 pa2, bf16x8 pa3) {
  const s16x4 l0 = tr_read<v_rd_off(D0, 0, 0)>(vb), h0 = tr_read<v_rd_off(D0, 0, 1)>(vb), l1 = tr_read<v_rd_off(D0, 1, 0)>(vb), h1 = tr_read<v_rd_off(D0, 1, 1)>(vb);
  const s16x4 l2 = tr_read<v_rd_off(D0, 2, 0)>(vb), h2 = tr_read<v_rd_off(D0, 2, 1)>(vb), l3 = tr_read<v_rd_off(D0, 3, 0)>(vb), h3 = tr_read<v_rd_off(D0, 3, 1)>(vb);
  asm volatile("s_waitcnt lgkmcnt(0)" ::: "memory"); SBAR();
#define PK(L, H) (bf16x8){L[0], L[1], L[2], L[3], H[0], H[1], H[2], H[3]}
  od = __builtin_amdgcn_mfma_f32_32x32x16_bf16(pa0, PK(l0, h0), od, 0, 0, 0);
  od = __builtin_amdgcn_mfma_f32_32x32x16_bf16(pa1, PK(l1, h1), od, 0, 0, 0);
  od = __builtin_amdgcn_mfma_f32_32x32x16_bf16(pa2, PK(l2, h2), od, 0, 0, 0);
  od = __builtin_amdgcn_mfma_f32_32x32x16_bf16(pa3, PK(l3, h3), od, 0, 0, 0);
#undef PK
}
__device__ __forceinline__ void pv_d0(f32x16* o, int vb, bf16x8 pa0, bf16x8 pa1, bf16x8 pa2, bf16x8 pa3) {
  pv_one<0>(o[0], vb, pa0, pa1, pa2, pa3); pv_one<1>(o[1], vb, pa0, pa1, pa2, pa3); pv_one<2>(o[2], vb, pa0, pa1, pa2, pa3); pv_one<3>(o[3], vb, pa0, pa1, pa2, pa3);
}
template <typename TQ, bool NOMAX>
__device__ __forceinline__ void attn_dense_body(const TQ* __restrict__ Qb, const bf16* __restrict__ Kh, const bf16* __restrict__ Vh,
                                                bf16* __restrict__ Ob, int seq, char* lds) {
  using St = Stage<bf16>; using SQ = Stage<TQ>;
  int tid_ = threadIdx.x; asm volatile("" : "+v"(tid_));
  const int tid = tid_, wid = tid >> 6, lane = tid & 63, r32 = lane & 31, hi = lane >> 5;
  bf16* V_lds = (bf16*)lds; bf16* K_lds = (bf16*)(lds + NBUF * SHM_V);
  float* ws = (float*)(lds + NBUF * SHM_V + NBUF * SHM_K) + wid * 64; float* li_l = ws; float* al_l = ws + 32;
  float m_reg = -1e30f, l_reg = 0; f32x16 o[4] = {}; bf16x8 qr[8];
  const TQ* Qw = Qb + (long)(wid * QBLK + r32) * LDQ + hi * 8;
#pragma unroll
  for (int d0 = 0; d0 < 8; ++d0) qr[d0] = SQ::tobf(SQ::ld8(Qw + d0 * 16));
  const int sr = tid >> 4, sc = (tid & 15) * 8, vst0 = v_st(sr, sc), vst1 = v_st(32 + sr, sc);
  const int vb0 = (int)(uintptr_t)V_lds + v_rd_base(lane);
  struct { typename St::T vs0, vs1, ks0, ks1; } sr_[SDEPTH];
  const unsigned lo0 = (unsigned)(sr * LDK + sc) * 2u;
#define UPTR(p) ((const GAS char*)(((unsigned long long)(unsigned)__builtin_amdgcn_readfirstlane((unsigned)((unsigned long long)(p) >> 32)) << 32) | (unsigned long long)(unsigned)__builtin_amdgcn_readfirstlane((unsigned)(unsigned long long)(p))))
#define SLOAD(i, k0) do { const GAS char* vt_ = UPTR((const char*)Vh + (size_t)(k0) * (LDK * 2)); const GAS char* kt_ = UPTR((const char*)Kh + (size_t)(k0) * (LDK * 2)); \
    unsigned lo1_ = lo0; asm volatile("v_add_u32 %0, 0x2000, %0" : "+v"(lo1_));     \
    sr_[i].vs0 = *(const GAS bf16x8*)(vt_ + lo0); sr_[i].vs1 = *(const GAS bf16x8*)(vt_ + lo1_); sr_[i].ks0 = *(const GAS bf16x8*)(kt_ + lo0); sr_[i].ks1 = *(const GAS bf16x8*)(kt_ + lo1_); } while (0)
#define SWRITE(b, i) do { *(bf16x8*)((char*)V_lds + (b) * SHM_V + vst0) = St::tobf(sr_[i].vs0);          \
    *(bf16x8*)((char*)V_lds + (b) * SHM_V + vst1) = St::tobf(sr_[i].vs1); int kc = sc * 2;               \
    *(bf16x8*)((char*)K_lds + (b) * SHM_K + KSWZ(sr, kc)) = St::tobf(sr_[i].ks0);                       \
    *(bf16x8*)((char*)K_lds + (b) * SHM_K + KSWZ(32 + sr, kc)) = St::tobf(sr_[i].ks1); } while (0)
#define SWAIT() do { if constexpr (SDEPTH == 2) asm volatile("s_waitcnt vmcnt(4)" ::: "memory"); else asm volatile("s_waitcnt vmcnt(0)" ::: "memory"); } while (0)
#define RESC(a) do { if constexpr (!NOMAX) if (__any((a) < 1.f)) { if (hi == 0) al_l[r32] = (a); asm volatile("s_waitcnt lgkmcnt(0)" ::: "memory"); \
    for (int d = 0; d < 4; ++d) for (int r = 0; r < 16; ++r) o[d][r] *= al_l[crow(r, hi)]; } } while (0)
  f32x16 pA0, pA1, pB0, pB1; float mnA, mnB, alA, alB; bf16x8 pa0, pa1, pa2, pa3; const int NT = seq / KVBLK;
  constexpr int SE = 0, SO = SDEPTH - 1;
  SLOAD(SE, 0); asm volatile("s_waitcnt vmcnt(0)" ::: "memory"); SWRITE(0, SE); __syncthreads();
  qkt(pA0, pA1, K_lds, qr, r32, hi); partialSM<NOMAX>(pA0, pA1, m_reg, mnA, alA);
  SLOAD(SO, KVBLK); if constexpr (SDEPTH == 2) { if (2 < NT) SLOAD(SE, 2 * KVBLK); }
  SWAIT(); SWRITE(1, SO); __syncthreads();
  if (__builtin_amdgcn_readfirstlane(wid) >= 4) __builtin_amdgcn_s_setprio(1);
  int bp = 0, bc = 1, bn = 2;
#define ROT() do { const int t_ = bp; bp = bc; bc = bn; bn = t_; } while (0)
  for (int j = 1; j + 1 < NT; j += 2) {
    SBAR(); if constexpr (NOMAX) qk_sm(pB0, pB1, (bf16*)((char*)K_lds + bc * SHM_K), qr, r32, hi, pA0, pA1, l_reg, pa0, pa1, pa2, pa3);
    else { qkt(pB0, pB1, (bf16*)((char*)K_lds + bc * SHM_K), qr, r32, hi);
    finishSM<NOMAX>(pA0, pA1, alA, l_reg, pa0, pa1, pa2, pa3); } SBAR();
    SLOAD(SO, (j + SDEPTH) * KVBLK); if (ATT_SLSB) SBAR();
    pv_d0(o, vb0 + bp * (int)SHM_V, pa0, pa1, pa2, pa3); partialSM<NOMAX>(pB0, pB1, m_reg, mnB, alB);
    SWAIT(); SWRITE(bn, SE);
    RESC(alB); __syncthreads(); ROT();
    SBAR(); if constexpr (NOMAX) qk_sm(pA0, pA1, (bf16*)((char*)K_lds + bc * SHM_K), qr, r32, hi, pB0, pB1, l_reg, pa0, pa1, pa2, pa3);
    else { qkt(pA0, pA1, (bf16*)((char*)K_lds + bc * SHM_K), qr, r32, hi);
    finishSM<NOMAX>(pB0, pB1, alB, l_reg, pa0, pa1, pa2, pa3); } SBAR();
    if (SDEPTH == 1 || j + 3 < NT) SLOAD(SE, (j + 1 + SDEPTH) * KVBLK); if (ATT_SLSB) SBAR();
    pv_d0(o, vb0 + bp * (int)SHM_V, pa0, pa1, pa2, pa3); partialSM<NOMAX>(pA0, pA1, m_reg, mnA, alA);
    SWAIT(); SWRITE(bn, SO);
    RESC(alA); __syncthreads(); ROT();
  }
  SBAR(); if constexpr (NOMAX) qk_sm(pB0, pB1, (bf16*)((char*)K_lds + bc * SHM_K), qr, r32, hi, pA0, pA1, l_reg, pa0, pa1, pa2, pa3);
    else { qkt(pB0, pB1, (bf16*)((char*)K_lds + bc * SHM_K), qr, r32, hi);
    finishSM<NOMAX>(pA0, pA1, alA, l_reg, pa0, pa1, pa2, pa3); } SBAR();
  pv_d0(o, vb0 + bp * (int)SHM_V, pa0, pa1, pa2, pa3); partialSM<NOMAX>(pB0, pB1, m_reg, mnB, alB);
  RESC(alB);
  finishSM<NOMAX>(pB0, pB1, alB, l_reg, pa0, pa1, pa2, pa3); SBAR();
  pv_d0(o, vb0 + bc * (int)SHM_V, pa0, pa1, pa2, pa3);
#undef ROT
  __builtin_amdgcn_s_setprio(0);
  if (hi == 0) li_l[r32] = l_reg; asm volatile("s_waitcnt lgkmcnt(0)" ::: "memory");
  float rli[16];
#pragma unroll
  for (int r = 0; r < 16; ++r) rli[r] = __builtin_amdgcn_rcpf(li_l[crow(r, hi)]);
  __syncthreads();
  char* st = lds + wid * 8192;
#pragma unroll
  for (int r = 0; r < 16; ++r) { const int orow = crow(r, hi);
#pragma unroll
    for (int d0 = 0; d0 < 4; ++d0) *(bf16*)(st + orow * 256 + (d0 * 32 + r32) * 2) = (bf16)(cvtpk(o[d0][r] * rli[r], 0.f) & 0xffffu); }
  asm volatile("s_waitcnt lgkmcnt(0)" ::: "memory");
  bf16* Ow = Ob + (long)(wid * QBLK) * LDO;
#pragma unroll
  for (int i = 0; i < 8; ++i) { const int orow = 4 * i + (lane >> 4), ch = lane & 15;
    *(u32x4*)(Ow + (long)orow * LDO + ch * 8) = *(const u32x4*)(st + orow * 256 + ch * 16); }
#undef SLOAD
#undef UPTR
#undef SWRITE
#undef SWAIT
#undef RESC
}
}
#define FFT_HD __device__ __forceinline__
#define FFT_DEVICE_ASM 1
#define FFT_LD(p, i) ((p)[i])
#define FFT_ST(p, i, v) ((p)[i] = (v))
#ifndef FFT_HD
#define FFT_HD __device__ __forceinline__
#endif
#ifndef FFT_SCHED_DEFINED_EARLY
#define FFT_SCHED_DEFINED_EARLY
#ifndef FFT_SCHED
#define FFT_SCHED() __builtin_amdgcn_sched_barrier(0)
#endif
#endif
#ifndef FFT_OPAQUE
#define FFT_OPAQUE(x) asm volatile("" : "+v"(x))
#endif
#ifndef FFT_LD
#define FFT_LD(p, i) ((p)[i])
#define FFT_ST(p, i, v) ((p)[i] = (v))
#endif
#ifdef FFT_DEVICE_ASM
typedef float cf __attribute__((ext_vector_type(2)));
FFT_HD cf cf_add(cf a, cf b) { return a + b; }
FFT_HD cf cf_sub(cf a, cf b) { return a - b; }
FFT_HD cf cf_conj(cf a) { return cf{a.x, -a.y}; }
FFT_HD cf cf_mul(cf a, cf b) {
    cf t, r; asm("v_pk_mul_f32 %0, %1, %2 op_sel_hi:[0,1]" : "=v"(t) : "v"(a), "v"(b));
    asm("v_pk_fma_f32 %0, %1, %2, %3 op_sel:[1,1,0] op_sel_hi:[1,0,1] neg_lo:[0,1,0]" : "=v"(r) : "v"(a), "v"(b), "v"(t)); return r; }
FFT_HD cf cf_mulc(cf a, cf b) {
    cf t, r; asm("v_pk_mul_f32 %0, %1, %2 op_sel_hi:[0,1] neg_hi:[0,1]" : "=v"(t) : "v"(a), "v"(b));
    asm("v_pk_fma_f32 %0, %1, %2, %3 op_sel:[1,1,0] op_sel_hi:[1,0,1]" : "=v"(r) : "v"(a), "v"(b), "v"(t)); return r; }
#define FFT_PKADD(name, mods) FFT_HD cf name(cf a, cf b) { cf r; asm("v_pk_add_f32 %0, %1, %2 " mods : "=v"(r) : "v"(a), "v"(b)); return r; }
FFT_PKADD(cf_sub_mi, "op_sel:[1,1] op_sel_hi:[0,0] neg_lo:[0,1] neg_hi:[1,0]")
FFT_PKADD(cf_sub_pi, "op_sel:[1,1] op_sel_hi:[0,0] neg_lo:[1,0] neg_hi:[0,1]")
FFT_PKADD(cf_add_conj, "neg_hi:[0,1]")
FFT_PKADD(cf_sub_conj, "neg_lo:[0,1]")
FFT_PKADD(cf_add_mi, "op_sel:[0,1] op_sel_hi:[1,0] neg_hi:[0,1]")
FFT_PKADD(cf_conj_sub_mi, "op_sel:[0,1] op_sel_hi:[1,0] neg_lo:[0,1] neg_hi:[1,1]")
FFT_PKADD(cf_add_pi, "op_sel:[0,1] op_sel_hi:[1,0] neg_lo:[0,1]")
FFT_PKADD(cf_conj_add_pi, "op_sel:[0,1] op_sel_hi:[1,0] neg_hi:[1,0]")
#else
struct __attribute__((aligned(8))) cf { float x, y; };
FFT_HD cf cf_add(cf a, cf b) { return cf{a.x + b.x, a.y + b.y}; }
FFT_HD cf cf_sub(cf a, cf b) { return cf{a.x - b.x, a.y - b.y}; }
FFT_HD cf cf_mul(cf a, cf b) { return cf{a.x * b.x - a.y * b.y, a.x * b.y + a.y * b.x}; }
FFT_HD cf cf_mulc(cf a, cf b) { return cf{a.x * b.x + a.y * b.y, a.y * b.x - a.x * b.y}; }
FFT_HD cf cf_conj(cf a) { return cf{a.x, -a.y}; }
FFT_HD cf cf_sub_mi(cf a, cf b) { return cf{a.y - b.y, b.x - a.x}; }
FFT_HD cf cf_sub_pi(cf a, cf b) { return cf{b.y - a.y, a.x - b.x}; }
FFT_HD cf cf_add_conj(cf a, cf b) { return cf{a.x + b.x, a.y - b.y}; }
FFT_HD cf cf_sub_conj(cf a, cf b) { return cf{a.x - b.x, a.y + b.y}; }
FFT_HD cf cf_add_mi(cf a, cf b) { return cf{a.x + b.y, a.y - b.x}; }
FFT_HD cf cf_conj_sub_mi(cf a, cf b) { return cf{a.x - b.y, -a.y - b.x}; }
FFT_HD cf cf_add_pi(cf a, cf b) { return cf{a.x - b.y, a.y + b.x}; }
FFT_HD cf cf_conj_add_pi(cf a, cf b) { return cf{a.x + b.y, -a.y + b.x}; }
#endif
constexpr int FFT_N = 16384;
constexpr int FFT_LDS_CF = 17904;
constexpr int FFT_LDS_BYTES = FFT_LDS_CF * 8;
FFT_HD int fft_phys(int p) { return p + (p >> 4) + ((p >> 9) << 4); }
#define FFT_CONSTS float fc1 = 0.98078528040323043f, fc2 = 0.92387953251128674f, fc3 = 0.83146961230254524f, fc4 = 0.70710678118654752f, fc5 = 0.55557023301960218f, \
    fc6 = 0.38268343236508978f, fc7 = 0.19509032201612825f; FFT_OPAQUE(fc1); FFT_OPAQUE(fc2); FFT_OPAQUE(fc3); FFT_OPAQUE(fc4); FFT_OPAQUE(fc5); FFT_OPAQUE(fc6); FFT_OPAQUE(fc7)
#define FFT_C32(k) ((k) == 0 ? 1.0f : (k) == 1 ? fc1 : (k) == 2 ? fc2 : (k) == 3 ? fc3 : (k) == 4 ? fc4 : (k) == 5 ? fc5 : (k) == 6 ? fc6 : (k) == 7 ? fc7 : (k) == 8 ? 0.0f : (k) == 9 ? -fc7 : \
    (k) == 10 ? -fc6 : (k) == 11 ? -fc5 : (k) == 12 ? -fc4 : (k) == 13 ? -fc3 : (k) == 14 ? -fc2 : -fc1)
#define FFT_S32(k) ((k) == 0 ? 0.0f : (k) == 1 ? fc7 : (k) == 2 ? fc6 : (k) == 3 ? fc5 : (k) == 4 ? fc4 : (k) == 5 ? fc3 : (k) == 6 ? fc2 : (k) == 7 ? fc1 : (k) == 8 ? 1.0f : (k) == 9 ? fc1 : \
    (k) == 10 ? fc2 : (k) == 11 ? fc3 : (k) == 12 ? fc4 : (k) == 13 ? fc5 : (k) == 14 ? fc6 : fc7)

template <int R, int HALF, bool INV> FFT_HD void dft_stage(cf (&v)[R], float fc1, float fc2, float fc3, float fc4, float fc5, float fc6, float fc7) {
#pragma unroll
    for (int g = 0; g < R; g += 2 * HALF) {
#pragma unroll
        for (int i = 0; i < HALF; ++i) {
            const cf a = v[g + i], b = v[g + i + HALF];
            v[g + i] = cf_add(a, b);
            const int ti = i * (16 / HALF);
            if (ti == 0) v[g + i + HALF] = cf_sub(a, b);
            else if (ti == 8) v[g + i + HALF] = INV ? cf_sub_pi(a, b) : cf_sub_mi(a, b);
            else { const cf w = cf{FFT_C32(ti), FFT_S32(ti)}; const cf d = cf_sub(a, b); v[g + i + HALF] = INV ? cf_mul(d, w) : cf_mulc(d, w); }
        }
    }
    FFT_SCHED();
    if constexpr (HALF > 1) dft_stage<R, HALF / 2, INV>(v, fc1, fc2, fc3, fc4, fc5, fc6, fc7);
}
template <int R, bool INV> FFT_HD void dft_reg(cf (&v)[R]) {
    FFT_CONSTS;
    dft_stage<R, R / 2, INV>(v, fc1, fc2, fc3, fc4, fc5, fc6, fc7);
    cf t[R];
#pragma unroll
    for (int k = 0; k < R; ++k) t[k] = v[k];
#pragma unroll
    for (int k = 0; k < R; ++k) {
        const int r = R == 32 ? (((k & 1) << 4) | ((k & 2) << 2) | (k & 4) | ((k & 8) >> 2) | ((k & 16) >> 4)) : (((k & 1) << 3) | ((k & 2) << 1) | ((k & 4) >> 1) | ((k & 8) >> 3));
        v[k] = t[r];
    }
}
#ifndef FFT_SCHED
#define FFT_SCHED() __builtin_amdgcn_sched_barrier(0)
#endif
#ifndef FFT_SINCOS2PI
#define FFT_SINCOS2PI(frac, s, c) do { (s) = __builtin_amdgcn_sinf(frac); (c) = __builtin_amdgcn_cosf(frac); asm volatile("s_nop 1" : "+v"(s), "+v"(c)); } while (0)
#endif
template <int R> FFT_HD void twiddle_chain(cf (&v)[R], float frac  ) {
    FFT_OPAQUE(frac);
    float s, c; FFT_SINCOS2PI(frac, s, c);
    const cf w = cf{c, s}; cf p = w;
#pragma unroll
    for (int k = 1; k < R; ++k) { v[k] = cf_mul(v[k], p); if (k + 1 < R) p = cf_mul(p, w); if ((k & 7) == 7) FFT_SCHED(); }
}
template <class LP> FFT_HD void fft_f1(LP lds, int t, cf (&v)[32]) {
    dft_reg<32, false>(v);
    twiddle_chain<32>(v, -(float)t * (1.0f / 16384.0f));
    int P1 = t + (t >> 4); FFT_OPAQUE(P1);
#pragma unroll
    for (int k = 0; k < 32; ++k) FFT_ST(lds, P1 + 560 * k, v[k]);
}
template <class LP> FFT_HD void fft_f2(LP lds, int t) {
    int P2 = 560 * (t >> 4) + (t & 15); FFT_OPAQUE(P2);
    cf v[32];
#pragma unroll
    for (int j = 0; j < 32; ++j) v[j] = FFT_LD(lds, P2 + 17 * j);
    dft_reg<32, false>(v);
    twiddle_chain<32>(v, -(float)(t & 15) * (1.0f / 512.0f));
#pragma unroll
    for (int k = 0; k < 32; ++k) FFT_ST(lds, P2 + 17 * k, v[k]);
}
template <class LP, bool INV> FFT_HD void fft_p3(LP lds, int t) {
#pragma unroll
    for (int q = 0; q < 2; ++q) {
        int P3 = 17 * t + 16 * (t >> 5) + 8960 * q; FFT_OPAQUE(P3);
        cf v[16];
#pragma unroll
        for (int j = 0; j < 16; ++j) v[j] = FFT_LD(lds, P3 + j);
        dft_reg<16, INV>(v);
#pragma unroll
        for (int k = 0; k < 16; ++k) FFT_ST(lds, P3 + k, v[k]);
    }
}
FFT_HD int fft_pos(int k) { return 512 * (k & 31) + 16 * ((k >> 5) & 31) + (k >> 10); }
template <class LP, int MODE> FFT_HD void fft_pair(LP lds, int t, float* K, const float (&Kr)[66]) {
    const int m = t & 31, alo = t >> 5; unsigned ut = (unsigned)t; FFT_OPAQUE(ut);
    float fr0 = -(float)(alo + 32 * m) * (1.0f / 32768.0f); FFT_OPAQUE(fr0);
    float s, c; FFT_SINCOS2PI(fr0, s, c);
    cf wh = cf{c, s};
    float k0 = 0.98078528040323043f, k1 = -0.19509032201612825f, k2 = 0.99999529380957619f, k3 = -0.0030679567629659761f; FFT_OPAQUE(k0); FFT_OPAQUE(k1); FFT_OPAQUE(k2); FFT_OPAQUE(k3);
    const cf c1024 = cf{k0, k1};
    const cf c16 = cf{k2, k3};
#pragma unroll
    for (int h = 0; h < 8; ++h) {
#pragma unroll
        for (int e = 0; e < 2; ++e) {
            const int j = 2 * h + e;
            const cf w = e ? cf_mul(wh, c16) : wh;
            const int k = alo + 16 * e + 32 * m + 1024 * h;
            const int a = alo + 16 * e, an = (32 - a) & 31, b1 = a != 0 ? 1 : 0, mn = (32 - m - b1) & 31, b2 = (m + b1) != 0 ? 1 : 0;
            const int pk = 560 * a + 17 * m + h, pn = 560 * an + 17 * mn + 16 - b2 - h;
            const cf zk = FFT_LD(lds, pk), zn = FFT_LD(lds, pn);
            const cf E2 = cf_add_conj(zk, zn), D2 = cf_sub_conj(zk, zn);
            const cf p = cf_mul(w, D2);
            cf xk = cf_add_mi(E2, p), xn = cf_conj_sub_mi(E2, p);
            if (k == 0) { xk = cf{2.0f * (zk.x + zk.y), 0.f}; xn = cf{2.0f * (zk.x - zk.y), 0.f}; }
            if (MODE == 0) { K[512 * (4 * j + 0) + ut] = xk.x; K[512 * (4 * j + 1) + ut] = xk.y; K[512 * (4 * j + 2) + ut] = xn.x; K[512 * (4 * j + 3) + ut] = xn.y; }
            else {
                const float q0 = Kr[4 * j + 0], q1 = Kr[4 * j + 1], q2 = Kr[4 * j + 2], q3 = Kr[4 * j + 3];
                const cf yk = cf_mul(xk, cf{q0, q1}), yn = cf_mul(xn, cf{q2, q3});
                const cf E = cf_add_conj(yk, yn), Dd = cf_sub_conj(yk, yn);
                const cf O = cf_mulc(Dd, w);
                cf ok = cf_add_pi(E, O), on = cf_conj_add_pi(E, O);
                if (k == 0) ok = cf{yk.x + yn.x, yk.x - yn.x};
                FFT_ST(lds, pk, ok); if (k != 0) FFT_ST(lds, pn, on);
            }
        }
        wh = cf_mul(wh, c1024);
    }
    if (t == 0) {
        const int pk = 8;
        const cf z = FFT_LD(lds, pk);
        if (MODE == 0) { K[512 * 64 + ut] = 2.0f * z.x; K[512 * 65 + ut] = -2.0f * z.y; }
        else { const cf r = cf_mulc(z, cf{Kr[64], Kr[65]}); FFT_ST(lds, pk, (cf{4.0f * r.x, 4.0f * r.y})); }
    }
}
FFT_HD void fft_kload(const float* K, int t, float (&Kr)[66]) {
    unsigned ut = (unsigned)t; FFT_OPAQUE(ut);
#pragma unroll
    for (int i = 0; i < 66; ++i) Kr[i] = K[512 * i + ut];
}
template <class LP> FFT_HD void fft_i2(LP lds, int t) {
    int P2 = 560 * (t >> 4) + (t & 15); FFT_OPAQUE(P2);
    cf v[32];
#pragma unroll
    for (int k = 0; k < 32; ++k) v[k] = FFT_LD(lds, P2 + 17 * k);
    twiddle_chain<32>(v, (float)(t & 15) * (1.0f / 512.0f));
    dft_reg<32, true>(v);
#pragma unroll
    for (int j = 0; j < 32; ++j) FFT_ST(lds, P2 + 17 * j, v[j]);
}
template <class LP> FFT_HD void fft_i1(LP lds, int t, cf (&v)[32]) {
    int P1 = t + (t >> 4); FFT_OPAQUE(P1);
#pragma unroll
    for (int k = 0; k < 32; ++k) v[k] = FFT_LD(lds, P1 + 560 * k);
    twiddle_chain<32>(v, (float)t * (1.0f / 16384.0f));
    dft_reg<32, true>(v);
}
constexpr int LDS_BYTES = 147456;
constexpr int LDS_BARW = LDS_BYTES - 64;

struct Fr {
    LAS unsigned char* lds; unsigned char* ldsg;
    int tid, lane, wave, blk, nblk, gw, ngw;
    const __attribute__((address_space(4))) unsigned long long* ka;
    unsigned char* ws;
};
#define BFE(v, e) (((e) & 1) ? bfhi((v)[(e) >> 1]) : bflo((v)[(e) >> 1]))

struct WSet { const float *gate, *up, *down, *win, *wout; int nin; };
struct WItem { const float* W; bf16_t* WT; int K, N, rbase, k0, n0; };
__device__ __forceinline__ WItem wconv_lookup(int it, const WSet& w, unsigned char* wslot  ) {
    const int I_G = 32 * (DFF / 32), I_D = (DFF / 64) * (D / 32), I_IN = 32 * (w.nin / 32);
    WItem x; int mode = 0, row_off = 0, r = it;
    if (r < I_G) { x.W = w.gate; x.K = D; x.N = DFF; x.WT = (bf16_t*)(wslot + WO_GU); mode = 1; }
    else if ((r -= I_G) < I_G) { x.W = w.up; x.K = D; x.N = DFF; x.WT = (bf16_t*)(wslot + WO_GU); mode = 1; row_off = 128; }
    else if ((r -= I_G) < I_D) { x.W = w.down; x.K = DFF; x.N = D; x.WT = (bf16_t*)(wslot + WO_D); }
    else if ((r -= I_D) < I_IN) { x.W = w.win; x.K = D; x.N = w.nin; x.WT = (bf16_t*)(wslot + WO_IN); }
    else { r -= I_IN; x.W = w.wout; x.K = D; x.N = D; x.WT = (bf16_t*)(wslot + WO_OUT); }
    const int nblk = x.N / 32, kb = r / nblk, nb = r % nblk; x.k0 = 64 * kb; x.n0 = 32 * nb;
    x.rbase = mode ? 256 * (x.n0 >> 7) + (x.n0 & 127) + row_off : x.n0;
    return x;
}
__device__ __forceinline__ void wconv_load(const WItem& x, int lane, f32x4 (&r)[8]) {
    const float* p = x.W + (size_t)(x.k0 + (lane >> 3)) * x.N + x.n0 + 4 * (lane & 7);
#pragma unroll
    for (int i = 0; i < 8; ++i) r[i] = *(const f32x4*)(p + (size_t)(8 * i) * x.N);
}
__device__ __forceinline__ void wconv_store(const WItem& x, int lane, const f32x4 (&r)[8], LAS float* scr) {
    const int c4 = lane & 7, kr = lane >> 3;
#pragma unroll
    for (int i = 0; i < 8; ++i)
#pragma unroll
        for (int e = 0; e < 4; ++e) scr[(4 * c4 + e) * 65 + kr + 8 * i] = r[i][e];
    LDS_WAIT(); asm volatile("" ::: "memory");
#pragma unroll
    for (int j = 0; j < 4; ++j) { const int n = (lane >> 3) + 8 * j; const LAS float* s = scr + n * 65 + 8 * (lane & 7);
        u32x4 o; o.x = cvt_pk_bf16(s[0], s[1]); o.y = cvt_pk_bf16(s[2], s[3]); o.z = cvt_pk_bf16(s[4], s[5]); o.w = cvt_pk_bf16(s[6], s[7]);
        *(u32x4*)(x.WT + (size_t)(x.rbase + n) * x.K + x.k0 + 8 * (lane & 7)) = o; }
    LDS_WAIT(); asm volatile("" ::: "memory");
}
__device__ __forceinline__ int wconv_total(int nin) { return 2 * 32 * (DFF / 32) + (DFF / 64) * (D / 32) + 32 * (nin / 32) + 32 * (D / 32); }
__device__ __forceinline__ void wconv_part(const Fr& F, const WSet& w, unsigned char* wslot, LAS float* scr, int& it, int nmax) {
    const int total = wconv_total(w.nin);
    if (it >= total || nmax <= 0) return;
    WItem cur = wconv_lookup(it, w, wslot); f32x4 rc[8]; wconv_load(cur, F.lane, rc);
    for (int n = 1;; ++n) {
        const int nx = it + F.ngw; const bool more = nx < total && n < nmax;
        WItem nxt = cur; f32x4 rn[8];
        if (more) { nxt = wconv_lookup(nx, w, wslot); wconv_load(nxt, F.lane, rn); }
        wconv_store(cur, F.lane, rc, scr);
        it = nx;
        if (!more) break;
        cur = nxt;
#pragma unroll
        for (int i = 0; i < 8; ++i) rc[i] = rn[i];
    }
}
__device__ __forceinline__ void wconv_layer(const Fr& F, const WSet& w, unsigned char* wslot) {
    int it = F.gw; wconv_part(F, w, wslot, (LAS float*)(F.lds + F.wave * 16384), it, 1 << 30);
}

__device__ __forceinline__ void adaln_phase(const Fr& F, const float* c, const float* c_ctx, const float* w_mod, const float* b_mod, float* mod) {
    LAS float* sl = (LAS float*)F.lds;
    LAS float* red = sl + 3 * D;
    for (int i = F.tid; i < 3 * D; i += NTHREADS) { const int cnd = i / D, k = i % D; const float x = cnd < 2 ? c[cnd * D + k] : c_ctx[k]; sl[i] = x / (1.0f + __expf(-x)); }
    __syncthreads();
    for (int g = F.blk; g < 192; g += F.nblk) {
        const int layer = g / 48, colg = (g % 48) * 256, col = colg + 4 * F.lane;
        const float* wp = w_mod + (size_t)layer * D * NMOD + col + (size_t)(F.wave * 256) * NMOD;
        f32x4 a0 = {0.f, 0.f, 0.f, 0.f}, a1 = a0, a2 = a0;
#pragma unroll 1
        for (int kb = 0; kb < 256; kb += 16) { f32x4 w[16];
#pragma unroll
            for (int u = 0; u < 16; ++u) w[u] = __builtin_nontemporal_load((const f32x4*)(wp + (size_t)(kb + u) * NMOD));
#pragma unroll
            for (int u = 0; u < 16; ++u) { const int k = F.wave * 256 + kb + u; a0 += w[u] * sl[k]; a1 += w[u] * sl[D + k]; a2 += w[u] * sl[2 * D + k]; } }
        *(LAS f32x4*)(red + (F.wave * 3 + 0) * 256 + 4 * F.lane) = a0; *(LAS f32x4*)(red + (F.wave * 3 + 1) * 256 + 4 * F.lane) = a1; *(LAS f32x4*)(red + (F.wave * 3 + 2) * 256 + 4 * F.lane) = a2;
        __syncthreads();
        for (int o = F.tid; o < 768; o += NTHREADS) { const int cnd = o >> 8, cc = o & 255; float s = 0.f;
#pragma unroll
            for (int w = 0; w < 8; ++w) s += red[(w * 3 + cnd) * 256 + cc];
            mod[((size_t)layer * 3 + cnd) * NMOD + colg + cc] = s + b_mod[layer * NMOD + colg + cc]; }
        __syncthreads();
    }
}

__device__ __forceinline__ void hdn_phase(const Fr& F, const float* w1, const float* b1, const float* w2, const float* b2, const float* w3, const float* b3, const float* freq, float* hdn) {
    const bool split = F.nblk > 192; if (split && F.blk < 192) return;
    const int first = split ? (F.blk - 192) * NWAVES + F.wave : F.gw, stride = split ? (F.nblk - 192) * NWAVES : F.ngw;
#pragma unroll 1
    for (int j = 0; j < 2; ++j) {
        float W1[33], W2[64], W3[64];
#pragma unroll
        for (int q = 0; q < 33; ++q) W1[q] = w1[(j * 33 + q) * 64 + F.lane];
#pragma unroll
        for (int q = 0; q < 64; ++q) { W2[q] = w2[(j * 64 + q) * 64 + F.lane]; W3[q] = w3[(j * 64 + q) * 64 + F.lane]; }
        const float fr = freq[j * 64 + F.lane], B1 = b1[j * 64 + F.lane], B2 = b2[j * 64 + F.lane], B3 = b3[j * 64 + F.lane];
#pragma unroll 1
        for (int tt = first; tt < SEQ + CTXL; tt += stride) {
            const bool ctx = tt >= SEQ; const int t = ctx ? tt - SEQ : tt, L = ctx ? CTXL : SEQ;
            const float tn = (float)t / (float)(L - 1), rev = (float)t / (float)L;
            const int k = F.lane; float z = 0.f;
            if (k == 0) z = tn;
            else if (k <= 32) { const int i = (k - 1) & 15; const float fb = 1e-4f + (float)i * ((15.0f - 1e-4f) / 15.0f); const float a = 6.283185307179586f * (fb * rev);
                z = k <= 16 ? cosf(a) : -sinf(a); }
            float acc = B1;
#pragma unroll
            for (int q = 0; q < 33; ++q) acc += lane_bcast(z, q) * W1[q];
            float h = sinf(fr * acc);
            acc = B2;
#pragma unroll
            for (int q = 0; q < 64; ++q) acc += lane_bcast(h, q) * W2[q];
            h = sinf(fr * acc);
            acc = B3;
#pragma unroll
            for (int q = 0; q < 64; ++q) acc += lane_bcast(h, q) * W3[q];
            hdn[((size_t)j * (SEQ + CTXL) + tt) * 64 + F.lane] = sinf(fr * acc);
        }
    }
}

typedef float f32x16_t __attribute__((ext_vector_type(16)));
__device__ __forceinline__ void split8(const float (&v)[8], bf16x8& h, bf16x8& l) {
    u32x4 hw, lw;
#pragma unroll
    for (int i = 0; i < 4; ++i) { const unsigned w = cvt_pk_bf16(v[2 * i], v[2 * i + 1]); hw[i] = w; lw[i] = cvt_pk_bf16(v[2 * i] - bflo(w), v[2 * i + 1] - bfhi(w)); }
    h = *(bf16x8*)&hw; l = *(bf16x8*)&lw;
}
template <typename TK>
__device__ __forceinline__ void hy_filt_tiles(const Fr& F, const float* hdn  , const float* w4  , TK* KF, int L, int first, int stride) {
    const int m = F.lane & 31, hi = F.lane >> 5;
    const int ntiles = ((L + 511) / 512) * 32;
    for (int tile = first; tile < ntiles; tile += stride) {
        const int t0 = (tile >> 5) * 512, c0 = (tile & 31) * 64;
#pragma unroll 1
        for (int bank = 0; bank < 2; ++bank) {
            bf16x8 Ah[2][4], Al[2][4];
#pragma unroll
            for (int mb = 0; mb < 2; ++mb) { const float* wp = w4 + bank * 2048 + c0 + mb * 32 + m + (size_t)(8 * hi) * 4096;
#pragma unroll
                for (int ks = 0; ks < 4; ++ks) { float v[8];
#pragma unroll
                    for (int e = 0; e < 8; ++e) v[e] = wp[(size_t)(16 * ks + e) * 4096];
                    split8(v, Ah[mb][ks], Al[mb][ks]); } }
#pragma unroll 1
            for (int nb = 0; nb < 2; ++nb) {
                const int tpos = t0 + 64 * F.wave + 32 * nb + m, tl = tpos < L ? tpos : L - 1;
                bf16x8 Bh[4], Bl[4];
#pragma unroll
                for (int ks = 0; ks < 4; ++ks) { const float* hp = hdn + (size_t)tl * 64 + 16 * ks + 8 * hi; const f32x4 x0 = *(const f32x4*)hp, x1 = *(const f32x4*)(hp + 4);
                    const float v[8] = {x0.x, x0.y, x0.z, x0.w, x1.x, x1.y, x1.z, x1.w}; split8(v, Bh[ks], Bl[ks]); }
                const float tn = (float)tpos / (float)(L - 1);
#pragma unroll
                for (int mb = 0; mb < 2; ++mb) {
                    f32x16_t acc = {0.f, 0.f, 0.f, 0.f, 0.f, 0.f, 0.f, 0.f, 0.f, 0.f, 0.f, 0.f, 0.f, 0.f, 0.f, 0.f};
#pragma unroll
                    for (int ks = 0; ks < 4; ++ks) { acc = __builtin_amdgcn_mfma_f32_32x32x16_bf16(Ah[mb][ks], Bh[ks], acc, 0, 0, 0);
                        acc = __builtin_amdgcn_mfma_f32_32x32x16_bf16(Ah[mb][ks], Bl[ks], acc, 0, 0, 0); acc = __builtin_amdgcn_mfma_f32_32x32x16_bf16(Al[mb][ks], Bh[ks], acc, 0, 0, 0); }
                    if (tpos < L) {
                        const int cb = c0 + mb * 32 + 4 * hi;
                        TK* dst = KF + (size_t)cb * (2 * L) + (bank ? (tpos > 0 ? 2 * L - tpos : L) : tpos);
#pragma unroll
                        for (int r = 0; r < 16; ++r) { const int mm = (r & 3) + 8 * (r >> 2);
                            const float dl = 3.0701134573253946f + 12.280453829301578f * ((float)(cb + mm) * (1.0f / 2047.0f));
                            const float kv = (bank && tpos == 0) ? 0.f : acc[r] * __expf(-tn * dl);
                            if constexpr (sizeof(TK) == 2) dst[(size_t)mm * (2 * L)] = (bf16_t)(cvt_pk_bf16(kv, 0.f) & 0xffffu); else dst[(size_t)mm * (2 * L)] = kv; }
                    }
                }
            }
        }
    }
}

__device__ __forceinline__ void hy_filt_long(const Fr& F, const float* hdn  , const float* w4  , bf16_t* KF, int first, int stride) {
    constexpr int L = SEQ, PITCH = 144;
    const int m = F.lane & 31, hi = F.lane >> 5;
    LAS unsigned char* T = (LAS unsigned char*)(F.lds + F.wave * 16384);
    const int ntiles = (L / 512) * 32;
    for (int tile = first; tile < ntiles; tile += stride) {
        const int t0 = (tile >> 5) * 512, c0 = (tile & 31) * 64, tw = t0 + 64 * F.wave;
#pragma unroll 1
        for (int bank = 0; bank < 2; ++bank) {
            bf16x8 Ah[2][4], Al[2][4];
#pragma unroll
            for (int mb = 0; mb < 2; ++mb) { const float* wp = w4 + bank * 2048 + c0 + mb * 32 + m + (size_t)(8 * hi) * 4096;
#pragma unroll
                for (int ks = 0; ks < 4; ++ks) { float v[8];
#pragma unroll
                    for (int e = 0; e < 8; ++e) v[e] = wp[(size_t)(16 * ks + e) * 4096];
                    split8(v, Ah[mb][ks], Al[mb][ks]); } }
            f32x16_t acc[2][2];
#pragma unroll
            for (int nb = 0; nb < 2; ++nb) {
                const int tpos = tw + 32 * nb + m + bank, tl = tpos < L ? tpos : L - 1;
                bf16x8 Bh[4], Bl[4];
#pragma unroll
                for (int ks = 0; ks < 4; ++ks) { const float* hp = hdn + (size_t)tl * 64 + 16 * ks + 8 * hi; const f32x4 x0 = *(const f32x4*)hp, x1 = *(const f32x4*)(hp + 4);
                    const float v[8] = {x0.x, x0.y, x0.z, x0.w, x1.x, x1.y, x1.z, x1.w}; split8(v, Bh[ks], Bl[ks]); }
#pragma unroll
                for (int mb = 0; mb < 2; ++mb) {
                    f32x16_t a = {0.f, 0.f, 0.f, 0.f, 0.f, 0.f, 0.f, 0.f, 0.f, 0.f, 0.f, 0.f, 0.f, 0.f, 0.f, 0.f};
#pragma unroll
                    for (int ks = 0; ks < 4; ++ks) { a = __builtin_amdgcn_mfma_f32_32x32x16_bf16(Ah[mb][ks], Bh[ks], a, 0, 0, 0);
                        a = __builtin_amdgcn_mfma_f32_32x32x16_bf16(Ah[mb][ks], Bl[ks], a, 0, 0, 0); a = __builtin_amdgcn_mfma_f32_32x32x16_bf16(Al[mb][ks], Bh[ks], a, 0, 0, 0); }
                    acc[nb][mb] = a; }
            }
#pragma unroll
            for (int mb = 0; mb < 2; ++mb) {
#pragma unroll
                for (int nb = 0; nb < 2; ++nb) {
                    const int tpos = tw + 32 * nb + m + bank, col = bank ? 63 - (32 * nb + m) : 32 * nb + m;
                    const float tn = (float)tpos / (float)(L - 1);
#pragma unroll
                    for (int r = 0; r < 16; ++r) { const int chl = (r & 3) + 8 * (r >> 2) + 4 * hi;
                        const float dl = 3.0701134573253946f + 12.280453829301578f * ((float)(c0 + mb * 32 + chl) * (1.0f / 2047.0f));
                        const float kv = tpos >= L ? 0.f : acc[nb][mb][r] * __expf(-tn * dl);
                        *(LAS bf16_t*)(T + chl * PITCH + col * 2) = (bf16_t)(cvt_pk_bf16(kv, 0.f) & 0xffffu); }
                }
                LDS_WAIT(); asm volatile("" ::: "memory");
                const size_t i0 = bank ? (size_t)(2 * L - tw - 64) : (size_t)tw;
#pragma unroll
                for (int k = 0; k < 4; ++k) { const int q = F.lane + 64 * k, ch = q >> 3, seg = q & 7;
                    const u32x4 w = *(const LAS u32x4*)(T + ch * PITCH + seg * 16);
                    *(u32x4*)(KF + (size_t)(c0 + mb * 32 + ch) * (2 * L) + i0 + seg * 8) = w; }
                LDS_WAIT(); asm volatile("" ::: "memory");
            }
        }
    }
}

__device__ __forceinline__ void nr_load(const float* src_lat, const float* src_ctx, const bf16_t* X, bool f32in, int r, int lane, f32x4 (&v)[8]) {
    if (f32in) { const float* xr = (r < M_LAT ? src_lat + (size_t)r * D : src_ctx + (size_t)(r - M_LAT) * D) + 8 * lane;
#pragma unroll
        for (int j = 0; j < 4; ++j) { v[2 * j] = *(const f32x4*)(xr + 512 * j); v[2 * j + 1] = *(const f32x4*)(xr + 512 * j + 4); } }
    else { const bf16_t* xr = X + (size_t)r * D + 8 * lane;
#pragma unroll
        for (int j = 0; j < 4; ++j) { const u32x4 w = *(const u32x4*)(xr + 512 * j);
            v[2 * j] = (f32x4){bflo(w.x), bfhi(w.x), bflo(w.y), bfhi(w.y)}; v[2 * j + 1] = (f32x4){bflo(w.z), bfhi(w.z), bflo(w.w), bfhi(w.w)}; } }
}
struct CtxPend { const float* slab; int ks; const float* gate; const float* bias; const float* base32; };
__device__ __forceinline__ void norm_rows(const Fr& F, const float* src_lat, const float* src_ctx, bf16_t* X, bool f32in, int nrows, const float* g, const float* modl, int sh_off, int sc_off, bf16_t* A, const CtxPend cp) {
    int r = F.gw; if (r >= nrows) return;
    f32x4 v[8]; nr_load(src_lat, src_ctx, X, f32in, r, F.lane, v);
    f32x4 ca[8], cb[8]; int ccond = -1;
    for (;;) {
        const int rn = r + F.ngw; const bool more = rn < nrows;
        f32x4 vn[8];
        if (more) { if (cp.base32 && rn >= M_LAT) nr_load(nullptr, cp.base32, X, true, rn, F.lane, vn); else nr_load(src_lat, src_ctx, X, f32in, rn, F.lane, vn); }
        const int cond = r < M_LAT ? (r >> 14) : 2;
        if (cp.slab && r >= M_LAT) {
            const int rc = r - M_LAT;
#pragma unroll
            for (int j = 0; j < 4; ++j) { const int c = 8 * F.lane + 512 * j;
                f32x4 s0 = {0.f, 0.f, 0.f, 0.f}, s1 = s0;
                for (int kc = 0; kc < cp.ks; ++kc) { const float* sp = cp.slab + ((size_t)kc * 512 + rc) * D + c; s0 += *(const f32x4*)sp; s1 += *(const f32x4*)(sp + 4); }
                if (cp.bias) { s0 += *(const f32x4*)(cp.bias + c); s1 += *(const f32x4*)(cp.bias + c + 4); }
                const f32x4 x0 = v[2 * j] + *(const f32x4*)(cp.gate + c) * s0, x1 = v[2 * j + 1] + *(const f32x4*)(cp.gate + c + 4) * s1;
                u32x4 o; o.x = cvt_pk_bf16(x0.x, x0.y); o.y = cvt_pk_bf16(x0.z, x0.w); o.z = cvt_pk_bf16(x1.x, x1.y); o.w = cvt_pk_bf16(x1.z, x1.w);
                *(u32x4*)(X + (size_t)r * D + c) = o;
                v[2 * j] = (f32x4){bflo(o.x), bfhi(o.x), bflo(o.y), bfhi(o.y)}; v[2 * j + 1] = (f32x4){bflo(o.z), bfhi(o.z), bflo(o.w), bfhi(o.w)}; }
        }
        if (cond != ccond) {
            const float* sh = modl + cond * NMOD + sh_off; const float* sc = modl + cond * NMOD + sc_off;
#pragma unroll
            for (int j = 0; j < 4; ++j)
#pragma unroll
                for (int q = 0; q < 2; ++q) { const int c = 8 * F.lane + 512 * j + 4 * q; ca[2 * j + q] = *(const f32x4*)(g + c) * (*(const f32x4*)(sc + c) + 1.0f); cb[2 * j + q] = *(const f32x4*)(sh + c); }
            ccond = cond;
        }
        float ss = 0.f;
#pragma unroll
        for (int j = 0; j < 8; ++j) ss += (v[j].x * v[j].x + v[j].y * v[j].y) + (v[j].z * v[j].z + v[j].w * v[j].w);
        const float rstd = 1.0f / sqrtf(wave_sum(ss) * (1.0f / D) + NORM_EPS);
#pragma unroll
        for (int j = 0; j < 4; ++j) { const int c = 8 * F.lane + 512 * j; f32x4 y[2];
#pragma unroll
            for (int q = 0; q < 2; ++q) y[q] = (v[2 * j + q] * rstd) * ca[2 * j + q] + cb[2 * j + q];
            u32x4 o; o.x = cvt_pk_bf16(y[0].x, y[0].y); o.y = cvt_pk_bf16(y[0].z, y[0].w); o.z = cvt_pk_bf16(y[1].x, y[1].y); o.w = cvt_pk_bf16(y[1].z, y[1].w);
            *(u32x4*)(A + (size_t)r * D + c) = o; }
        if (!more) break;
        r = rn;
#pragma unroll
        for (int j = 0; j < 8; ++j) v[j] = vn[j];
    }
}
__device__ __forceinline__ void final_norm(const Fr& F, const bf16_t* X, const float* g, float* out) {
    int r = F.gw; if (r >= M_LAT) return;
    f32x4 v[8]; nr_load(nullptr, nullptr, X, false, r, F.lane, v);
    f32x4 gv[8];
#pragma unroll
    for (int j = 0; j < 4; ++j)
#pragma unroll
        for (int q = 0; q < 2; ++q) gv[2 * j + q] = *(const f32x4*)(g + 8 * F.lane + 512 * j + 4 * q);
    for (;;) {
        const int rn = r + F.ngw; const bool more = rn < M_LAT;
        f32x4 vn[8];
        if (more) nr_load(nullptr, nullptr, X, false, rn, F.lane, vn);
        float ss = 0.f;
#pragma unroll
        for (int j = 0; j < 8; ++j) ss += (v[j].x * v[j].x + v[j].y * v[j].y) + (v[j].z * v[j].z + v[j].w * v[j].w);
        const float rstd = 1.0f / sqrtf(wave_sum(ss) * (1.0f / D) + NORM_EPS);
#pragma unroll
        for (int j = 0; j < 4; ++j)
#pragma unroll
            for (int q = 0; q < 2; ++q) { const int c = 8 * F.lane + 512 * j + 4 * q; *(f32x4*)(out + (size_t)r * D + c) = (v[2 * j + q] * rstd) * gv[2 * j + q]; }
        if (!more) break;
        r = rn;
#pragma unroll
        for (int j = 0; j < 8; ++j) v[j] = vn[j];
    }
}

struct ZR { u32x4 m, c, p; };
__device__ __forceinline__ ZR zr_load(const bf16_t* zr  , int ld, int col, bool hp, bool hn) {
    const u32x4 z0 = {0u, 0u, 0u, 0u}; ZR z;
    z.m = hp ? *(const u32x4*)(zr - ld + col) : z0; z.c = *(const u32x4*)(zr + col); z.p = hn ? *(const u32x4*)(zr + ld + col) : z0; return z;
}
__device__ __forceinline__ void w8_load(const float* w, int wld, const float* b, int col, float (&wv)[3][8], float (&bv)[8]) {
#pragma unroll
    for (int k = 0; k < 3; ++k) { const f32x4 a = *(const f32x4*)(w + k * wld + col), c = *(const f32x4*)(w + k * wld + col + 4);
        wv[k][0] = a.x; wv[k][1] = a.y; wv[k][2] = a.z; wv[k][3] = a.w; wv[k][4] = c.x; wv[k][5] = c.y; wv[k][6] = c.z; wv[k][7] = c.w; }
    if (b) { const f32x4 a = *(const f32x4*)(b + col), c = *(const f32x4*)(b + col + 4); bv[0] = a.x; bv[1] = a.y; bv[2] = a.z; bv[3] = a.w; bv[4] = c.x; bv[5] = c.y; bv[6] = c.z; bv[7] = c.w; }
    else {
#pragma unroll
        for (int e = 0; e < 8; ++e) bv[e] = 0.f; }
}
__device__ __forceinline__ void conv3_w(const ZR& z, const float (&wv)[3][8], const float (&bv)[8], float (&out)[8]) {
#pragma unroll
    for (int e = 0; e < 8; ++e) out[e] = BFE(z.m, e) * wv[0][e] + BFE(z.c, e) * wv[1][e] + BFE(z.p, e) * wv[2][e] + bv[e];
}
__device__ __forceinline__ void row_pos(int r, int& tpos, int& Ls) { if (r < M_LAT) { Ls = SEQ; tpos = r & (SEQ - 1); } else { Ls = CTXL; tpos = (r - M_LAT) & (CTXL - 1); } }
__device__ __forceinline__ bf16_t* vt_addr(bf16_t* VT, bf16_t* VTC, int r0, int ch) {
    if (r0 < M_LAT) return VT + ((size_t)((r0 >> 14) * D + ch) * SEQ + (r0 & (SEQ - 1)));
    const int q = r0 - M_LAT; return VTC + ((size_t)((q >> 8) * D + ch) * CTXL + (q & (CTXL - 1)));
}
__device__ __forceinline__ u32x4 pack8(const float (&y)[8]) { u32x4 o; o.x = cvt_pk_bf16(y[0], y[1]); o.y = cvt_pk_bf16(y[2], y[3]); o.z = cvt_pk_bf16(y[4], y[5]); o.w = cvt_pk_bf16(y[6], y[7]); return o; }

__device__ __forceinline__ void hy_elem_phase(const Fr& F, const bf16_t* Z, const float* sw, const float* sb, bf16_t* VT, bf16_t* VTC, int nrows) {
    LAS float* T0 = (LAS float*)F.lds;
    int par = 0;
    const int ntiles = (nrows / 64) * 32, tt = F.tid >> 3, cg = F.tid & 7;
    int tile = F.blk; if (tile >= ntiles) return;
    float w1[3][8], b1[8], w2[3][8], b2[8]; int cw = -1;
    ZR za, zb;
    { const int r = (tile >> 5) * 64 + tt, c = (tile & 31) * 64 + 8 * cg; int tpos, Ls; row_pos(r, tpos, Ls); const bf16_t* zr = Z + (size_t)r * (3 * D);
      za = zr_load(zr, 3 * D, D + c, tpos > 0, tpos < Ls - 1); zb = zr_load(zr, 3 * D, 2 * D + c, tpos > 0, tpos < Ls - 1); }
    for (;;) {
        LAS float* T = T0 + par * (64 * 65); par ^= 1;
        const int r0 = (tile >> 5) * 64, c0 = (tile & 31) * 64, c = c0 + 8 * cg;
        const int nt = tile + F.nblk; const bool more = nt < ntiles;
        ZR na = za, nb = zb;
        if (more) { const int r = (nt >> 5) * 64 + tt, cn = (nt & 31) * 64 + 8 * cg; int tpos, Ls; row_pos(r, tpos, Ls); const bf16_t* zr = Z + (size_t)r * (3 * D);
            na = zr_load(zr, 3 * D, D + cn, tpos > 0, tpos < Ls - 1); nb = zr_load(zr, 3 * D, 2 * D + cn, tpos > 0, tpos < Ls - 1); }
        if (c != cw) { w8_load(sw, 3 * D, sb, D + c, w1, b1); w8_load(sw, 3 * D, sb, 2 * D + c, w2, b2); cw = c; }
        float x1[8], vv[8];
        conv3_w(za, w1, b1, x1); conv3_w(zb, w2, b2, vv);
#pragma unroll
        for (int e = 0; e < 8; ++e) T[tt * 65 + 8 * cg + e] = vv[e] * x1[e];
        __syncthreads();
        { const int ch = F.tid >> 3, chunk = F.tid & 7; float y[8];
#pragma unroll
          for (int i = 0; i < 8; ++i) y[i] = T[(8 * chunk + i) * 65 + ch];
          *(u32x4*)(vt_addr(VT, VTC, r0, c0 + ch) + 8 * chunk) = pack8(y); }
        if (!more) break;
        tile = nt; za = na; zb = nb;
    }
}
__device__ __forceinline__ void hy_post_phase(const Fr& F, const bf16_t* Z, const float* sw, const float* sb, bf16_t* VT, bf16_t* VTC, bf16_t* A, int nrows) {
    LAS float* T0 = (LAS float*)F.lds;
    int par = 0;
    const int ntiles = (nrows / 64) * 32, tt = F.tid >> 3, cg = F.tid & 7;
    int tile = F.blk; if (tile >= ntiles) return;
    float w0[3][8], b0[8]; int cw = -1;
    ZR za; u32x4 yv;
    { const int r0 = (tile >> 5) * 64, c0 = (tile & 31) * 64, r = r0 + tt; int tpos, Ls; row_pos(r, tpos, Ls);
      za = zr_load(Z + (size_t)r * (3 * D), 3 * D, c0 + 8 * cg, tpos > 0, tpos < Ls - 1); yv = *(const u32x4*)(vt_addr(VT, VTC, r0, c0 + (F.tid >> 3)) + 8 * (F.tid & 7)); }
    for (;;) {
        LAS float* T = T0 + par * (64 * 65); par ^= 1;
        const int r0 = (tile >> 5) * 64, c0 = (tile & 31) * 64, r = r0 + tt, c = c0 + 8 * cg;
        const int nt = tile + F.nblk; const bool more = nt < ntiles;
        ZR na = za; u32x4 yn = yv;
        if (more) { const int r0n = (nt >> 5) * 64, c0n = (nt & 31) * 64, rn = r0n + tt; int tpos, Ls; row_pos(rn, tpos, Ls);
            na = zr_load(Z + (size_t)rn * (3 * D), 3 * D, c0n + 8 * cg, tpos > 0, tpos < Ls - 1); yn = *(const u32x4*)(vt_addr(VT, VTC, r0n, c0n + (F.tid >> 3)) + 8 * (F.tid & 7)); }
        { const int ch = F.tid >> 3, chunk = F.tid & 7;
#pragma unroll
          for (int i = 0; i < 8; ++i) T[(8 * chunk + i) * 65 + ch] = BFE(yv, i); }
        __syncthreads();
        if (c != cw) { w8_load(sw, 3 * D, sb, c, w0, b0); cw = c; }
        float x0[8], y[8];
        conv3_w(za, w0, b0, x0);
#pragma unroll
        for (int e = 0; e < 8; ++e) y[e] = T[tt * 65 + 8 * cg + e] * x0[e];
        *(u32x4*)(A + (size_t)r * D + c) = pack8(y);
        if (!more) break;
        tile = nt; za = na; yv = yn;
    }
}
struct SC7 { u32x4 gb, gcm, gcc, gcp, xvm, xvc, xvp; };
__device__ __forceinline__ SC7 sc_load(const bf16_t* Z, int r, int c) {
    int tpos, Ls; row_pos(r, tpos, Ls); const bf16_t* zr = Z + (size_t)r * (3 * D); const bool hp = tpos > 0, hn = tpos < Ls - 1; const u32x4 z0 = {0u, 0u, 0u, 0u};
    SC7 s; s.gb = *(const u32x4*)(zr + c); s.gcc = *(const u32x4*)(zr + D + c); s.xvc = *(const u32x4*)(zr + 2 * D + c);
    s.gcm = hp ? *(const u32x4*)(zr - 3 * D + D + c) : z0; s.xvm = hp ? *(const u32x4*)(zr - 3 * D + 2 * D + c) : z0;
    s.gcp = hn ? *(const u32x4*)(zr + 3 * D + D + c) : z0; s.xvp = hn ? *(const u32x4*)(zr + 3 * D + 2 * D + c) : z0; return s;
}
__device__ __forceinline__ void sc_elem_phase(const Fr& F, const bf16_t* Z, const float* cw  , bf16_t* A, int nrows) {
    const size_t nitems = (size_t)nrows * 256, step = (size_t)F.nblk * NTHREADS;
    size_t idx = (size_t)F.blk * NTHREADS + F.tid; if (idx >= nitems) return;
    float wv[3][8], bv[8]; int cl = -1;
    SC7 s = sc_load(Z, (int)(idx >> 8), 8 * (int)(idx & 255));
    for (;;) {
        const int r = (int)(idx >> 8), c = 8 * (int)(idx & 255);
        const size_t nx = idx + step; const bool more = nx < nitems;
        SC7 sn = s; if (more) sn = sc_load(Z, (int)(nx >> 8), 8 * (int)(nx & 255));
        if (c != cl) { w8_load(cw, D, nullptr, c, wv, bv); cl = c; }
        float y[8];
#pragma unroll
        for (int e = 0; e < 8; ++e) { const float pm = BFE(s.gcm, e) * BFE(s.xvm, e), pc = BFE(s.gcc, e) * BFE(s.xvc, e), pp = BFE(s.gcp, e) * BFE(s.xvp, e);
            y[e] = BFE(s.gb, e) * (pm * wv[0][e] + pc * wv[1][e] + pp * wv[2][e]); }
        *(u32x4*)(A + (size_t)r * D + c) = pack8(y);
        if (!more) break;
        idx = nx; s = sn;
    }
}
__device__ __forceinline__ void qk_prep_phase(const Fr& F, const bf16_t* Z  , const float* qg, const float* kg, bf16_t* Q, bf16_t* KALL, bf16_t* VALL) {
    const int p = F.lane;
    constexpr float QSC = 0.088388347648318440f * 1.4426950408889634f;
    const float qg1 = qg[2 * p] * QSC, qg2 = qg[2 * p + 1] * QSC, kg1 = kg[2 * p], kg2 = kg[2 * p + 1];
    const float invf = exp2f(-(float)(p & 31) * (13.287712379549449f / 32.0f));
    int r = F.gw; if (r >= M_ALL) return;
    unsigned w[24];
#pragma unroll
    for (int h = 0; h < 24; ++h) w[h] = *(const unsigned*)(Z + (size_t)r * 3072 + h * HD + 2 * p);
    for (;;) {
        const int rn = r + F.ngw; const bool more = rn < M_ALL;
        unsigned wn[24];
        if (more) {
#pragma unroll
            for (int h = 0; h < 24; ++h) wn[h] = *(const unsigned*)(Z + (size_t)rn * 3072 + h * HD + 2 * p); }
        const bool lat = r < M_LAT; const int b = lat ? (r >> 14) : ((r - M_LAT) >> 8), t = lat ? (r & (SEQ - 1)) : ((r - M_LAT) & (CTXL - 1));
        float cs = 1.f, sn = 0.f;
        if (lat) { const float ang = (float)(p < 32 ? (t >> 6) : (t & 63)) * invf; sn = sinf(ang); cs = cosf(ang); }
        if (lat) {
#pragma unroll
            for (int h = 0; h < NH; ++h) { const float x1 = bflo(w[h]), x2 = bfhi(w[h]);
                const float rstd = 1.0f / sqrtf(wave_sum(x1 * x1 + x2 * x2) * (1.0f / HD) + NORM_EPS);
                const float y1 = x1 * rstd * qg1, y2 = x2 * rstd * qg2;
                *(unsigned*)(Q + (size_t)r * D + h * HD + 2 * p) = cvt_pk_bf16(y1 * cs - y2 * sn, y1 * sn + y2 * cs); }
        }
        const size_t kpos = (size_t)(lat ? t : SEQ + t);
#pragma unroll
        for (int h = 0; h < NKV; ++h) { const float x1 = bflo(w[NH + h]), x2 = bfhi(w[NH + h]);
            const float rstd = 1.0f / sqrtf(wave_sum(x1 * x1 + x2 * x2) * (1.0f / HD) + NORM_EPS);
            const float y1 = x1 * rstd * kg1, y2 = x2 * rstd * kg2;
            const size_t ko = (((size_t)b * NKV + h) * LK + kpos) * HD + 2 * p;
            *(unsigned*)(KALL + ko) = cvt_pk_bf16(y1 * cs - y2 * sn, y1 * sn + y2 * cs);
            *(unsigned*)(VALL + ko) = w[NH + NKV + h]; }
        if (!more) break;
        r = rn;
#pragma unroll
        for (int h = 0; h < 24; ++h) w[h] = wn[h];
    }
}
__device__ __forceinline__ void hy_ctx_conv(const Fr& F, const float* KFC  , const float* skip, bf16_t* VTC  ) {
    LAS float* kp = (LAS float*)(F.lds + F.wave * 4096);
    LAS float* us = kp + 512;
    for (int pr = F.gw; pr < NB * D; pr += F.ngw) {
        const int c = pr & (D - 1);
        const float* kf = KFC + (size_t)c * 512; bf16_t* up = VTC + (size_t)pr * CTXL;
        *(LAS f32x4*)(kp + 4 * F.lane) = *(const f32x4*)(kf + 4 * F.lane); *(LAS f32x4*)(kp + 256 + 4 * F.lane) = *(const f32x4*)(kf + 256 + 4 * F.lane);
        const u32x2 uw = *(const u32x2*)(up + 4 * F.lane);
        *(LAS f32x4*)(us + 4 * F.lane) = (f32x4){bflo(uw.x), bfhi(uw.x), bflo(uw.y), bfhi(uw.y)};
        LDS_WAIT(); asm volatile("" ::: "memory");
        float acc[4] = {0.f, 0.f, 0.f, 0.f};
#pragma unroll 4
        for (int s = 0; s < CTXL; ++s) { const float u = us[s];
#pragma unroll
            for (int q = 0; q < 4; ++q) acc[q] += kp[(F.lane + 64 * q - s) & 511] * u; }
        const float sk = skip[c];
#pragma unroll
        for (int q = 0; q < 4; ++q) { const int t = F.lane + 64 * q; up[t] = (bf16_t)(cvt_pk_bf16(acc[q] + sk * us[t], 0.f) & 0xffffu); }
        LDS_WAIT(); asm volatile("" ::: "memory");
    }
}
#ifndef PROBE_AMP
#define PROBE_AMP 0
#define PROBE_MASK 0ull
#endif
#ifndef PROBE_CYCLES
#define PROBE_CYCLES 0
#endif
#ifndef STAG_GU
#define STAG_GU 0
#define STAG_N 2
#endif
#ifndef STAG_RS
#define STAG_RS 0
#endif
#ifndef EN_DEFAULT
#define EN_DEFAULT 1
#endif
#ifndef EN_PRO
#define EN_PRO EN_DEFAULT
#endif
#ifndef EN_NORM
#define EN_NORM EN_DEFAULT
#endif
#ifndef EN_FILT
#define EN_FILT EN_DEFAULT
#endif
#ifndef EN_G1
#define EN_G1 EN_DEFAULT
#endif
#ifndef EN_HYE
#define EN_HYE EN_DEFAULT
#endif
#ifndef EN_FFT
#define EN_FFT EN_DEFAULT
#endif
#ifndef EN_ATT
#define EN_ATT EN_DEFAULT
#endif
#ifndef EN_G2
#define EN_G2 EN_DEFAULT
#endif
#ifndef EN_G3
#define EN_G3 EN_DEFAULT
#endif
#ifndef EN_G4
#define EN_G4 EN_DEFAULT
#endif
struct Args { const float* in[34]; float* out; unsigned char* ws; int ph_lo, ph_hi; };
static_assert(offsetof(Args, out) == 34 * 8 && offsetof(Args, ws) == 35 * 8, "Args layout");
enum { I_X = 0, I_C, I_CTX, I_CCTX, I_N1G, I_N2G, I_WMOD, I_BMOD, I_FG, I_FU, I_FD, I_HWIN, I_HBIN, I_HSW, I_HSB, I_HFW1, I_HFB1, I_HFW2, I_HFB2, I_HFW3, I_HFB3, I_HFW4, I_HFREQ, I_HSKIP, I_HWOUT, I_HBOUT,
       I_SWIN, I_SCW, I_SWOUT, I_AQKV, I_AQG, I_AKG, I_AWO, I_FING };

__device__ __forceinline__ WSet wset_of(const Fr& F, int layer) {
    const int kind = layer % 3, j = layer / 3; WSet w;
#define IN_(i) ((const float*)(GAS const float*)F.ka[i])
    w.gate = IN_(I_FG) + (size_t)layer * D * DFF; w.up = IN_(I_FU) + (size_t)layer * D * DFF; w.down = IN_(I_FD) + (size_t)layer * DFF * D; w.nin = kind == 2 ? 3072 : 3 * D;
    if (kind == 0) { w.win = IN_(I_HWIN) + (size_t)j * D * 3 * D; w.wout = IN_(I_HWOUT) + (size_t)j * D * D; }
    else if (kind == 1) { w.win = IN_(I_SWIN); w.wout = IN_(I_SWOUT); }
    else { w.win = IN_(I_AQKV); w.wout = IN_(I_AWO); }
#undef IN_
    return w;
}
__device__ __forceinline__ void hy_fft_phase(const Fr& F, const bf16_t* KF  , const float* skip, bf16_t* VT  , float* KSP  , bool conv) {
    LAS f32x2* L = (LAS f32x2*)F.lds;
    const int t = F.tid;
    int it1 = F.gw, it2 = F.gw; LAS float* scr = (LAS float*)(F.lds + F.wave * 16384);
#pragma unroll 1
    for (int c = F.blk; c < D; c += F.nblk) {
        float* K = KSP + (size_t)F.blk * (66 * 512);
        unsigned un[16];
        {
            cf v[32]; const bf16_t* kf = KF + (size_t)c * (2 * SEQ); unsigned ut = (unsigned)t; FFT_OPAQUE(ut);
#pragma unroll
            for (int n1 = 0; n1 < 32; ++n1) { const unsigned w = *(const unsigned*)(kf + (1024 * n1 + 2 * ut)); v[n1] = cf{bflo(w), bfhi(w)}; }
            fft_f1(L, t, v); __syncthreads(); fft_f2(L, t); __syncthreads();
            {   unsigned ut = (unsigned)t; FFT_OPAQUE(ut); const bf16_t* up0 = VT + (size_t)c * SEQ;
#pragma unroll
                for (int n1 = 0; n1 < 16; ++n1) un[n1] = *(const unsigned*)(up0 + (1024 * n1 + 2 * ut)); }
            fft_p3<LAS f32x2*, false>(L, t); __syncthreads();
            { float Kz[66]; fft_pair<LAS f32x2*, 0>(L, t, K, Kz); } __syncthreads();
        }
        const float sk = skip[c];
#pragma unroll 1
        for (int b = 0; b < NB; ++b) {
            bf16_t* up = VT + (size_t)(b * D + c) * SEQ;
            unsigned uw[16];
#pragma unroll
            for (int n1 = 0; n1 < 16; ++n1) uw[n1] = un[n1];
            {   cf v[32];
#pragma unroll
                for (int n1 = 0; n1 < 16; ++n1) v[n1] = cf{bflo(uw[n1]), bfhi(uw[n1])};
#pragma unroll
                for (int n1 = 16; n1 < 32; ++n1) v[n1] = cf{0.f, 0.f};
                fft_f1(L, t, v); }
            __syncthreads(); fft_f2(L, t); __syncthreads();
            float Kr[66]; fft_kload(K, t, Kr);
            fft_p3<LAS f32x2*, false>(L, t); __syncthreads();
            fft_pair<LAS f32x2*, 1>(L, t, K, Kr); __syncthreads();
            if (b + 1 < NB) { unsigned ut = (unsigned)t; FFT_OPAQUE(ut); const bf16_t* upn = VT + (size_t)((b + 1) * D + c) * SEQ;
#pragma unroll
                for (int n1 = 0; n1 < 16; ++n1) un[n1] = *(const unsigned*)(upn + (1024 * n1 + 2 * ut)); }
            fft_p3<LAS f32x2*, true>(L, t); __syncthreads(); fft_i2(L, t); __syncthreads();
            {   unsigned ut = (unsigned)t; FFT_OPAQUE(ut);
#pragma unroll
                for (int n1 = 0; n1 < 16; ++n1) uw[n1] = *(const unsigned*)(up + (1024 * n1 + 2 * ut));
                cf v[32]; fft_i1(L, t, v);
#pragma unroll
                for (int n1 = 0; n1 < 16; ++n1) *(unsigned*)(up + (1024 * n1 + 2 * ut)) = cvt_pk_bf16(v[n1].x * (1.0f / 131072.0f) + sk * bflo(uw[n1]), v[n1].y * (1.0f / 131072.0f) + sk * bfhi(uw[n1])); }
        }
        if (conv) {
            __syncthreads();
            { const WSet w1 = wset_of(F, 1); wconv_part(F, w1, F.ws + w_slot_off(1), scr, it1, 2); }
            { const WSet w2 = wset_of(F, 2); wconv_part(F, w2, F.ws + w_slot_off(2), scr, it2, 2); }
            __syncthreads();
        }
    }
    __syncthreads();
    if (conv) {
        { const WSet w1 = wset_of(F, 1); wconv_part(F, w1, F.ws + w_slot_off(1), scr, it1, 1 << 30); }
        { const WSet w2 = wset_of(F, 2); wconv_part(F, w2, F.ws + w_slot_off(2), scr, it2, 1 << 30); }
        __syncthreads();
    }
}

__device__ __forceinline__ Fr fr_fresh(const Fr& F0) {
    Fr G = F0; int t = threadIdx.x; asm volatile("" : "+v"(t));
    G.tid = t; G.lane = t & 63; G.wave = __builtin_amdgcn_readfirstlane(t >> 6); G.gw = G.blk * NWAVES + G.wave;
    unsigned long long kv = (unsigned long long)__builtin_amdgcn_kernarg_segment_ptr(); asm volatile("" : "+s"(kv));
    G.ka = (const __attribute__((address_space(4))) unsigned long long*)kv; G.ws = (unsigned char*)(GAS unsigned char*)G.ka[35];
    return G;
}
__global__ void __launch_bounds__(NTHREADS, 2) dit_fwd(Args args) {
    extern __shared__ __attribute__((aligned(16))) unsigned char lds_raw[];
    Fr F0;
    F0.lds = (LAS unsigned char*)lds_raw; F0.ldsg = lds_raw;
    F0.tid = threadIdx.x; F0.lane = F0.tid & 63; F0.wave = __builtin_amdgcn_readfirstlane(F0.tid >> 6);
    F0.blk = blockIdx.x; F0.nblk = gridDim.x; F0.gw = F0.blk * NWAVES + F0.wave; F0.ngw = F0.nblk * NWAVES;
    F0.ka = nullptr; F0.ws = args.ws;
    const int lo = args.ph_lo, hi = args.ph_hi;
    if (F0.tid < 4) ((LAS unsigned*)(F0.lds + LDS_BARW))[F0.tid] = 0u;
    __syncthreads();
    XcdBarrier bar; bar.bar = (unsigned*)(args.ws + WS_CTL) + CW_BAR; bar.x = 0; bar.st = (volatile LAS unsigned*)(F0.lds + LDS_BARW);
    if (hi - lo > 1) bar = xcd_barrier_post((unsigned*)(args.ws + WS_CTL) + CW_BAR, (volatile LAS unsigned*)(F0.lds + LDS_BARW));
    int ph = 0;
#if PROBE_AMP
    unsigned long long pr_acc = 0, pr_t0 = __builtin_amdgcn_s_memrealtime();
#define PH_IF if ((pr_t0 = __builtin_amdgcn_s_memrealtime(), true) && ph >= lo && ph < hi) if (Fr F = fr_fresh(F0); true)
#if PROBE_CYCLES
#undef PH_IF
#define PH_IF if ((pr_t0 = (unsigned long long)clock64(), true) && ph >= lo && ph < hi) if (Fr F = fr_fresh(F0); true)
#define PH_END do { if (ph >= lo && ph + 1 < hi) xcd_barrier(bar); if ((PROBE_MASK >> ph) & 1ull) pr_acc += ((unsigned long long)clock64() - pr_t0) / 24ull; ++ph; } while (0)
#else
#define PH_END do { if (ph >= lo && ph + 1 < hi) xcd_barrier(bar); if ((PROBE_MASK >> ph) & 1ull) pr_acc += __builtin_amdgcn_s_memrealtime() - pr_t0; ++ph; } while (0)
#endif
#else
#define PH_IF if (ph >= lo && ph < hi) if (Fr F = fr_fresh(F0); true)
#define PH_END do { if (ph >= lo && ph + 1 < hi) xcd_barrier(bar); ++ph; } while (0)
#endif
#define IN(i) ((const float*)(GAS const float*)F.ka[i])
#define MOD ((float*)(F.ws + WS_MOD))
#define HDN ((float*)(F.ws + WS_HDN))
#define KFC ((float*)(F.ws + WS_KFC))
#define VTC ((bf16_t*)(F.ws + WS_VTC))
#define XRES ((bf16_t*)(F.ws + WS_XRES))
#define XRES_CTX (XRES + (size_t)M_LAT * D)
#define ABUF ((bf16_t*)(F.ws + WS_A))
#define ZBUF ((bf16_t*)(F.ws + WS_Z))
#define WSLOT(l) (F.ws + w_slot_off(l))
#define WGU ((bf16_t*)(WSLOT(layer) + WO_GU))
#define WD ((bf16_t*)(WSLOT(layer) + WO_D))
#define WIN ((bf16_t*)(WSLOT(layer) + WO_IN))
#define WOUT ((bf16_t*)(WSLOT(layer) + WO_OUT))
#define VT ((bf16_t*)(F.ws + WS_VT))
#define KF ((bf16_t*)(F.ws + WS_KF))
#define KALL ((bf16_t*)(F.ws + WS_KALL))
#define VALL ((bf16_t*)(F.ws + WS_VALL))
#define SLAB ((float*)(F.ws + WS_SLAB))
#define MODL (MOD + (size_t)layer * 3 * NMOD)
#define SRC_LAT (layer == 0 ? IN(I_X) : (const float*)nullptr)
#define SRC_CTX (layer == 0 ? IN(I_CTX) : (const float*)nullptr)
#define HY_SW (IN(I_HSW) + (size_t)j * 3 * 3 * D)
#define HY_SB (IN(I_HSB) + (size_t)j * 3 * D)

    PH_IF {
#if EN_PRO
        adaln_phase(F, IN(I_C), IN(I_CCTX), IN(I_WMOD), IN(I_BMOD), MOD);
        hdn_phase(F, IN(I_HFW1), IN(I_HFB1), IN(I_HFW2), IN(I_HFB2), IN(I_HFW3), IN(I_HFB3), IN(I_HFREQ), HDN);
#endif
    }
    PH_END;

#pragma unroll 1
    for (int layer = 0; layer < 4; ++layer) {
        const int kind = layer % 3, j = layer / 3;
        const int rows_n1 = layer <= 2 ? M_ALL : M_LAT;
        const int rows_full = layer <= 1 ? M_ALL : M_LAT;
        const int nin = kind == 2 ? 3072 : 3 * D;
        PH_IF {
#if EN_NORM
            CtxPend cp{nullptr, 0, nullptr, nullptr, nullptr};
            if (layer == 1 || layer == 2) cp = CtxPend{SLAB, 11, MOD + (size_t)(layer - 1) * 3 * NMOD + 2 * NMOD + 5 * D, nullptr, nullptr};
            norm_rows(F, SRC_LAT, SRC_CTX, XRES, layer == 0, rows_n1, IN(I_N1G) + layer * D, MODL, 0, D, ABUF, cp);
            if (layer == 0) { const WSet w = wset_of(F, 0); wconv_layer(F, w, WSLOT(0)); }
#endif
#if EN_FILT
            if (kind == 0) {
                hy_filt_long(F, HDN + (size_t)j * (SEQ + CTXL) * 64, IN(I_HFW4) + (size_t)j * 64 * 2 * D, KF, F.blk, F.nblk);
                if (layer == 0) hy_filt_tiles(F, HDN + ((size_t)j * (SEQ + CTXL) + SEQ) * 64, IN(I_HFW4) + (size_t)j * 64 * 2 * D, KFC, CTXL, F.blk, F.nblk);
                __syncthreads();
            }
#endif
        }
        PH_END;
        PH_IF {
#if EN_G1
            pg8::Gemm g{ABUF, WIN, rows_n1, nin, D, D}; pg8::StaticOrder S; S.init(rows_n1, nin, F.nblk, F.blk);
            pg8::EpiStoreBf16 E{ZBUF, nin, kind == 0 ? IN(I_HBIN) + (size_t)j * 3 * D : nullptr};
            pg8::gemm_phase<pg8::EpiStoreBf16, pg8::StaticOrder>(F.lds, g, S, E, nullptr);
#endif
        }
        PH_END;
        if (kind == 0) {
            PH_IF {
#if EN_HYE
                hy_elem_phase(F, ZBUF, HY_SW, HY_SB, VT, VTC, rows_full);
#endif
            }
            PH_END;
            PH_IF {
#if EN_FFT
                hy_fft_phase(F, KF, IN(I_HSKIP) + j * D, VT, (float*)(F.ws + WS_KSP), layer == 0);
#endif
#if EN_HYE
                if (rows_full > M_LAT) hy_ctx_conv(F, KFC, IN(I_HSKIP) + j * D, VTC);
#endif
            }
            PH_END;
            PH_IF {
#if EN_HYE
                hy_post_phase(F, ZBUF, HY_SW, HY_SB, VT, VTC, ABUF, rows_full);
#endif
            }
            PH_END;
        } else if (kind == 1) {
            PH_IF {
#if EN_HYE
                sc_elem_phase(F, ZBUF, IN(I_SCW), ABUF, rows_full);
#endif
            }
            PH_END;
        } else {
            PH_IF {
#if EN_HYE
                qk_prep_phase(F, ZBUF, IN(I_AQG), IN(I_AKG), VT  , KALL, VALL);
#endif
            }
            PH_END;
            PH_IF {
#if EN_ATT
                const float gqm = wave_max(fmaxf(fabsf(IN(I_AQG)[F.lane]), fabsf(IN(I_AQG)[F.lane + 64]))), gkm = wave_max(fmaxf(fabsf(IN(I_AKG)[F.lane]), fabsf(IN(I_AKG)[F.lane + 64])));
                const bool nomax = 16.33f * gqm * gkm < ATT_NOMAX_BOUND;
                int it3 = F.gw;
                for (int unit = F.blk; unit < NB * NH * (SEQ / 256); unit += F.nblk) {
                    const int bk = unit >> 8, b = bk >> 2, kvh = bk & 3, g = (unit >> 6) & 3, qb = unit & 63, h = kvh * 4 + g;
                    const size_t qo = ((size_t)(b * SEQ + qb * 256)) * D + h * HD, ko = ((size_t)b * NKV + kvh) * LK * HD;
                    if (nomax) att::attn_dense_body<att::bf16, true>(VT + qo, KALL + ko, VALL + ko, ABUF + qo, LK, (char*)F.ldsg);
                    else att::attn_dense_body<att::bf16, false>(VT + qo, KALL + ko, VALL + ko, ABUF + qo, LK, (char*)F.ldsg);
                    __syncthreads();
                    {   const Fr Fs = fr_fresh(F0);
                        LAS float* scr2 = (LAS float*)(Fs.lds + 67584 + Fs.wave * 8448);
                        { const WSet w3 = wset_of(Fs, 3); wconv_part(Fs, w3, Fs.ws + w_slot_off(3), scr2, it3, 2); }
                    }
                }
                { const Fr Fe = fr_fresh(F0); LAS float* scr3 = (LAS float*)(Fe.lds + 67584 + Fe.wave * 8448);
                  const WSet w3 = wset_of(Fe, 3); wconv_part(Fe, w3, Fe.ws + w_slot_off(3), scr3, it3, 1 << 30); }
#endif
            }
            PH_END;
        }
        PH_IF {
#if EN_G2
            pg8::Gemm g{ABUF, WOUT, M_LAT, D, D, D}; pg8::StaticOrder S; S.init(M_LAT, D, F.nblk, F.blk);
            const float* bias = kind == 0 ? IN(I_HBOUT) + j * D : nullptr;
            pg8::EpiResid E{SRC_LAT, SRC_CTX, XRES, bias, MODL + 2 * D};
#if STAG_RS
            { const int grp = (F.blk >> 3) & (STAG_N - 1); if (grp) { const unsigned long long t1 = __builtin_amdgcn_s_memrealtime(); while (__builtin_amdgcn_s_memrealtime() - t1 < (unsigned long long)(grp * STAG_RS)) __builtin_amdgcn_s_sleep(2); } }
#endif
            pg8::gemm_phase<pg8::EpiResid, pg8::StaticOrder>(F.lds, g, S, E, nullptr);
            if (rows_full > M_LAT) {
                pg8::Gemm gc{ABUF, WOUT, M_ALL, D, 256, D}; pg8::CtxSplitOrder Sc; Sc.init(D, 8, F.nblk, F.blk);
                pg8::EpiSlab Ec{SLAB};
                pg8::gemm_phase<pg8::EpiSlab, pg8::CtxSplitOrder>(F.lds, gc, Sc, Ec, nullptr);
            }
#endif
        }
        PH_END;
        PH_IF {
#if EN_NORM
            CtxPend cp{nullptr, 0, nullptr, nullptr, nullptr};
            if (rows_full > M_LAT) cp = CtxPend{SLAB, 8, MODL + 2 * NMOD + 2 * D, kind == 0 ? IN(I_HBOUT) + j * D : nullptr, layer == 0 ? IN(I_CTX) : nullptr};
            norm_rows(F, nullptr, nullptr, XRES, false, rows_full, IN(I_N2G) + layer * D, MODL, 3 * D, 4 * D, ABUF, cp);
#endif
        }
        PH_END;
        PH_IF {
#if EN_G3
            pg8::Gemm g{ABUF, WGU, rows_full, 2 * DFF, D, D}; pg8::StaticOrder S; S.init(rows_full, 2 * DFF, F.nblk, F.blk);
            pg8::EpiSwiGLU E{ZBUF, DFF};
#if STAG_GU
            { const int grp = (F.blk >> 3) & (STAG_N - 1); if (grp) { const unsigned long long t1 = __builtin_amdgcn_s_memrealtime(); while (__builtin_amdgcn_s_memrealtime() - t1 < (unsigned long long)(grp * STAG_GU)) __builtin_amdgcn_s_sleep(2); } }
#endif
            pg8::gemm_phase<pg8::EpiSwiGLU, pg8::StaticOrder>(F.lds, g, S, E, nullptr);
#endif
        }
        PH_END;
        PH_IF {
#if EN_G4
            pg8::Gemm g{ZBUF, WD, M_LAT, D, DFF, DFF}; pg8::StaticOrder S; S.init(M_LAT, D, F.nblk, F.blk);
            pg8::EpiResid E{nullptr, nullptr, XRES, nullptr, MODL + 5 * D};
#if STAG_RS
            { const int grp = (F.blk >> 3) & (STAG_N - 1); if (grp) { const unsigned long long t1 = __builtin_amdgcn_s_memrealtime(); while (__builtin_amdgcn_s_memrealtime() - t1 < (unsigned long long)(grp * STAG_RS)) __builtin_amdgcn_s_sleep(2); } }
#endif
            pg8::gemm_phase<pg8::EpiResid, pg8::StaticOrder>(F.lds, g, S, E, nullptr);
            if (rows_full > M_LAT) {
                pg8::Gemm gc{ZBUF, WD, M_ALL, D, 512, DFF}; pg8::CtxSplitOrder Sc; Sc.init(D, 11, F.nblk, F.blk);
                pg8::EpiSlab Ec{SLAB};
                pg8::gemm_phase<pg8::EpiSlab, pg8::CtxSplitOrder>(F.lds, gc, Sc, Ec, nullptr);
            }
#endif
        }
        PH_END;
    }
    PH_IF {
#if EN_NORM
        final_norm(F, XRES, IN(I_FING), (float*)IN(34));
#endif
    }
    PH_END;
#if PROBE_AMP
    { const unsigned long long t1 = __builtin_amdgcn_s_memrealtime(); while (__builtin_amdgcn_s_memrealtime() - t1 < (unsigned long long)PROBE_AMP * pr_acc) __builtin_amdgcn_s_sleep(8); }
#endif
#undef PH_IF
#undef PH_END
}

extern "C" void kernel_launch(void* const* d_in, const int* in_sizes, int n_in, void* d_out, int out_size, void* d_ws, size_t ws_size, hipStream_t stream) {
    static int grid = 0;
    if (grid == 0) {
        if (n_in != 34 || in_sizes[0] != M_LAT * D || out_size != M_LAT * D || ws_size < WS_END) {
            fprintf(stderr, "kernel_launch: shape mismatch: n_in %d in0 %d out %d ws %zu (need >= %zu); nothing launched\n", n_in, n_in > 0 ? in_sizes[0] : -1, out_size, ws_size, (size_t)WS_END); grid = -1; return; }
        int dev = 0, cus = 0, per_cu = 0;
        if (hipGetDevice(&dev) != hipSuccess || hipDeviceGetAttribute(&cus, hipDeviceAttributeMultiprocessorCount, dev) != hipSuccess) { fprintf(stderr, "kernel_launch: device query failed\n"); grid = -1; return; }
        if (hipFuncSetAttribute((const void*)dit_fwd, hipFuncAttributeMaxDynamicSharedMemorySize, LDS_BYTES) != hipSuccess) { fprintf(stderr, "kernel_launch: hipFuncSetAttribute failed\n"); grid = -1; return; }
        if (hipOccupancyMaxActiveBlocksPerMultiprocessor(&per_cu, (const void*)dit_fwd, NTHREADS, LDS_BYTES) != hipSuccess || per_cu < 1) {
            fprintf(stderr, "kernel_launch: occupancy query reports %d workgroups per CU; nothing launched\n", per_cu); (void)hipGetLastError(); grid = -1; return; }
        grid = cus;
    }
    if (grid < 0) return;
    if (hipMemsetAsync((char*)d_ws + WS_CTL, 0, CTL_ZERO_BYTES, stream) != hipSuccess) { fprintf(stderr, "kernel_launch: memset failed\n"); return; }
    Args a{};
    for (int i = 0; i < 34; ++i) a.in[i] = (const float*)d_in[i];
    a.out = (float*)d_out; a.ws = (unsigned char*)d_ws;
#if MK_PER_PHASE_LAUNCH
    for (int p = 0; p < N_PHASES; ++p) { a.ph_lo = p; a.ph_hi = p + 1; hipLaunchKernelGGL(dit_fwd, dim3(grid), dim3(NTHREADS), LDS_BYTES, stream, a); }
#else
    a.ph_lo = 0; a.ph_hi = N_PHASES;
    hipLaunchKernelGGL(dit_fwd, dim3(grid), dim3(NTHREADS), LDS_BYTES, stream, a);
#endif
    const hipError_t le = hipPeekAtLastError();
    if (le != hipSuccess) fprintf(stderr, "kernel_launch: launch failed: %s\n", hipGetErrorName(le));
}
```

```cpp
#include <hip/hip_runtime.h>
#include <cstdio>
#include <cstdint>
#include <cstddef>

#ifndef MK_PER_PHASE_LAUNCH
#define MK_PER_PHASE_LAUNCH 0
#endif

#ifndef EPI_TWICE
#define EPI_TWICE 0
#endif
#ifndef SEGPROBE
#define SEGPROBE 0
#define SEG_EPI 2
#define SEG_AMP 4
#endif
#ifndef RESID_NUP
#define RESID_NUP 0
#endif
#ifndef ATT_VPM
#define ATT_VPM 5
#define ATT_VMASK 0x402
#endif
#ifndef ATT_NOMAX_BOUND
#define ATT_NOMAX_BOUND 90.f
#endif
#define LAS __attribute__((address_space(3)))
#define GAS __attribute__((address_space(1)))
typedef unsigned short bf16_t;
typedef short bf16x8 __attribute__((ext_vector_type(8)));
typedef float f32x4 __attribute__((ext_vector_type(4)));
typedef float f32x2 __attribute__((ext_vector_type(2)));
typedef unsigned u32x4 __attribute__((ext_vector_type(4)));
typedef unsigned u32x2 __attribute__((ext_vector_type(2)));

constexpr int D = 2048, NB = 2, SEQ = 16384, CTXL = 256, DFF = 5632, HD = 128, NH = 16, NKV = 4;
constexpr int M_LAT = NB * SEQ, M_CTX = NB * CTXL, M_ALL = M_LAT + M_CTX;
constexpr int NMOD = 6 * D;
constexpr int LK = SEQ + CTXL;
constexpr float NORM_EPS = 1e-6f;
constexpr int NWAVES = 8, NTHREADS = 512;
constexpr int N_PHASES = 1 + 9 + 7 + 8 + 9 + 1;

constexpr size_t MiB = 1u << 20;
constexpr size_t WS_CTL = 0, CTL_ZERO_BYTES = 1 * MiB;
constexpr size_t WS_MOD = 1 * MiB;
constexpr size_t WS_HDN = 2 * MiB;
constexpr size_t WS_KFC = 11 * MiB;
constexpr size_t WS_VTC = 15 * MiB;
constexpr size_t WS_XRES = 17 * MiB;
constexpr size_t WS_A = 277 * MiB;
constexpr size_t WS_Z = 407 * MiB;
constexpr size_t WS_W = 797 * MiB, W_SLOT = 98 * MiB;
constexpr size_t WO_GU = 0, WO_D = 44 * MiB, WO_IN = 66 * MiB, WO_OUT = 90 * MiB;
constexpr size_t WS_VT = 895 * MiB;
constexpr size_t WS_KF = 1023 * MiB;
constexpr size_t WS_KALL = WS_Z + 200 * MiB, WS_VALL = WS_Z + 240 * MiB;
constexpr size_t WS_SLAB = WS_KF + 128 * MiB;
constexpr size_t WS_KSP = 1279 * MiB;
constexpr size_t WS_W1 = 1319 * MiB;
constexpr size_t WS_END = 1515 * MiB;
__host__ __device__ constexpr size_t w_slot_off(int layer) { return layer == 1 ? WS_W1 : (layer == 2 ? WS_W1 + W_SLOT : WS_W); }
constexpr int CW_BAR = 1024;

__device__ __forceinline__ float bf2f(unsigned short b) { return __uint_as_float(((unsigned)b) << 16); }
__device__ __forceinline__ float bflo(unsigned w) { return __uint_as_float(w << 16); }
__device__ __forceinline__ float bfhi(unsigned w) { return __uint_as_float(w & 0xffff0000u); }
__device__ __forceinline__ unsigned cvt_pk_bf16(float lo, float hi) { unsigned r; asm volatile("v_cvt_pk_bf16_f32 %0, %1, %2" : "=v"(r) : "v"(lo), "v"(hi)); return r; }
__device__ __forceinline__ float wave_sum(float v) {
    v += __int_as_float(__builtin_amdgcn_update_dpp(0, __float_as_int(v), 0xB1, 0xf, 0xf, true));
    v += __int_as_float(__builtin_amdgcn_update_dpp(0, __float_as_int(v), 0x4E, 0xf, 0xf, true));
    v += __int_as_float(__builtin_amdgcn_update_dpp(0, __float_as_int(v), 0x124, 0xf, 0xf, true));
    v += __int_as_float(__builtin_amdgcn_update_dpp(0, __float_as_int(v), 0x128, 0xf, 0xf, true));
    const int i = __float_as_int(v);
    return (__int_as_float(__builtin_amdgcn_readlane(i, 0)) + __int_as_float(__builtin_amdgcn_readlane(i, 16))) + (__int_as_float(__builtin_amdgcn_readlane(i, 32)) + __int_as_float(__builtin_amdgcn_readlane(i, 48)));
}
__device__ __forceinline__ float wave_max(float v) {
    v = fmaxf(v, __int_as_float(__builtin_amdgcn_update_dpp(0, __float_as_int(v), 0xB1, 0xf, 0xf, true)));
    v = fmaxf(v, __int_as_float(__builtin_amdgcn_update_dpp(0, __float_as_int(v), 0x4E, 0xf, 0xf, true)));
    v = fmaxf(v, __int_as_float(__builtin_amdgcn_update_dpp(0, __float_as_int(v), 0x124, 0xf, 0xf, true)));
    v = fmaxf(v, __int_as_float(__builtin_amdgcn_update_dpp(0, __float_as_int(v), 0x128, 0xf, 0xf, true)));
    const int i = __float_as_int(v);
    return fmaxf(fmaxf(__int_as_float(__builtin_amdgcn_readlane(i, 0)), __int_as_float(__builtin_amdgcn_readlane(i, 16))), fmaxf(__int_as_float(__builtin_amdgcn_readlane(i, 32)), __int_as_float(__builtin_amdgcn_readlane(i, 48))));
}
__device__ __forceinline__ float lane_bcast(float v, int k) { return __int_as_float(__builtin_amdgcn_readlane(__float_as_int(v), k)); }
#define LDS_WAIT() asm volatile("s_waitcnt lgkmcnt(0)" ::: "memory")
#define VM_WAIT() asm volatile("s_waitcnt vmcnt(0)" ::: "memory")
#define XB_TMO      128
#define XB_XCNT(j)  (256  + 64 * (j))
#define XB_XSUB(j)  (1280 + 64 * (j))
#define XB_XGEN(j)  (2304 + 64 * (j))
#define XB_TOP      3328
#define XB_TOPGEN   3392
#define XCD_BAR_WORDS 3456
#define XB_SPIN_CAP (1u << 18)

__device__ __forceinline__ unsigned xb_ld(unsigned* p)              { return __hip_atomic_load(p, __ATOMIC_RELAXED, __HIP_MEMORY_SCOPE_AGENT); }
__device__ __forceinline__ unsigned xb_add(unsigned* p, unsigned v) { return __hip_atomic_fetch_add(p, v, __ATOMIC_RELAXED, __HIP_MEMORY_SCOPE_AGENT); }
__device__ __forceinline__ unsigned xb_xcc_id() { return (unsigned)__builtin_amdgcn_s_getreg((3 << 11) | 20) & 0xFu; }
#define XB_SPIN(cond, bar) do { unsigned _sp = 0; while (cond) { __builtin_amdgcn_s_sleep(1); \
    if ((++_sp & 255u) == 0u) { if (xb_ld(&(bar)[XB_TMO])) break; if (_sp > XB_SPIN_CAP) { atomicAdd(&(bar)[XB_TMO], 1u); break; } } } } while (0)

struct XcdBarrier {
    unsigned* bar; unsigned x;
    volatile LAS unsigned* st;
};

__device__ __forceinline__ XcdBarrier xcd_barrier_post(unsigned* bar, volatile LAS unsigned* st) {
    XcdBarrier b; b.bar = bar; b.x = xb_xcc_id(); b.st = st;
    if (threadIdx.x == 0) (void)xb_add(&bar[XB_XCNT(b.x)], 1u);
    return b;
}
__device__ __forceinline__ void xcd_barrier_complete(unsigned* bar, unsigned x, unsigned& nloc, unsigned& nx) {
    const unsigned G = gridDim.x * gridDim.y * gridDim.z;
    unsigned sum, cnt, mine, sp = 0u;
    for (;;) {
        sum = 0u; cnt = 0u; mine = 0u;
#pragma unroll
        for (unsigned j = 0; j < 16; ++j) { const unsigned c = xb_ld(&bar[XB_XCNT(j)]); sum += c; cnt += (c > 0u) ? 1u : 0u; mine = (j == x) ? c : mine; }
        if (sum == G) break;
        __builtin_amdgcn_s_sleep(1);
        if ((++sp & 255u) == 0u) { if (xb_ld(&bar[XB_TMO])) break; if (sp > XB_SPIN_CAP) { atomicAdd(&bar[XB_TMO], 1u); break; } }
    }
    nloc = mine > 0u ? mine : 1u; nx = cnt > 0u ? cnt : 1u;
}

__device__ __forceinline__ void xcd_barrier(const XcdBarrier& b) {
    asm volatile("s_waitcnt vmcnt(0)" ::: "memory");
    __syncthreads();
    if (threadIdx.x == 0) {
        unsigned* bar = b.bar;
        __builtin_amdgcn_s_waitcnt(0);
        unsigned nloc = b.st[0], nx = b.st[1];
        if (nloc == 0u) { xcd_barrier_complete(bar, b.x, nloc, nx); b.st[0] = nloc; b.st[1] = nx; }
        const unsigned old = xb_add(&bar[XB_XSUB(b.x)], 1u);
        const unsigned gen = old / nloc;
        if (old + 1u == (gen + 1u) * nloc) {
            __builtin_amdgcn_fence(__ATOMIC_RELEASE, "agent");
            asm volatile("s_waitcnt vmcnt(0)" ::: "memory");
            const unsigned og = xb_add(&bar[XB_TOP], 1u);
            const unsigned tg = og / nx;
            if (og + 1u == (tg + 1u) * nx) xb_add(&bar[XB_TOPGEN], 1u);
            else XB_SPIN(xb_ld(&bar[XB_TOPGEN]) == tg, bar);
            __builtin_amdgcn_fence(__ATOMIC_ACQUIRE, "agent");
            xb_add(&bar[XB_XGEN(b.x)], 1u);
            asm volatile("s_waitcnt vmcnt(0)" ::: "memory");
        } else {
            XB_SPIN(xb_ld(&bar[XB_XGEN(b.x)]) == gen, bar);
            __builtin_amdgcn_fence(__ATOMIC_ACQUIRE, "agent");
            asm volatile("s_waitcnt vmcnt(0)" ::: "memory");
        }
    }
    __syncthreads();
}
namespace pg8 {
#define PG8_LAS __attribute__((address_space(3)))
typedef unsigned short bf16_t;
typedef short bf16x8 __attribute__((ext_vector_type(8)));
typedef float f32x4 __attribute__((ext_vector_type(4)));
typedef unsigned u32x4 __attribute__((ext_vector_type(4)));
constexpr int BM = 256, BK = 64, HALF = 128, HTB = HALF * BK * 2  , STAGE_BYTES = 8 * HTB, NXCD = 8, WGM = 8;

__host__ __device__ __forceinline__ int lds_byte(int r, int c) { const int st = (r >> 4) * 2 + (c >> 5), rr = r & 15, cc = c & 31, ob = rr * 64 + cc * 2; return st * 1024 + (ob ^ (((ob >> 9) & 1) << 5)); }
__host__ __device__ __forceinline__ void stage_rc(int b, int& R, int& C) { const int st = b / 1024, sb = b % 1024, swz = sb ^ (((sb >> 9) & 1) << 5); R = (st >> 1) * 16 + swz / 64; C = (st & 1) * 32 + (swz % 64) / 2; }
__host__ __device__ __forceinline__ int perm32(int rho) { const int n = rho >> 4, i = rho & 15; return 8 * (i >> 2) + 4 * n + (i & 3); }

struct Unit { int pm, pn, kc; };
struct Gemm { const bf16_t* A; const bf16_t* Bt; int M, N, K, ldk; };

struct StaticOrder {
    int nM, nN, nwg, G, c; float inv_nig;
    __host__ __device__ void init(int M, int N, int G_, int c_) { nM = M / BM; nN = N / BM; nwg = nM * nN; G = G_; c = c_; inv_nig = 1.0f / (float)(WGM * nN); }
    __host__ __device__ bool next(int i, Unit& u) const {
        const int L = i * G + c; if (L >= nwg) return false;
        int wgid = L; { const int q = nwg >> 3, r = nwg & 7, xcd = wgid & 7, off = wgid >> 3; wgid = (xcd < r ? xcd * (q + 1) : r * (q + 1) + (xcd - r) * q) + off; }
        const int nig = WGM * nN, gid = (int)(((float)wgid + 0.5f) * inv_nig), rem = wgid - gid * nig, fm = gid * WGM, gsz = (nM - fm) < WGM ? (nM - fm) : WGM;
        if (gsz == WGM) { u.pm = fm + (rem & 7); u.pn = rem >> 3; }
        else { const int pn = (int)(((float)rem + 0.5f) / (float)gsz); u.pm = fm + rem - pn * gsz; u.pn = pn; }
        u.kc = 0; return true;
    }
    __device__ __forceinline__ void a_ready(const Unit&) const {}
    __device__ __forceinline__ void done(const Unit&) const {}
};
struct CtxSplitOrder {
    int nN, ks, G, c;
    __host__ __device__ void init(int N, int ks_, int G_, int c_) { nN = N / BM; ks = ks_; G = G_; c = c_; }
    __host__ __device__ bool next(int i, Unit& u) const { const int l = i * G + c; if (l >= 2 * nN * ks) return false;
        const int kc = (int)(((float)l + 0.5f) / (float)(2 * nN)), rem = l - kc * 2 * nN, hi = rem >= nN ? 1 : 0; u.kc = kc; u.pm = 128 + hi; u.pn = rem - hi * nN; return true; }
    __device__ __forceinline__ void a_ready(const Unit&) const {}
    __device__ __forceinline__ void done(const Unit&) const {}
};
struct EpiStoreBf16 {
    static constexpr bool PERM = true, AFTER_DRAIN = false; static constexpr int TW = 1;
    bf16_t* O; int ldc; const float* bias;
    __device__ __forceinline__ void operator()(const f32x4 (&acc)[2][2][4][2], const Unit& u, int wr, int wc, int fr, int fq) const {
        const int row0 = u.pm * BM + wr * 64 + fr, col0 = u.pn * BM + wc * 32 + 8 * fq;
        f32x4 bv[2][2];
#pragma unroll
        for (int bj = 0; bj < 2; ++bj)
#pragma unroll
            for (int n = 0; n < 2; ++n) bv[bj][n] = bias ? *(const f32x4*)(bias + col0 + bj * HALF + 4 * n) : (f32x4){0.f, 0.f, 0.f, 0.f};
#pragma unroll
        for (int ai = 0; ai < 2; ++ai)
#pragma unroll
            for (int m = 0; m < 4; ++m) { bf16_t* rowp = O + (size_t)(row0 + ai * HALF + m * 16) * ldc + col0;
#pragma unroll
                for (int bj = 0; bj < 2; ++bj) { const f32x4 v0 = acc[ai][bj][m][0] + bv[bj][0], v1 = acc[ai][bj][m][1] + bv[bj][1];
                    u32x4 w; w.x = cvt_pk_bf16(v0[0], v0[1]); w.y = cvt_pk_bf16(v0[2], v0[3]); w.z = cvt_pk_bf16(v1[0], v1[1]); w.w = cvt_pk_bf16(v1[2], v1[3]);
                    *(u32x4*)(rowp + bj * HALF) = w; } }
    }
};
__device__ __forceinline__ float silu_mul(float g, float u) { return g * u * __builtin_amdgcn_rcpf(1.0f + __builtin_amdgcn_exp2f(-1.4426950408889634f * g)); }
struct EpiSwiGLU {
    static constexpr bool PERM = true, AFTER_DRAIN = false; static constexpr int TW = 2;
    bf16_t* O; int ldc;
    __device__ __forceinline__ void operator()(const f32x4 (&acc)[2][2][4][2], const Unit& u, int wr, int wc, int fr, int fq) const {
        const int row0 = u.pm * BM + wr * 64 + fr, col0 = u.pn * HALF + wc * 32 + 8 * fq;
#pragma unroll
        for (int ai = 0; ai < 2; ++ai)
#pragma unroll
            for (int m = 0; m < 4; ++m) {
                const f32x4 g0 = acc[ai][0][m][0], g1 = acc[ai][0][m][1], u0 = acc[ai][1][m][0], u1 = acc[ai][1][m][1];
                u32x4 w;
                w.x = cvt_pk_bf16(silu_mul(g0[0], u0[0]), silu_mul(g0[1], u0[1])); w.y = cvt_pk_bf16(silu_mul(g0[2], u0[2]), silu_mul(g0[3], u0[3]));
                w.z = cvt_pk_bf16(silu_mul(g1[0], u1[0]), silu_mul(g1[1], u1[1])); w.w = cvt_pk_bf16(silu_mul(g1[2], u1[2]), silu_mul(g1[3], u1[3]));
                *(u32x4*)(O + (size_t)(row0 + ai * HALF + m * 16) * ldc + col0) = w; }
    }
};
struct EpiResid {
    static constexpr bool PERM = true, AFTER_DRAIN = false; static constexpr int TW = 3;
    const float* base32_lat; const float* base32_ctx; bf16_t* xres; const float* bias; const float* gate;
    __device__ __forceinline__ void operator()(const f32x4 (&acc)[2][2][4][2], const Unit& u, int wr, int wc, int fr, int fq) const {
        int rin0 = wr * 64 + fr; asm volatile("" : "+v"(rin0));
        const int col0 = u.pn * BM + wc * 32 + 8 * fq;
        const int cond = u.pm < 64 ? 0 : (u.pm < 128 ? 1 : 2);
        bf16_t* op = xres + (size_t)u.pm * BM * 2048 + col0;
        const float* gp = gate + cond * 12288 + col0;
        if (RESID_NUP && !base32_lat && !bias) {
            constexpr int NUP = RESID_NUP ? RESID_NUP : 1;
            u32x4 b[NUP][2];
#pragma unroll
            for (int am = 0; am < NUP; ++am)
#pragma unroll
                for (int bj = 0; bj < 2; ++bj) b[am][bj] = *(const u32x4*)(op + (size_t)(rin0 + (am >> 2) * HALF + (am & 3) * 16) * 2048 + bj * HALF);
            f32x4 gv[2][2];
#pragma unroll
            for (int bj = 0; bj < 2; ++bj)
#pragma unroll
                for (int n = 0; n < 2; ++n) gv[bj][n] = *(const f32x4*)(gp + bj * HALF + 4 * n);
            asm volatile("" ::: "memory");
#pragma unroll
            for (int am = 0; am < 8; ++am) { const int ai = am >> 2, m = am & 3, sl = am < NUP ? am : am - NUP;
#pragma unroll
                for (int bj = 0; bj < 2; ++bj) { const u32x4 bb = b[sl][bj];
                    const f32x4 b0 = {bflo(bb.x), bfhi(bb.x), bflo(bb.y), bfhi(bb.y)}, b1 = {bflo(bb.z), bfhi(bb.z), bflo(bb.w), bfhi(bb.w)};
                    const f32x4 v0 = b0 + gv[bj][0] * acc[ai][bj][m][0], v1 = b1 + gv[bj][1] * acc[ai][bj][m][1];
                    u32x4 w; w.x = cvt_pk_bf16(v0[0], v0[1]); w.y = cvt_pk_bf16(v0[2], v0[3]); w.z = cvt_pk_bf16(v1[0], v1[1]); w.w = cvt_pk_bf16(v1[2], v1[3]);
                    *(u32x4*)(op + (size_t)(rin0 + ai * HALF + m * 16) * 2048 + bj * HALF) = w; }
                if (am + NUP < 8) { const int an = am + NUP; asm volatile("" ::: "memory");
#pragma unroll
                    for (int bj = 0; bj < 2; ++bj) b[am][bj] = *(const u32x4*)(op + (size_t)(rin0 + (an >> 2) * HALF + (an & 3) * 16) * 2048 + bj * HALF); }
            }
            return;
        }
        f32x4 gv[2][2], bv[2][2];
#pragma unroll
        for (int bj = 0; bj < 2; ++bj)
#pragma unroll
            for (int n = 0; n < 2; ++n) { gv[bj][n] = *(const f32x4*)(gp + bj * HALF + 4 * n); bv[bj][n] = bias ? *(const f32x4*)(bias + col0 + bj * HALF + 4 * n) : (f32x4){0.f, 0.f, 0.f, 0.f}; }
        if (base32_lat) {
            const float* bp = (u.pm < 128 ? base32_lat + (size_t)u.pm * BM * 2048 : base32_ctx + (size_t)(u.pm - 128) * BM * 2048) + col0;
#pragma unroll
            for (int am = 0; am < 8; ++am) { const int ai = am >> 2, m = am & 3; const size_t ro = (size_t)(rin0 + ai * HALF + m * 16) * 2048;
                f32x4 b[2][2];
#pragma unroll
                for (int bj = 0; bj < 2; ++bj)
#pragma unroll
                    for (int n = 0; n < 2; ++n) b[bj][n] = *(const f32x4*)(bp + ro + bj * HALF + 4 * n);
#pragma unroll
                for (int bj = 0; bj < 2; ++bj) { const f32x4 v0 = b[bj][0] + gv[bj][0] * (acc[ai][bj][m][0] + bv[bj][0]), v1 = b[bj][1] + gv[bj][1] * (acc[ai][bj][m][1] + bv[bj][1]);
                    u32x4 w; w.x = cvt_pk_bf16(v0[0], v0[1]); w.y = cvt_pk_bf16(v0[2], v0[3]); w.z = cvt_pk_bf16(v1[0], v1[1]); w.w = cvt_pk_bf16(v1[2], v1[3]);
                    *(u32x4*)(op + ro + bj * HALF) = w; }
                asm volatile("" ::: "memory"); }
        } else {
            u32x4 b[2][2], bn[2][2];
#pragma unroll
            for (int mm = 0; mm < 2; ++mm)
#pragma unroll
                for (int bj = 0; bj < 2; ++bj) b[mm][bj] = *(const u32x4*)(op + (size_t)(rin0 + mm * 16) * 2048 + bj * HALF);
#pragma unroll
            for (int am = 0; am < 4; ++am) { const int ai = am >> 1, m0 = (am & 1) * 2;
                if (am < 3) { const int ain = (am + 1) >> 1, m0n = ((am + 1) & 1) * 2;
#pragma unroll
                    for (int mm = 0; mm < 2; ++mm)
#pragma unroll
                        for (int bj = 0; bj < 2; ++bj) bn[mm][bj] = *(const u32x4*)(op + (size_t)(rin0 + ain * HALF + (m0n + mm) * 16) * 2048 + bj * HALF); }
#pragma unroll
                for (int mm = 0; mm < 2; ++mm)
#pragma unroll
                    for (int bj = 0; bj < 2; ++bj) { const u32x4 bb = b[mm][bj]; const int m = m0 + mm;
                        const f32x4 b0 = {bflo(bb.x), bfhi(bb.x), bflo(bb.y), bfhi(bb.y)}, b1 = {bflo(bb.z), bfhi(bb.z), bflo(bb.w), bfhi(bb.w)};
                        const f32x4 v0 = b0 + gv[bj][0] * (acc[ai][bj][m][0] + bv[bj][0]), v1 = b1 + gv[bj][1] * (acc[ai][bj][m][1] + bv[bj][1]);
                        u32x4 w; w.x = cvt_pk_bf16(v0[0], v0[1]); w.y = cvt_pk_bf16(v0[2], v0[3]); w.z = cvt_pk_bf16(v1[0], v1[1]); w.w = cvt_pk_bf16(v1[2], v1[3]);
                        *(u32x4*)(op + (size_t)(rin0 + ai * HALF + m * 16) * 2048 + bj * HALF) = w; }
                asm volatile("" ::: "memory");
#pragma unroll
                for (int mm = 0; mm < 2; ++mm)
#pragma unroll
                    for (int bj = 0; bj < 2; ++bj) b[mm][bj] = bn[mm][bj];
            }
        }
    }
};
struct EpiSlab {
    static constexpr bool PERM = false, AFTER_DRAIN = false; static constexpr int TW = 4;
    float* slab;
    __device__ __forceinline__ void operator()(const f32x4 (&acc)[2][2][4][2], const Unit& u, int wr, int wc, int fr, int fq) const {
        float* op = slab + ((size_t)u.kc * 512 + (u.pm - 128) * BM + wr * 64 + fr) * 2048 + u.pn * BM + wc * 32 + 4 * fq;
#pragma unroll
        for (int ai = 0; ai < 2; ++ai)
#pragma unroll
            for (int m = 0; m < 4; ++m)
#pragma unroll
                for (int bj = 0; bj < 2; ++bj)
#pragma unroll
                    for (int n = 0; n < 2; ++n) *(f32x4*)(op + (size_t)(ai * HALF + m * 16) * 2048 + bj * HALF + n * 16) = acc[ai][bj][m][n];
    }
};
template <class Epi, class Sched, bool STAMP = false>
__device__ __forceinline__ void gemm_phase(PG8_LAS unsigned char* lds, const Gemm g, const Sched& S, const Epi& E, unsigned long long* stamps) {
    int tid_ = threadIdx.x; asm volatile("" : "+v"(tid_));
    const int tid = tid_, wid = __builtin_amdgcn_readfirstlane(tid >> 6), lane = tid & 63, wr = wid >> 2, wc = wid & 3, fr = lane & 15, fq = lane >> 4;
    const int K = g.ldk  , nt = g.K / BK; const size_t kchunk = (size_t)g.K * 2;
    int ts_lo = 0, ts_hi = 0, nts = 0; const unsigned long long rt_entry = STAMP ? (unsigned long long)wall_clock64() : 0ull;
#define PG8_STAMP() do { if (STAMP && wid == 0 && nts < 64) { const unsigned long long _c = (unsigned long long)clock64(); \
        ts_lo = (lane == nts) ? (int)(unsigned)_c : ts_lo; ts_hi = (lane == nts) ? (int)(unsigned)(_c >> 32) : ts_hi; ++nts; } } while (0)
    PG8_STAMP();
    unsigned voffA[2], voffB[2];
#pragma unroll
    for (int i = 0; i < 2; ++i) { int R, C; stage_rc(tid * 16 + i * 8192, R, C); const int Rb = Epi::PERM ? ((R & ~31) + perm32(R & 31)) : R;
        voffA[i] = (unsigned)(R * K + C) * 2u; voffB[i] = (unsigned)(Rb * K + C) * 2u; }
    const size_t kstep = (size_t)(BK * 2);
    const size_t hstep = (size_t)HALF * K * 2;
    const size_t tstep = 2 * hstep;
    const unsigned ldsw = (unsigned)wid * 1024u;
    const int aoff = lds_byte(wr * 64 + fr, fq * 8), boff = lds_byte(wc * 32 + fr, fq * 8);
#define PG8_SA(b, h) (((b) * 2 + (h)) * HTB)
#define PG8_SB(b, h) ((4 + (b) * 2 + (h)) * HTB)
#define PG8_STAGE(bufoff, gbase, voff) do { _Pragma("unroll") for (int _i = 0; _i < 2; ++_i) \
        __builtin_amdgcn_global_load_lds((const unsigned*)((const char*)(gbase) + (voff)[_i]), (PG8_LAS unsigned*)(lds + (bufoff) + ldsw + _i * 8192), 16, 0, 0); } while (0)
#define PG8_LDA(dst, b, h) do { _Pragma("unroll") for (int m = 0; m < 4; ++m) _Pragma("unroll") for (int k = 0; k < 2; ++k) dst[m][k] = *(const PG8_LAS bf16x8*)(lds + PG8_SA(b, h) + aoff + m * 2048 + k * 1024); } while (0)
#define PG8_LDB(dst, b, h) do { _Pragma("unroll") for (int n = 0; n < 2; ++n) _Pragma("unroll") for (int k = 0; k < 2; ++k) dst[n][k] = *(const PG8_LAS bf16x8*)(lds + PG8_SB(b, h) + boff + n * 2048 + k * 1024); } while (0)
#define PG8_MMA(ai, bj, At, Bt) do { __builtin_amdgcn_s_setprio(1); _Pragma("unroll") for (int m = 0; m < 4; ++m) _Pragma("unroll") for (int n = 0; n < 2; ++n) _Pragma("unroll") for (int k = 0; k < 2; ++k) \
        acc[ai][bj][m][n] = __builtin_amdgcn_mfma_f32_16x16x32_bf16(Bt[n][k], At[m][k], acc[ai][bj][m][n], 0, 0, 0); __builtin_amdgcn_s_setprio(0); } while (0)
#define PG8_WAIT_V(n) asm volatile("s_waitcnt vmcnt(" #n ")" ::: "memory")
#define PG8_WAIT_L(n) asm volatile("s_waitcnt lgkmcnt(" #n ")" ::: "memory")
#define PG8_BAR __builtin_amdgcn_s_barrier()
#define PG8_SCHED __builtin_amdgcn_sched_barrier(0)
    Unit cur, nxt; int ui = 0;
    if (!S.next(0, cur)) return;
#if SEGPROBE
    unsigned sp_acc = 0, sp_t0 = 0; constexpr bool SPON = (Epi::TW == SEG_EPI);
#define SP_BEGIN(seg) do { if (SPON && SEGPROBE == (seg)) sp_t0 = __builtin_amdgcn_readfirstlane((unsigned)__builtin_amdgcn_s_memrealtime()); } while (0)
#define SP_END(seg) do { if (SPON && SEGPROBE == (seg)) sp_acc = __builtin_amdgcn_readfirstlane(sp_acc + ((unsigned)__builtin_amdgcn_s_memrealtime() - sp_t0)); } while (0)
#else
#define SP_BEGIN(seg) do {} while (0)
#define SP_END(seg) do {} while (0)
#endif
    SP_BEGIN(7); SP_BEGIN(9);
    f32x4 acc[2][2][4][2];
#pragma unroll
    for (int a = 0; a < 2; ++a)
#pragma unroll
        for (int b = 0; b < 2; ++b)
#pragma unroll
            for (int m = 0; m < 4; ++m)
#pragma unroll
                for (int n = 0; n < 2; ++n) acc[a][b][m][n] = (f32x4){0.f, 0.f, 0.f, 0.f};
    bf16x8 At[4][2], B0[2][2], B1[2][2];
    const char* cA = (const char*)g.A + (size_t)cur.pm * tstep + cur.kc * kchunk; const char* cB = (const char*)g.Bt + (size_t)cur.pn * tstep + cur.kc * kchunk;
    S.a_ready(cur);
    PG8_STAGE(PG8_SB(0, 0), cB, voffB); PG8_STAGE(PG8_SA(0, 0), cA, voffA); PG8_STAGE(PG8_SB(0, 1), cB + hstep, voffB); PG8_STAGE(PG8_SA(0, 1), cA + hstep, voffA);
    if (wr == 1) PG8_BAR;
    PG8_WAIT_V(4); PG8_BAR;
    PG8_STAGE(PG8_SB(1, 0), cB + kstep, voffB); PG8_STAGE(PG8_SA(1, 0), cA + kstep, voffA); PG8_STAGE(PG8_SB(1, 1), cB + hstep + kstep, voffB);
    PG8_WAIT_V(6); PG8_BAR;
    PG8_STAMP(); SP_END(7);
    for (;;) {
        const bool has_next = S.next(ui + 1, nxt);
        const char* nA = has_next ? (const char*)g.A + (size_t)nxt.pm * tstep + nxt.kc * kchunk : cA; const char* nB = has_next ? (const char*)g.Bt + (size_t)nxt.pn * tstep + nxt.kc * kchunk : cB;
        if (ui > 0) SP_END(6);
        SP_BEGIN(5);
        for (int t = 0; t < nt; t += 2) {
            const bool last = (t == nt - 2);
            const char* a1 = cA + (size_t)(t + 1) * kstep;
            const char* a2 = last ? nA : cA + (size_t)(t + 2) * kstep; const char* b2 = last ? nB : cB + (size_t)(t + 2) * kstep;
            const char* a3 = a2 + kstep; const char* b3 = b2 + kstep;
            if (last && has_next) S.a_ready(nxt);
            if (last) SP_BEGIN(4);
            PG8_LDB(B0, 0, 0); PG8_SCHED; PG8_LDA(At, 0, 0); PG8_STAGE(PG8_SA(1, 1), a1 + hstep, voffA);
            PG8_WAIT_L(8); PG8_BAR; PG8_WAIT_L(0); PG8_MMA(0, 0, At, B0); PG8_BAR; PG8_SCHED;
            PG8_LDB(B1, 0, 1); PG8_STAGE(PG8_SB(0, 0), b2, voffB);
            PG8_BAR; PG8_WAIT_L(0); PG8_MMA(0, 1, At, B1); PG8_BAR;
            PG8_LDA(At, 0, 1); PG8_STAGE(PG8_SA(0, 0), a2, voffA);
            PG8_BAR; PG8_WAIT_L(0); PG8_MMA(1, 0, At, B0); PG8_BAR; PG8_SCHED;
            PG8_STAGE(PG8_SB(0, 1), b2 + hstep, voffB);
            PG8_WAIT_V(6); PG8_BAR; PG8_MMA(1, 1, At, B1); PG8_BAR;
            PG8_LDB(B0, 1, 0); PG8_SCHED; PG8_LDA(At, 1, 0); PG8_STAGE(PG8_SA(0, 1), a2 + hstep, voffA);
            PG8_WAIT_L(8); PG8_BAR; PG8_WAIT_L(0); PG8_MMA(0, 0, At, B0); PG8_BAR; PG8_SCHED;
            PG8_LDB(B1, 1, 1); PG8_STAGE(PG8_SB(1, 0), b3, voffB);
            PG8_BAR; PG8_WAIT_L(0); PG8_MMA(0, 1, At, B1); PG8_BAR;
            PG8_LDA(At, 1, 1); PG8_STAGE(PG8_SA(1, 0), a3, voffA);
            PG8_BAR; PG8_WAIT_L(0); PG8_MMA(1, 0, At, B0); PG8_BAR; PG8_SCHED;
            PG8_STAGE(PG8_SB(1, 1), b3 + hstep, voffB);
            PG8_WAIT_V(6); PG8_BAR; PG8_MMA(1, 1, At, B1); PG8_BAR;
            if (last) SP_END(4);
        }
        PG8_STAMP(); SP_END(5); SP_BEGIN(1);
        if constexpr (!Epi::AFTER_DRAIN) { E(acc, cur, wr, wc, fr, fq); S.done(cur); }
#if EPI_TWICE
        if constexpr ((EPI_TWICE >> Epi::TW) & 1) { asm volatile("" ::: "memory"); E(acc, cur, wr, wc, fr, fq); }
#endif
        PG8_STAMP(); SP_END(1); SP_BEGIN(6);
        if (!has_next) { SP_BEGIN(8); break; }
#pragma unroll
        for (int a = 0; a < 2; ++a)
#pragma unroll
            for (int b = 0; b < 2; ++b)
#pragma unroll
                for (int m = 0; m < 4; ++m)
#pragma unroll
                    for (int n = 0; n < 2; ++n) acc[a][b][m][n] = (f32x4){0.f, 0.f, 0.f, 0.f};
        cur = nxt; cA = nA; cB = nB; ++ui;
    }
    PG8_WAIT_V(0);
    if (wr == 0) PG8_BAR;
    PG8_BAR;
#if SEGPROBE
    SP_END(8); SP_END(9);
    if (SPON) { const unsigned long long t1 = __builtin_amdgcn_s_memrealtime(); while (__builtin_amdgcn_s_memrealtime() - t1 < (unsigned long long)SEG_AMP * sp_acc) __builtin_amdgcn_s_sleep(8); }
#endif
#undef SP_BEGIN
#undef SP_END
    if constexpr (Epi::AFTER_DRAIN) { E.fused(acc, cur, wr, wc, fr, fq, lds, wid, lane); S.done(cur); }
    PG8_STAMP();
    if (STAMP && wid == 0) { stamps[lane] = lane < nts ? (((unsigned long long)(unsigned)ts_hi << 32) | (unsigned)ts_lo) : 0ull;
        if (lane == 62) stamps[62] = rt_entry; if (lane == 63) stamps[63] = (unsigned long long)wall_clock64(); }
#undef PG8_STAMP
#undef PG8_SA
#undef PG8_SB
#undef PG8_STAGE
#undef PG8_LDA
#undef PG8_LDB
#undef PG8_MMA
#undef PG8_WAIT_V
#undef PG8_WAIT_L
#undef PG8_BAR
#undef PG8_SCHED
}
}
namespace att {
using bf16 = unsigned short;
constexpr int D = 128, NW = 8, QBLK = 32, KVBLK = 64;
constexpr float SCALE = 0.088388347648318440f;
constexpr float THR = 8.f;
constexpr int SDEPTH = 2;
constexpr int LDQ = 2048, LDK = 128, LDO = 2048;
constexpr int NBUF = 3;
constexpr size_t SHM_V = KVBLK * D * 2, SHM_K = KVBLK * D * 2, SHM_ATTN = NBUF * SHM_V + NBUF * SHM_K + NW * 64 * 4;
using bf16x8 = __attribute__((ext_vector_type(8))) short;
using s16x4  = __attribute__((ext_vector_type(4))) short;
using f32x16 = __attribute__((ext_vector_type(16))) float;
using f32x8  = __attribute__((ext_vector_type(8))) float;
using u32x4  = __attribute__((ext_vector_type(4))) unsigned;
#define KSWZ(row, colB) ((row) * 256 + ((colB) ^ (((row) & 7) << 4)))
#define SBAR() __builtin_amdgcn_sched_barrier(0)
__device__ __forceinline__ int crow(int r, int hi) { return (r & 3) + 8 * (r >> 2) + 4 * hi; }
typedef __bf16 bf16x2_t __attribute__((ext_vector_type(2)));
typedef float f32x2_t __attribute__((ext_vector_type(2)));
__device__ __forceinline__ unsigned cvtpk(float lo, float hi) {
  return __builtin_bit_cast(unsigned, __builtin_convertvector((f32x2_t){lo, hi}, bf16x2_t));
}
template <typename TIn> struct Stage;
template <> struct Stage<bf16>  { using T = bf16x8;
  __device__ static __forceinline__ T ld8(const bf16* p) { return *reinterpret_cast<const bf16x8*>(p); }
  __device__ static __forceinline__ bf16x8 tobf(T x) { return x; } };
template <> struct Stage<float> { using T = f32x8;
  __device__ static __forceinline__ T ld8(const float* p) { return *reinterpret_cast<const f32x8*>(p); }
  __device__ static __forceinline__ bf16x8 tobf(T x) {
    u32x4 w = {cvtpk(x[0], x[1]), cvtpk(x[2], x[3]), cvtpk(x[4], x[5]), cvtpk(x[6], x[7])}; return *reinterpret_cast<bf16x8*>(&w); } };

template <bool NOMAX>
__device__ __forceinline__ void partialSM(f32x16& p0, f32x16& p1, float& m_reg, float& mn, float& alpha) {
  if constexpr (!NOMAX) {
    float pmax = p0[0]; for (int r = 1; r < 16; ++r) pmax = fmaxf(pmax, p0[r]); for (int r = 0; r < 16; ++r) pmax = fmaxf(pmax, p1[r]);
    { auto rr = __builtin_amdgcn_permlane32_swap(__float_as_uint(pmax), __float_as_uint(pmax), false, false);
      pmax = fmaxf(__uint_as_float(rr[0]), __uint_as_float(rr[1])); }
    if (__builtin_expect(__all(pmax - m_reg <= THR * 1.4426950408889634f), 1)) { mn = m_reg; alpha = 1.f; }
    else { mn = fmaxf(m_reg, pmax); alpha = __builtin_amdgcn_exp2f(m_reg - mn); m_reg = mn; }
    for (int r = 0; r < 16; ++r) p0[r] -= mn; for (int r = 0; r < 16; ++r) p1[r] -= mn;
  }
  for (int r = 0; r < 16; ++r) p0[r] = __builtin_amdgcn_exp2f(p0[r]);
}
template <bool NOMAX>
__device__ __forceinline__ void finishSM(f32x16& p0, f32x16& p1, float alpha, float& l_reg, bf16x8& pa0, bf16x8& pa1, bf16x8& pa2, bf16x8& pa3) {
  for (int r = 0; r < 16; ++r) p1[r] = __builtin_amdgcn_exp2f(p1[r]);
  float ps = 0; for (int r = 0; r < 16; ++r) ps += p0[r]; for (int r = 0; r < 16; ++r) ps += p1[r];
  { auto rr = __builtin_amdgcn_permlane32_swap(__float_as_uint(ps), __float_as_uint(ps), false, false);
    ps = __uint_as_float(rr[0]) + __uint_as_float(rr[1]); }
  if constexpr (NOMAX) l_reg += ps; else l_reg = l_reg * alpha + ps;
#define PK4(P, BASE, OUT) do { unsigned a0 = cvtpk(P[BASE + 0], P[BASE + 1]), a1 = cvtpk(P[BASE + 2], P[BASE + 3]);   \
    unsigned b0 = cvtpk(P[BASE + 4], P[BASE + 5]), b1 = cvtpk(P[BASE + 6], P[BASE + 7]);                              \
    auto r0 = __builtin_amdgcn_permlane32_swap(a0, b0, false, false); auto r1 = __builtin_amdgcn_permlane32_swap(a1, b1, false, false); \
    u32x4 w = {r0[0], r1[0], r0[1], r1[1]}; OUT = *reinterpret_cast<bf16x8*>(&w); } while (0)
  PK4(p0, 0, pa0); PK4(p0, 8, pa1); PK4(p1, 0, pa2); PK4(p1, 8, pa3);
#undef PK4
}
__device__ __forceinline__ void qkt(f32x16& p0, f32x16& p1, const bf16* Ks, const bf16x8* qr, int r32, int hi) {
  p0 = f32x16{}; p1 = f32x16{};
  for (int d0 = 0; d0 < 8; ++d0) { int cb = (d0 * 16 + hi * 8) * 2;
    bf16x8 b0 = *reinterpret_cast<const bf16x8*>((const char*)Ks + KSWZ(r32, cb));
    bf16x8 b1 = *reinterpret_cast<const bf16x8*>((const char*)Ks + KSWZ(32 + r32, cb));
    p0 = __builtin_amdgcn_mfma_f32_32x32x16_bf16(b0, qr[d0], p0, 0, 0, 0);
    p1 = __builtin_amdgcn_mfma_f32_32x32x16_bf16(b1, qr[d0], p1, 0, 0, 0); }
}
#define PK4S(P, BASE, OUT) do { unsigned a0 = cvtpk(P[BASE + 0], P[BASE + 1]), a1 = cvtpk(P[BASE + 2], P[BASE + 3]);   \
    unsigned b0 = cvtpk(P[BASE + 4], P[BASE + 5]), b1 = cvtpk(P[BASE + 6], P[BASE + 7]);                              \
    auto r0 = __builtin_amdgcn_permlane32_swap(a0, b0, false, false); auto r1 = __builtin_amdgcn_permlane32_swap(a1, b1, false, false); \
    u32x4 w = {r0[0], r1[0], r0[1], r1[1]}; OUT = *reinterpret_cast<bf16x8*>(&w); } while (0)
constexpr int QKPF = 1;
template <int I> __device__ __forceinline__ void sm_slice(f32x16& p0, f32x16& p1, float& psA, float& psB, bf16x8& pa0, bf16x8& pa1, bf16x8& pa2, bf16x8& pa3) {
  if constexpr (I < 8) { p1[2 * I] = __builtin_amdgcn_exp2f(p1[2 * I]); p1[2 * I + 1] = __builtin_amdgcn_exp2f(p1[2 * I + 1]); }
  else if constexpr (I < 10) { constexpr int b = (I - 8) * 8; psA += p0[b] + p0[b + 1]; psB += p0[b + 2] + p0[b + 3]; psA += p0[b + 4] + p0[b + 5]; psB += p0[b + 6] + p0[b + 7]; }
  else if constexpr (I < 12) { constexpr int b = (I - 10) * 8; psA += p1[b] + p1[b + 1]; psB += p1[b + 2] + p1[b + 3]; psA += p1[b + 4] + p1[b + 5]; psB += p1[b + 6] + p1[b + 7]; }
  else if constexpr (I == 12) PK4S(p0, 0, pa0);
  else if constexpr (I == 13) PK4S(p0, 8, pa1);
  else if constexpr (I == 14) PK4S(p1, 0, pa2);
  else PK4S(p1, 8, pa3);
}
template <int D0> __device__ __forceinline__ void qk_sm_step(f32x16& n0, f32x16& n1, const char* Kb, const bf16x8* qr, int r32, int hi, bf16x8 (&k0)[8], bf16x8 (&k1)[8],
                                                             f32x16& p0, f32x16& p1, float& psA, float& psB, bf16x8& pa0, bf16x8& pa1, bf16x8& pa2, bf16x8& pa3) {
  if constexpr (D0 + QKPF < 8) { const int cb = ((D0 + QKPF) * 16 + hi * 8) * 2;
    k0[D0 + QKPF] = *reinterpret_cast<const bf16x8*>(Kb + KSWZ(r32, cb)); k1[D0 + QKPF] = *reinterpret_cast<const bf16x8*>(Kb + KSWZ(32 + r32, cb)); }
  SBAR(); n0 = __builtin_amdgcn_mfma_f32_32x32x16_bf16(k0[D0], qr[D0], n0, 0, 0, 0); sm_slice<2 * D0>(p0, p1, psA, psB, pa0, pa1, pa2, pa3);
  SBAR(); n1 = __builtin_amdgcn_mfma_f32_32x32x16_bf16(k1[D0], qr[D0], n1, 0, 0, 0); sm_slice<2 * D0 + 1>(p0, p1, psA, psB, pa0, pa1, pa2, pa3);
  if constexpr (D0 + 1 < 8) qk_sm_step<D0 + 1>(n0, n1, Kb, qr, r32, hi, k0, k1, p0, p1, psA, psB, pa0, pa1, pa2, pa3);
}
__device__ __forceinline__ void qk_sm(f32x16& n0, f32x16& n1, const bf16* Ks, const bf16x8* qr, int r32, int hi, f32x16& p0, f32x16& p1, float& l_reg,
                                      bf16x8& pa0, bf16x8& pa1, bf16x8& pa2, bf16x8& pa3) {
  n0 = f32x16{}; n1 = f32x16{};
  bf16x8 k0[8], k1[8]; const char* Kb = (const char*)Ks; float psA = 0.f, psB = 0.f;
#pragma unroll
  for (int d0 = 0; d0 < QKPF; ++d0) { const int cb = (d0 * 16 + hi * 8) * 2;
    k0[d0] = *reinterpret_cast<const bf16x8*>(Kb + KSWZ(r32, cb)); k1[d0] = *reinterpret_cast<const bf16x8*>(Kb + KSWZ(32 + r32, cb)); }
  qk_sm_step<0>(n0, n1, Kb, qr, r32, hi, k0, k1, p0, p1, psA, psB, pa0, pa1, pa2, pa3);
  SBAR();
  float ps = psA + psB;
  { auto rr = __builtin_amdgcn_permlane32_swap(__float_as_uint(ps), __float_as_uint(ps), false, false); ps = __uint_as_float(rr[0]) + __uint_as_float(rr[1]); }
  l_reg += ps;
}
#undef PK4S
__device__ __forceinline__ int v_st(int k, int c) { const int kk = (k & ~0xC) | ((k & 4) << 1) | ((k & 8) >> 1); return ((kk >> 3) * 4 + (c >> 5)) * 512 + ((kk & 7) * 32 + (c & 31)) * 2; }
__device__ __forceinline__ int v_rd_base(int lane) { return ((lane & 3) << 3) | (((lane >> 2) & 3) << 6) | (((lane >> 4) & 1) << 5) | (((lane >> 5) & 1) << 8); }
constexpr int v_rd_off(int d0, int ks, int half) { return d0 * 512 + ks * 4096 + half * 2048; }
template <int OFF> __device__ __forceinline__ s16x4 tr_read(int vb) {
  s16x4 r; asm volatile("ds_read_b64_tr_b16 %0, %1 offset:%2" : "=&v"(r) : "v"(vb), "i"(OFF) : "memory"); return r;
}
template <int D0> __device__ __forceinline__ void pv_one(f32x16& od, int vb, bf16x8 pa0, bf16x8 pa1, bf16x8 pa2, bf16x8 pa3) {
  const s16x4 l0 = tr_read<v_rd_off(D0, 0, 0)>(vb), h0 = tr_read<v_rd_off(D0, 0, 1)>(vb), l1 = tr_read<v_rd_off(D0, 1, 0)>(vb), h1 = tr_read<v_rd_off(D0, 1, 1)>(vb);
  const s16x4 l2 = tr_read<v_rd_off(D0, 2, 0)>(vb), h2 = tr_read<v_rd_off(D0, 2, 1)>(vb), l3 = tr_read<v_rd_off(D0, 3, 0)>(vb), h3 = tr_read<v_rd_off(D0, 3, 1)>(vb);
  asm volatile("s_waitcnt lgkmcnt(0)" ::: "memory"); SBAR();
#define PK(L, H) (bf16x8){L[0], L[1], L[2], L[3], H[0], H[1], H[2], H[3]}
  od = __builtin_amdgcn_mfma_f32_32x32x16_bf16(pa0, PK(l0, h0), od, 0, 0, 0);
  od = __builtin_amdgcn_mfma_f32_32x32x16_bf16(pa1, PK(l1, h1), od, 0, 0, 0);
  od = __builtin_amdgcn_mfma_f32_32x32x16_bf16(pa2, PK(l2, h2), od, 0, 0, 0);
  od = __builtin_amdgcn_mfma_f32_32x32x16_bf16(pa3, PK(l3, h3), od, 0, 0, 0);
#undef PK
}
__device__ __forceinline__ void pv_d0(f32x16* o, int vb, bf16x8 pa0, bf16x8 pa1, bf16x8 pa2, bf16x8 pa3) {
  pv_one<0>(o[0], vb, pa0, pa1, pa2, pa3); pv_one<1>(o[1], vb, pa0, pa1, pa2, pa3); pv_one<2>(o[2], vb, pa0, pa1, pa2, pa3); pv_one<3>(o[3], vb, pa0, pa1, pa2, pa3);
}
template <typename TQ, bool NOMAX>
__device__ __forceinline__ void attn_dense_body(const TQ* __restrict__ Qb, const bf16* __restrict__ Kh, const bf16* __restrict__ Vh,
                                                bf16* __restrict__ Ob, int seq, char* lds) {
  using St = Stage<bf16>; using SQ = Stage<TQ>;
  int tid_ = threadIdx.x; asm volatile("" : "+v"(tid_));
  const int tid = tid_, wid = tid >> 6, lane = tid & 63, r32 = lane & 31, hi = lane >> 5;
  bf16* V_lds = (bf16*)lds; bf16* K_lds = (bf16*)(lds + NBUF * SHM_V);
  float* ws = (float*)(lds + NBUF * SHM_V + NBUF * SHM_K) + wid * 64; float* li_l = ws; float* al_l = ws + 32;
  float m_reg = -1e30f, l_reg = 0; f32x16 o[4] = {}; bf16x8 qr[8];
  const TQ* Qw = Qb + (long)(wid * QBLK + r32) * LDQ + hi * 8;
#pragma unroll
  for (int d0 = 0; d0 < 8; ++d0) qr[d0] = SQ::tobf(SQ::ld8(Qw + d0 * 16));
  const int sr = tid >> 4, sc = (tid & 15) * 8, vst0 = v_st(sr, sc), vst1 = v_st(32 + sr, sc);
  const int vb0 = (int)(uintptr_t)V_lds + v_rd_base(lane);
  struct { typename St::T vs0, vs1, ks0, ks1; } sr_[SDEPTH];
  const unsigned lo0 = (unsigned)(sr * LDK + sc) * 2u;
#define UPTR(p) ((const GAS char*)(((unsigned long long)(unsigned)__builtin_amdgcn_readfirstlane((unsigned)((unsigned long long)(p) >> 32)) << 32) | (unsigned long long)(unsigned)__builtin_amdgcn_readfirstlane((unsigned)(unsigned long long)(p))))
#define SLOAD(i, k0) do { const GAS char* vt_ = UPTR((const char*)Vh + (size_t)(k0) * (LDK * 2)); const GAS char* kt_ = UPTR((const char*)Kh + (size_t)(k0) * (LDK * 2)); \
    unsigned lo1_ = lo0; asm volatile("v_add_u32 %0, 0x2000, %0" : "+v"(lo1_));     \
    sr_[i].vs0 = *(const GAS bf16x8*)(vt_ + lo0); sr_[i].vs1 = *(const GAS bf16x8*)(vt_ + lo1_); sr_[i].ks0 = *(const GAS bf16x8*)(kt_ + lo0); sr_[i].ks1 = *(const GAS bf16x8*)(kt_ + lo1_); } while (0)
#define SWRITE(b, i) do { *(bf16x8*)((char*)V_lds + (b) * SHM_V + vst0) = St::tobf(sr_[i].vs0);          \
    *(bf16x8*)((char*)V_lds + (b) * SHM_V + vst1) = St::tobf(sr_[i].vs1); int kc = sc * 2;               \
    *(bf16x8*)((char*)K_lds + (b) * SHM_K + KSWZ(sr, kc)) = St::tobf(sr_[i].ks0);                       \
    *(bf16x8*)((char*)K_lds + (b) * SHM_K + KSWZ(32 + sr, kc)) = St::tobf(sr_[i].ks1); } while (0)
#define SWAIT() do { if constexpr (SDEPTH == 2) asm volatile("s_waitcnt vmcnt(4)" ::: "memory"); else asm volatile("s_waitcnt vmcnt(0)" ::: "memory"); } while (0)
#define RESC(a) do { if constexpr (!NOMAX) if (__any((a) < 1.f)) { if (hi == 0) al_l[r32] = (a); asm volatile("s_waitcnt lgkmcnt(0)" ::: "memory"); \
    for (int d = 0; d < 4; ++d) for (int r = 0; r < 16; ++r) o[d][r] *= al_l[crow(r, hi)]; } } while (0)
  f32x16 pA0, pA1, pB0, pB1; float mnA, mnB, alA, alB; bf16x8 pa0, pa1, pa2, pa3; const int NT = seq / KVBLK;
  constexpr int SE = 0, SO = SDEPTH - 1;
  SLOAD(SE, 0); asm volatile("s_waitcnt vmcnt(0)" ::: "memory"); SWRITE(0, SE); __syncthreads();
  qkt(pA0, pA1, K_lds, qr, r32, hi); partialSM<NOMAX>(pA0, pA1, m_reg, mnA, alA);
  SLOAD(SO, KVBLK); if constexpr (SDEPTH == 2) { if (2 < NT) SLOAD(SE, 2 * KVBLK); }
  SWAIT(); SWRITE(1, SO); __syncthreads();
  if (__builtin_amdgcn_readfirstlane(wid) >= 4) __builtin_amdgcn_s_setprio(1);
  int bp = 0, bc = 1, bn = 2;
#define ROT() do { const int t_ = bp; bp = bc; bc = bn; bn = t_; } while (0)
  for (int j = 1; j + 1 < NT; j += 2) {
    SBAR(); if constexpr (NOMAX) qk_sm(pB0, pB1, (bf16*)((char*)K_lds + bc * SHM_K), qr, r32, hi, pA0, pA1, l_reg, pa0, pa1, pa2, pa3);
    else { qkt(pB0, pB1, (bf16*)((char*)K_lds + bc * SHM_K), qr, r32, hi);
    finishSM<NOMAX>(pA0, pA1, alA, l_reg, pa0, pa1, pa2, pa3); } SBAR();
    SLOAD(SO, (j + SDEPTH) * KVBLK); SBAR();
    pv_d0(o, vb0 + bp * (int)SHM_V, pa0, pa1, pa2, pa3); partialSM<NOMAX>(pB0, pB1, m_reg, mnB, alB);
    SWAIT(); SWRITE(bn, SE);
    RESC(alB); __syncthreads(); ROT();
    SBAR(); if constexpr (NOMAX) qk_sm(pA0, pA1, (bf16*)((char*)K_lds + bc * SHM_K), qr, r32, hi, pB0, pB1, l_reg, pa0, pa1, pa2, pa3);
    else { qkt(pA0, pA1, (bf16*)((char*)K_lds + bc * SHM_K), qr, r32, hi);
    finishSM<NOMAX>(pB0, pB1, alB, l_reg, pa0, pa1, pa2, pa3); } SBAR();
    if (SDEPTH == 1 || j + 3 < NT) SLOAD(SE, (j + 1 + SDEPTH) * KVBLK); SBAR();
    pv_d0(o, vb0 + bp * (int)SHM_V, pa0, pa1, pa2, pa3); partialSM<NOMAX>(pA0, pA1, m_reg, mnA, alA);
    SWAIT(); SWRITE(bn, SO);
    RESC(alA); __syncthreads(); ROT();
  }
  SBAR(); if constexpr (NOMAX) qk_sm(pB0, pB1, (bf16*)((char*)K_lds + bc * SHM_K), qr, r32, hi, pA0, pA1, l_reg, pa0, pa1, pa2, pa3);
    else { qkt(pB0, pB1, (bf16*)((char*)K_lds + bc * SHM_K), qr, r32, hi);
    finishSM<NOMAX>(pA0, pA1, alA, l_reg, pa0, pa1, pa2, pa3); } SBAR();
  pv_d0(o, vb0 + bp * (int)SHM_V, pa0, pa1, pa2, pa3); partialSM<NOMAX>(pB0, pB1, m_reg, mnB, alB);
  RESC(alB);
  finishSM<NOMAX>(pB0, pB1, alB, l_reg, pa0, pa1, pa2, pa3); SBAR();
  pv_d0(o, vb0 + bc * (int)SHM_V, pa0, pa1, pa2, pa3);
#undef ROT
  __builtin_amdgcn_s_setprio(0);
  if (hi == 0) li_l[r32] = l_reg; asm volatile("s_waitcnt lgkmcnt(0)" ::: "memory");
  float rli[16];
#pragma unroll
  for (int r = 0; r < 16; ++r) rli[r] = __builtin_amdgcn_rcpf(li_l[crow(r, hi)]);
  __syncthreads();
  char* st = lds + wid * 8192;
#pragma unroll
  for (int r = 0; r < 16; ++r) { const int orow = crow(r, hi);
#pragma unroll
    for (int d0 = 0; d0 < 4; ++d0) *(bf16*)(st + orow * 256 + (d0 * 32 + r32) * 2) = (bf16)(cvtpk(o[d0][r] * rli[r], 0.f) & 0xffffu); }
  asm volatile("s_waitcnt lgkmcnt(0)" ::: "memory");
  bf16* Ow = Ob + (long)(wid * QBLK) * LDO;
#pragma unroll
  for (int i = 0; i < 8; ++i) { const int orow = 4 * i + (lane >> 4), ch = lane & 15;
    *(u32x4*)(Ow + (long)orow * LDO + ch * 8) = *(const u32x4*)(st + orow * 256 + ch * 16); }
#undef SLOAD
#undef UPTR
#undef SWRITE
#undef SWAIT
#undef RESC
}
}
#define FFT_HD __device__ __forceinline__
#define FFT_DEVICE_ASM 1
#define FFT_LD(p, i) ((p)[i])
#define FFT_ST(p, i, v) ((p)[i] = (v))
#ifndef FFT_HD
#define FFT_HD __device__ __forceinline__
#endif
#ifndef FFT_SCHED_DEFINED_EARLY
#define FFT_SCHED_DEFINED_EARLY
#ifndef FFT_SCHED
#define FFT_SCHED() __builtin_amdgcn_sched_barrier(0)
#endif
#endif
#ifndef FFT_OPAQUE
#define FFT_OPAQUE(x) asm volatile("" : "+v"(x))
#endif
#ifndef FFT_LD
#define FFT_LD(p, i) ((p)[i])
#define FFT_ST(p, i, v) ((p)[i] = (v))
#endif
#ifdef FFT_DEVICE_ASM
typedef float cf __attribute__((ext_vector_type(2)));
FFT_HD cf cf_add(cf a, cf b) { return a + b; }
FFT_HD cf cf_sub(cf a, cf b) { return a - b; }
FFT_HD cf cf_conj(cf a) { return cf{a.x, -a.y}; }
FFT_HD cf cf_mul(cf a, cf b) {
    cf t, r; asm("v_pk_mul_f32 %0, %1, %2 op_sel_hi:[0,1]" : "=v"(t) : "v"(a), "v"(b));
    asm("v_pk_fma_f32 %0, %1, %2, %3 op_sel:[1,1,0] op_sel_hi:[1,0,1] neg_lo:[0,1,0]" : "=v"(r) : "v"(a), "v"(b), "v"(t)); return r; }
FFT_HD cf cf_mulc(cf a, cf b) {
    cf t, r; asm("v_pk_mul_f32 %0, %1, %2 op_sel_hi:[0,1] neg_hi:[0,1]" : "=v"(t) : "v"(a), "v"(b));
    asm("v_pk_fma_f32 %0, %1, %2, %3 op_sel:[1,1,0] op_sel_hi:[1,0,1]" : "=v"(r) : "v"(a), "v"(b), "v"(t)); return r; }
#define FFT_PKADD(name, mods) FFT_HD cf name(cf a, cf b) { cf r; asm("v_pk_add_f32 %0, %1, %2 " mods : "=v"(r) : "v"(a), "v"(b)); return r; }
FFT_PKADD(cf_sub_mi, "op_sel:[1,1] op_sel_hi:[0,0] neg_lo:[0,1] neg_hi:[1,0]")
FFT_PKADD(cf_sub_pi, "op_sel:[1,1] op_sel_hi:[0,0] neg_lo:[1,0] neg_hi:[0,1]")
FFT_PKADD(cf_add_conj, "neg_hi:[0,1]")
FFT_PKADD(cf_sub_conj, "neg_lo:[0,1]")
FFT_PKADD(cf_add_mi, "op_sel:[0,1] op_sel_hi:[1,0] neg_hi:[0,1]")
FFT_PKADD(cf_conj_sub_mi, "op_sel:[0,1] op_sel_hi:[1,0] neg_lo:[0,1] neg_hi:[1,1]")
FFT_PKADD(cf_add_pi, "op_sel:[0,1] op_sel_hi:[1,0] neg_lo:[0,1]")
FFT_PKADD(cf_conj_add_pi, "op_sel:[0,1] op_sel_hi:[1,0] neg_hi:[1,0]")
#else
struct __attribute__((aligned(8))) cf { float x, y; };
FFT_HD cf cf_add(cf a, cf b) { return cf{a.x + b.x, a.y + b.y}; }
FFT_HD cf cf_sub(cf a, cf b) { return cf{a.x - b.x, a.y - b.y}; }
FFT_HD cf cf_mul(cf a, cf b) { return cf{a.x * b.x - a.y * b.y, a.x * b.y + a.y * b.x}; }
FFT_HD cf cf_mulc(cf a, cf b) { return cf{a.x * b.x + a.y * b.y, a.y * b.x - a.x * b.y}; }
FFT_HD cf cf_conj(cf a) { return cf{a.x, -a.y}; }
FFT_HD cf cf_sub_mi(cf a, cf b) { return cf{a.y - b.y, b.x - a.x}; }
FFT_HD cf cf_sub_pi(cf a, cf b) { return cf{b.y - a.y, a.x - b.x}; }
FFT_HD cf cf_add_conj(cf a, cf b) { return cf{a.x + b.x, a.y - b.y}; }
FFT_HD cf cf_sub_conj(cf a, cf b) { return cf{a.x - b.x, a.y + b.y}; }
FFT_HD cf cf_add_mi(cf a, cf b) { return cf{a.x + b.y, a.y - b.x}; }
FFT_HD cf cf_conj_sub_mi(cf a, cf b) { return cf{a.x - b.y, -a.y - b.x}; }
FFT_HD cf cf_add_pi(cf a, cf b) { return cf{a.x - b.y, a.y + b.x}; }
FFT_HD cf cf_conj_add_pi(cf a, cf b) { return cf{a.x + b.y, -a.y + b.x}; }
#endif
constexpr int FFT_N = 16384;
constexpr int FFT_LDS_CF = 17904;
constexpr int FFT_LDS_BYTES = FFT_LDS_CF * 8;
FFT_HD int fft_phys(int p) { return p + (p >> 4) + ((p >> 9) << 4); }
#define FFT_CONSTS float fc1 = 0.98078528040323043f, fc2 = 0.92387953251128674f, fc3 = 0.83146961230254524f, fc4 = 0.70710678118654752f, fc5 = 0.55557023301960218f, \
    fc6 = 0.38268343236508978f, fc7 = 0.19509032201612825f; FFT_OPAQUE(fc1); FFT_OPAQUE(fc2); FFT_OPAQUE(fc3); FFT_OPAQUE(fc4); FFT_OPAQUE(fc5); FFT_OPAQUE(fc6); FFT_OPAQUE(fc7)
#define FFT_C32(k) ((k) == 0 ? 1.0f : (k) == 1 ? fc1 : (k) == 2 ? fc2 : (k) == 3 ? fc3 : (k) == 4 ? fc4 : (k) == 5 ? fc5 : (k) == 6 ? fc6 : (k) == 7 ? fc7 : (k) == 8 ? 0.0f : (k) == 9 ? -fc7 : \
    (k) == 10 ? -fc6 : (k) == 11 ? -fc5 : (k) == 12 ? -fc4 : (k) == 13 ? -fc3 : (k) == 14 ? -fc2 : -fc1)
#define FFT_S32(k) ((k) == 0 ? 0.0f : (k) == 1 ? fc7 : (k) == 2 ? fc6 : (k) == 3 ? fc5 : (k) == 4 ? fc4 : (k) == 5 ? fc3 : (k) == 6 ? fc2 : (k) == 7 ? fc1 : (k) == 8 ? 1.0f : (k) == 9 ? fc1 : \
    (k) == 10 ? fc2 : (k) == 11 ? fc3 : (k) == 12 ? fc4 : (k) == 13 ? fc5 : (k) == 14 ? fc6 : fc7)

template <int R, int HALF, bool INV> FFT_HD void dft_stage(cf (&v)[R], float fc1, float fc2, float fc3, float fc4, float fc5, float fc6, float fc7) {
#pragma unroll
    for (int g = 0; g < R; g += 2 * HALF) {
#pragma unroll
        for (int i = 0; i < HALF; ++i) {
            const cf a = v[g + i], b = v[g + i + HALF];
            v[g + i] = cf_add(a, b);
            const int ti = i * (16 / HALF);
            if (ti == 0) v[g + i + HALF] = cf_sub(a, b);
            else if (ti == 8) v[g + i + HALF] = INV ? cf_sub_pi(a, b) : cf_sub_mi(a, b);
            else { const cf w = cf{FFT_C32(ti), FFT_S32(ti)}; const cf d = cf_sub(a, b); v[g + i + HALF] = INV ? cf_mul(d, w) : cf_mulc(d, w); }
        }
    }
    FFT_SCHED();
    if constexpr (HALF > 1) dft_stage<R, HALF / 2, INV>(v, fc1, fc2, fc3, fc4, fc5, fc6, fc7);
}
template <int R, bool INV> FFT_HD void dft_reg(cf (&v)[R]) {
    FFT_CONSTS;
    dft_stage<R, R / 2, INV>(v, fc1, fc2, fc3, fc4, fc5, fc6, fc7);
    cf t[R];
#pragma unroll
    for (int k = 0; k < R; ++k) t[k] = v[k];
#pragma unroll
    for (int k = 0; k < R; ++k) {
        const int r = R == 32 ? (((k & 1) << 4) | ((k & 2) << 2) | (k & 4) | ((k & 8) >> 2) | ((k & 16) >> 4)) : (((k & 1) << 3) | ((k & 2) << 1) | ((k & 4) >> 1) | ((k & 8) >> 3));
        v[k] = t[r];
    }
}
#ifndef FFT_SCHED
#define FFT_SCHED() __builtin_amdgcn_sched_barrier(0)
#endif
#ifndef FFT_SINCOS2PI
#define FFT_SINCOS2PI(frac, s, c) do { (s) = __builtin_amdgcn_sinf(frac); (c) = __builtin_amdgcn_cosf(frac); asm volatile("s_nop 1" : "+v"(s), "+v"(c)); } while (0)
#endif
template <int R> FFT_HD void twiddle_chain(cf (&v)[R], float frac  ) {
    FFT_OPAQUE(frac);
    float s, c; FFT_SINCOS2PI(frac, s, c);
    const cf w = cf{c, s}; cf p = w;
#pragma unroll
    for (int k = 1; k < R; ++k) { v[k] = cf_mul(v[k], p); if (k + 1 < R) p = cf_mul(p, w); if ((k & 7) == 7) FFT_SCHED(); }
}
template <class LP> FFT_HD void fft_f1(LP lds, int t, cf (&v)[32]) {
    dft_reg<32, false>(v);
    twiddle_chain<32>(v, -(float)t * (1.0f / 16384.0f));
    int P1 = t + (t >> 4); FFT_OPAQUE(P1);
#pragma unroll
    for (int k = 0; k < 32; ++k) FFT_ST(lds, P1 + 560 * k, v[k]);
}
template <class LP> FFT_HD void fft_f2(LP lds, int t) {
    int P2 = 560 * (t >> 4) + (t & 15); FFT_OPAQUE(P2);
    cf v[32];
#pragma unroll
    for (int j = 0; j < 32; ++j) v[j] = FFT_LD(lds, P2 + 17 * j);
    dft_reg<32, false>(v);
    twiddle_chain<32>(v, -(float)(t & 15) * (1.0f / 512.0f));
#pragma unroll
    for (int k = 0; k < 32; ++k) FFT_ST(lds, P2 + 17 * k, v[k]);
}
template <class LP, bool INV> FFT_HD void fft_p3(LP lds, int t) {
#pragma unroll
    for (int q = 0; q < 2; ++q) {
        int P3 = 17 * t + 16 * (t >> 5) + 8960 * q; FFT_OPAQUE(P3);
        cf v[16];
#pragma unroll
        for (int j = 0; j < 16; ++j) v[j] = FFT_LD(lds, P3 + j);
        dft_reg<16, INV>(v);
#pragma unroll
        for (int k = 0; k < 16; ++k) FFT_ST(lds, P3 + k, v[k]);
    }
}
FFT_HD int fft_pos(int k) { return 512 * (k & 31) + 16 * ((k >> 5) & 31) + (k >> 10); }
template <class LP, int MODE> FFT_HD void fft_pair(LP lds, int t, float* K, const float (&Kr)[66]) {
    const int m = t & 31, alo = t >> 5; unsigned ut = (unsigned)t; FFT_OPAQUE(ut);
    float fr0 = -(float)(alo + 32 * m) * (1.0f / 32768.0f); FFT_OPAQUE(fr0);
    float s, c; FFT_SINCOS2PI(fr0, s, c);
    cf wh = cf{c, s};
    float k0 = 0.98078528040323043f, k1 = -0.19509032201612825f, k2 = 0.99999529380957619f, k3 = -0.0030679567629659761f; FFT_OPAQUE(k0); FFT_OPAQUE(k1); FFT_OPAQUE(k2); FFT_OPAQUE(k3);
    const cf c1024 = cf{k0, k1};
    const cf c16 = cf{k2, k3};
#pragma unroll
    for (int h = 0; h < 8; ++h) {
#pragma unroll
        for (int e = 0; e < 2; ++e) {
            const int j = 2 * h + e;
            const cf w = e ? cf_mul(wh, c16) : wh;
            const int k = alo + 16 * e + 32 * m + 1024 * h;
            const int a = alo + 16 * e, an = (32 - a) & 31, b1 = a != 0 ? 1 : 0, mn = (32 - m - b1) & 31, b2 = (m + b1) != 0 ? 1 : 0;
            const int pk = 560 * a + 17 * m + h, pn = 560 * an + 17 * mn + 16 - b2 - h;
            const cf zk = FFT_LD(lds, pk), zn = FFT_LD(lds, pn);
            const cf E2 = cf_add_conj(zk, zn), D2 = cf_sub_conj(zk, zn);
            const cf p = cf_mul(w, D2);
            cf xk = cf_add_mi(E2, p), xn = cf_conj_sub_mi(E2, p);
            if (k == 0) { xk = cf{2.0f * (zk.x + zk.y), 0.f}; xn = cf{2.0f * (zk.x - zk.y), 0.f}; }
            if (MODE == 0) { K[512 * (4 * j + 0) + ut] = xk.x; K[512 * (4 * j + 1) + ut] = xk.y; K[512 * (4 * j + 2) + ut] = xn.x; K[512 * (4 * j + 3) + ut] = xn.y; }
            else {
                const float q0 = Kr[4 * j + 0], q1 = Kr[4 * j + 1], q2 = Kr[4 * j + 2], q3 = Kr[4 * j + 3];
                const cf yk = cf_mul(xk, cf{q0, q1}), yn = cf_mul(xn, cf{q2, q3});
                const cf E = cf_add_conj(yk, yn), Dd = cf_sub_conj(yk, yn);
                const cf O = cf_mulc(Dd, w);
                cf ok = cf_add_pi(E, O), on = cf_conj_add_pi(E, O);
                if (k == 0) ok = cf{yk.x + yn.x, yk.x - yn.x};
                FFT_ST(lds, pk, ok); if (k != 0) FFT_ST(lds, pn, on);
            }
        }
        wh = cf_mul(wh, c1024);
    }
    if (t == 0) {
        const int pk = 8;
        const cf z = FFT_LD(lds, pk);
        if (MODE == 0) { K[512 * 64 + ut] = 2.0f * z.x; K[512 * 65 + ut] = -2.0f * z.y; }
        else { const cf r = cf_mulc(z, cf{Kr[64], Kr[65]}); FFT_ST(lds, pk, (cf{4.0f * r.x, 4.0f * r.y})); }
    }
}
FFT_HD void fft_kload(const float* K, int t, float (&Kr)[66]) {
    unsigned ut = (unsigned)t; FFT_OPAQUE(ut);
#pragma unroll
    for (int i = 0; i < 66; ++i) Kr[i] = K[512 * i + ut];
}
template <class LP> FFT_HD void fft_i2(LP lds, int t) {
    int P2 = 560 * (t >> 4) + (t & 15); FFT_OPAQUE(P2);
    cf v[32];
#pragma unroll
    for (int k = 0; k < 32; ++k) v[k] = FFT_LD(lds, P2 + 17 * k);
    twiddle_chain<32>(v, (float)(t & 15) * (1.0f / 512.0f));
    dft_reg<32, true>(v);
#pragma unroll
    for (int j = 0; j < 32; ++j) FFT_ST(lds, P2 + 17 * j, v[j]);
}
template <class LP> FFT_HD void fft_i1(LP lds, int t, cf (&v)[32]) {
    int P1 = t + (t >> 4); FFT_OPAQUE(P1);
#pragma unroll
    for (int k = 0; k < 32; ++k) v[k] = FFT_LD(lds, P1 + 560 * k);
    twiddle_chain<32>(v, (float)t * (1.0f / 16384.0f));
    dft_reg<32, true>(v);
}
constexpr int LDS_BYTES = 147456;
constexpr int LDS_BARW = LDS_BYTES - 64;

struct Fr {
    LAS unsigned char* lds; unsigned char* ldsg;
    int tid, lane, wave, blk, nblk, gw, ngw;
    const __attribute__((address_space(4))) unsigned long long* ka;
    unsigned char* ws;
};
#define BFE(v, e) (((e) & 1) ? bfhi((v)[(e) >> 1]) : bflo((v)[(e) >> 1]))

struct WSet { const float *gate, *up, *down, *win, *wout; int nin; };
struct WItem { const float* W; bf16_t* WT; int K, N, rbase, k0, n0; };
__device__ __forceinline__ WItem wconv_lookup(int it, const WSet& w, unsigned char* wslot  ) {
    const int I_G = 32 * (DFF / 32), I_D = (DFF / 64) * (D / 32), I_IN = 32 * (w.nin / 32);
    WItem x; int mode = 0, row_off = 0, r = it;
    if (r < I_G) { x.W = w.gate; x.K = D; x.N = DFF; x.WT = (bf16_t*)(wslot + WO_GU); mode = 1; }
    else if ((r -= I_G) < I_G) { x.W = w.up; x.K = D; x.N = DFF; x.WT = (bf16_t*)(wslot + WO_GU); mode = 1; row_off = 128; }
    else if ((r -= I_G) < I_D) { x.W = w.down; x.K = DFF; x.N = D; x.WT = (bf16_t*)(wslot + WO_D); }
    else if ((r -= I_D) < I_IN) { x.W = w.win; x.K = D; x.N = w.nin; x.WT = (bf16_t*)(wslot + WO_IN); }
    else { r -= I_IN; x.W = w.wout; x.K = D; x.N = D; x.WT = (bf16_t*)(wslot + WO_OUT); }
    const int nblk = x.N / 32, kb = r / nblk, nb = r % nblk; x.k0 = 64 * kb; x.n0 = 32 * nb;
    x.rbase = mode ? 256 * (x.n0 >> 7) + (x.n0 & 127) + row_off : x.n0;
    return x;
}
__device__ __forceinline__ void wconv_load(const WItem& x, int lane, f32x4 (&r)[8]) {
    const float* p = x.W + (size_t)(x.k0 + (lane >> 3)) * x.N + x.n0 + 4 * (lane & 7);
#pragma unroll
    for (int i = 0; i < 8; ++i) r[i] = *(const f32x4*)(p + (size_t)(8 * i) * x.N);
}
__device__ __forceinline__ void wconv_store(const WItem& x, int lane, const f32x4 (&r)[8], LAS float* scr) {
    const int c4 = lane & 7, kr = lane >> 3;
#pragma unroll
    for (int i = 0; i < 8; ++i)
#pragma unroll
        for (int e = 0; e < 4; ++e) scr[(4 * c4 + e) * 65 + kr + 8 * i] = r[i][e];
    LDS_WAIT(); asm volatile("" ::: "memory");
#pragma unroll
    for (int j = 0; j < 4; ++j) { const int n = (lane >> 3) + 8 * j; const LAS float* s = scr + n * 65 + 8 * (lane & 7);
        u32x4 o; o.x = cvt_pk_bf16(s[0], s[1]); o.y = cvt_pk_bf16(s[2], s[3]); o.z = cvt_pk_bf16(s[4], s[5]); o.w = cvt_pk_bf16(s[6], s[7]);
        *(u32x4*)(x.WT + (size_t)(x.rbase + n) * x.K + x.k0 + 8 * (lane & 7)) = o; }
    LDS_WAIT(); asm volatile("" ::: "memory");
}
__device__ __forceinline__ int wconv_total(int nin) { return 2 * 32 * (DFF / 32) + (DFF / 64) * (D / 32) + 32 * (nin / 32) + 32 * (D / 32); }
__device__ __forceinline__ void wconv_part(const Fr& F, const WSet& w, unsigned char* wslot, LAS float* scr, int& it, int nmax, int stride = 0, int hi = 0) {
    const int total = hi ? hi : wconv_total(w.nin), step = stride ? stride : F.ngw;
    if (it >= total || nmax <= 0) return;
    WItem cur = wconv_lookup(it, w, wslot); f32x4 rc[8]; wconv_load(cur, F.lane, rc);
    for (int n = 1;; ++n) {
        const int nx = it + step; const bool more = nx < total && n < nmax;
        WItem nxt = cur; f32x4 rn[8];
        if (more) { nxt = wconv_lookup(nx, w, wslot); wconv_load(nxt, F.lane, rn); }
        wconv_store(cur, F.lane, rc, scr);
        it = nx;
        if (!more) break;
        cur = nxt;
#pragma unroll
        for (int i = 0; i < 8; ++i) rc[i] = rn[i];
    }
}
__device__ __forceinline__ void wconv_layer(const Fr& F, const WSet& w, unsigned char* wslot) {
    int it = F.gw; wconv_part(F, w, wslot, (LAS float*)(F.lds + F.wave * 16384), it, 1 << 30);
}

__device__ __forceinline__ void adaln_phase(const Fr& F, const float* c, const float* c_ctx, const float* w_mod, const float* b_mod, float* mod) {
    LAS float* sl = (LAS float*)F.lds;
    LAS float* red = sl + 3 * D;
    for (int i = F.tid; i < 3 * D; i += NTHREADS) { const int cnd = i / D, k = i % D; const float x = cnd < 2 ? c[cnd * D + k] : c_ctx[k]; sl[i] = x / (1.0f + __expf(-x)); }
    __syncthreads();
    for (int g = F.blk; g < 192; g += F.nblk) {
        const int layer = g / 48, colg = (g % 48) * 256, col = colg + 4 * F.lane;
        const float* wp = w_mod + (size_t)layer * D * NMOD + col + (size_t)(F.wave * 256) * NMOD;
        f32x4 a0 = {0.f, 0.f, 0.f, 0.f}, a1 = a0, a2 = a0;
#pragma unroll 1
        for (int kb = 0; kb < 256; kb += 16) { f32x4 w[16];
#pragma unroll
            for (int u = 0; u < 16; ++u) w[u] = __builtin_nontemporal_load((const f32x4*)(wp + (size_t)(kb + u) * NMOD));
#pragma unroll
            for (int u = 0; u < 16; ++u) { const int k = F.wave * 256 + kb + u; a0 += w[u] * sl[k]; a1 += w[u] * sl[D + k]; a2 += w[u] * sl[2 * D + k]; } }
        *(LAS f32x4*)(red + (F.wave * 3 + 0) * 256 + 4 * F.lane) = a0; *(LAS f32x4*)(red + (F.wave * 3 + 1) * 256 + 4 * F.lane) = a1; *(LAS f32x4*)(red + (F.wave * 3 + 2) * 256 + 4 * F.lane) = a2;
        __syncthreads();
        for (int o = F.tid; o < 768; o += NTHREADS) { const int cnd = o >> 8, cc = o & 255; float s = 0.f;
#pragma unroll
            for (int w = 0; w < 8; ++w) s += red[(w * 3 + cnd) * 256 + cc];
            mod[((size_t)layer * 3 + cnd) * NMOD + colg + cc] = s + b_mod[layer * NMOD + colg + cc]; }
        __syncthreads();
    }
}

__device__ __forceinline__ void hdn_phase(const Fr& F, const float* w1, const float* b1, const float* w2, const float* b2, const float* w3, const float* b3, const float* freq, float* hdn) {
    const bool split = F.nblk > 192; if (split && F.blk < 192) return;
    const int first = split ? (F.blk - 192) * NWAVES + F.wave : F.gw, stride = split ? (F.nblk - 192) * NWAVES : F.ngw;
#pragma unroll 1
    for (int j = 0; j < 2; ++j) {
        float W1[33], W2[64], W3[64];
#pragma unroll
        for (int q = 0; q < 33; ++q) W1[q] = w1[(j * 33 + q) * 64 + F.lane];
#pragma unroll
        for (int q = 0; q < 64; ++q) { W2[q] = w2[(j * 64 + q) * 64 + F.lane]; W3[q] = w3[(j * 64 + q) * 64 + F.lane]; }
        const float fr = freq[j * 64 + F.lane], B1 = b1[j * 64 + F.lane], B2 = b2[j * 64 + F.lane], B3 = b3[j * 64 + F.lane];
#pragma unroll 1
        for (int tt = first; tt < SEQ + CTXL; tt += stride) {
            const bool ctx = tt >= SEQ; const int t = ctx ? tt - SEQ : tt, L = ctx ? CTXL : SEQ;
            const float tn = (float)t / (float)(L - 1), rev = (float)t / (float)L;
            const int k = F.lane; float z = 0.f;
            if (k == 0) z = tn;
            else if (k <= 32) { const int i = (k - 1) & 15; const float fb = 1e-4f + (float)i * ((15.0f - 1e-4f) / 15.0f); const float a = 6.283185307179586f * (fb * rev);
                z = k <= 16 ? cosf(a) : -sinf(a); }
            float acc = B1;
#pragma unroll
            for (int q = 0; q < 33; ++q) acc += lane_bcast(z, q) * W1[q];
            float h = sinf(fr * acc);
            acc = B2;
#pragma unroll
            for (int q = 0; q < 64; ++q) acc += lane_bcast(h, q) * W2[q];
            h = sinf(fr * acc);
            acc = B3;
#pragma unroll
            for (int q = 0; q < 64; ++q) acc += lane_bcast(h, q) * W3[q];
            hdn[((size_t)j * (SEQ + CTXL) + tt) * 64 + F.lane] = sinf(fr * acc);
        }
    }
}

typedef float f32x16_t __attribute__((ext_vector_type(16)));
__device__ __forceinline__ void split8(const float (&v)[8], bf16x8& h, bf16x8& l) {
    u32x4 hw, lw;
#pragma unroll
    for (int i = 0; i < 4; ++i) { const unsigned w = cvt_pk_bf16(v[2 * i], v[2 * i + 1]); hw[i] = w; lw[i] = cvt_pk_bf16(v[2 * i] - bflo(w), v[2 * i + 1] - bfhi(w)); }
    h = *(bf16x8*)&hw; l = *(bf16x8*)&lw;
}
template <typename TK>
__device__ __forceinline__ void hy_filt_tiles(const Fr& F, const float* hdn  , const float* w4  , TK* KF, int L, int first, int stride) {
    const int m = F.lane & 31, hi = F.lane >> 5;
    const int ntiles = ((L + 511) / 512) * 32;
    for (int tile = first; tile < ntiles; tile += stride) {
        const int t0 = (tile >> 5) * 512, c0 = (tile & 31) * 64;
#pragma unroll 1
        for (int bank = 0; bank < 2; ++bank) {
            bf16x8 Ah[2][4], Al[2][4];
#pragma unroll
            for (int mb = 0; mb < 2; ++mb) { const float* wp = w4 + bank * 2048 + c0 + mb * 32 + m + (size_t)(8 * hi) * 4096;
#pragma unroll
                for (int ks = 0; ks < 4; ++ks) { float v[8];
#pragma unroll
                    for (int e = 0; e < 8; ++e) v[e] = wp[(size_t)(16 * ks + e) * 4096];
                    split8(v, Ah[mb][ks], Al[mb][ks]); } }
#pragma unroll 1
            for (int nb = 0; nb < 2; ++nb) {
                const int tpos = t0 + 64 * F.wave + 32 * nb + m, tl = tpos < L ? tpos : L - 1;
                bf16x8 Bh[4], Bl[4];
#pragma unroll
                for (int ks = 0; ks < 4; ++ks) { const float* hp = hdn + (size_t)tl * 64 + 16 * ks + 8 * hi; const f32x4 x0 = *(const f32x4*)hp, x1 = *(const f32x4*)(hp + 4);
                    const float v[8] = {x0.x, x0.y, x0.z, x0.w, x1.x, x1.y, x1.z, x1.w}; split8(v, Bh[ks], Bl[ks]); }
                const float tn = (float)tpos / (float)(L - 1);
#pragma unroll
                for (int mb = 0; mb < 2; ++mb) {
                    f32x16_t acc = {0.f, 0.f, 0.f, 0.f, 0.f, 0.f, 0.f, 0.f, 0.f, 0.f, 0.f, 0.f, 0.f, 0.f, 0.f, 0.f};
#pragma unroll
                    for (int ks = 0; ks < 4; ++ks) { acc = __builtin_amdgcn_mfma_f32_32x32x16_bf16(Ah[mb][ks], Bh[ks], acc, 0, 0, 0);
                        acc = __builtin_amdgcn_mfma_f32_32x32x16_bf16(Ah[mb][ks], Bl[ks], acc, 0, 0, 0); acc = __builtin_amdgcn_mfma_f32_32x32x16_bf16(Al[mb][ks], Bh[ks], acc, 0, 0, 0); }
                    if (tpos < L) {
                        const int cb = c0 + mb * 32 + 4 * hi;
                        TK* dst = KF + (size_t)cb * (2 * L) + (bank ? (tpos > 0 ? 2 * L - tpos : L) : tpos);
#pragma unroll
                        for (int r = 0; r < 16; ++r) { const int mm = (r & 3) + 8 * (r >> 2);
                            const float dl = 3.0701134573253946f + 12.280453829301578f * ((float)(cb + mm) * (1.0f / 2047.0f));
                            const float kv = (bank && tpos == 0) ? 0.f : acc[r] * __expf(-tn * dl);
                            if constexpr (sizeof(TK) == 2) dst[(size_t)mm * (2 * L)] = (bf16_t)(cvt_pk_bf16(kv, 0.f) & 0xffffu); else dst[(size_t)mm * (2 * L)] = kv; }
                    }
                }
            }
        }
    }
}

__device__ __forceinline__ void hy_filt_long(const Fr& F, const float* hdn  , const float* w4  , bf16_t* KF, int first, int stride) {
    constexpr int L = SEQ, PITCH = 144;
    const int m = F.lane & 31, hi = F.lane >> 5;
    LAS unsigned char* T = (LAS unsigned char*)(F.lds + F.wave * 16384);
    const int ntiles = (L / 512) * 32;
    for (int tile = first; tile < ntiles; tile += stride) {
        const int t0 = (tile >> 5) * 512, c0 = (tile & 31) * 64, tw = t0 + 64 * F.wave;
#pragma unroll 1
        for (int bank = 0; bank < 2; ++bank) {
            bf16x8 Ah[2][4], Al[2][4];
#pragma unroll
            for (int mb = 0; mb < 2; ++mb) { const float* wp = w4 + bank * 2048 + c0 + mb * 32 + m + (size_t)(8 * hi) * 4096;
#pragma unroll
                for (int ks = 0; ks < 4; ++ks) { float v[8];
#pragma unroll
                    for (int e = 0; e < 8; ++e) v[e] = wp[(size_t)(16 * ks + e) * 4096];
                    split8(v, Ah[mb][ks], Al[mb][ks]); } }
            f32x16_t acc[2][2];
#pragma unroll
            for (int nb = 0; nb < 2; ++nb) {
                const int tpos = tw + 32 * nb + m + bank, tl = tpos < L ? tpos : L - 1;
                bf16x8 Bh[4], Bl[4];
#pragma unroll
                for (int ks = 0; ks < 4; ++ks) { const float* hp = hdn + (size_t)tl * 64 + 16 * ks + 8 * hi; const f32x4 x0 = *(const f32x4*)hp, x1 = *(const f32x4*)(hp + 4);
                    const float v[8] = {x0.x, x0.y, x0.z, x0.w, x1.x, x1.y, x1.z, x1.w}; split8(v, Bh[ks], Bl[ks]); }
#pragma unroll
                for (int mb = 0; mb < 2; ++mb) {
                    f32x16_t a = {0.f, 0.f, 0.f, 0.f, 0.f, 0.f, 0.f, 0.f, 0.f, 0.f, 0.f, 0.f, 0.f, 0.f, 0.f, 0.f};
#pragma unroll
                    for (int ks = 0; ks < 4; ++ks) { a = __builtin_amdgcn_mfma_f32_32x32x16_bf16(Ah[mb][ks], Bh[ks], a, 0, 0, 0);
                        a = __builtin_amdgcn_mfma_f32_32x32x16_bf16(Ah[mb][ks], Bl[ks], a, 0, 0, 0); a = __builtin_amdgcn_mfma_f32_32x32x16_bf16(Al[mb][ks], Bh[ks], a, 0, 0, 0); }
                    acc[nb][mb] = a; }
            }
#pragma unroll
            for (int mb = 0; mb < 2; ++mb) {
#pragma unroll
                for (int nb = 0; nb < 2; ++nb) {
                    const int tpos = tw + 32 * nb + m + bank, col = bank ? 63 - (32 * nb + m) : 32 * nb + m;
                    const float tn = (float)tpos / (float)(L - 1);
#pragma unroll
                    for (int r = 0; r < 16; ++r) { const int chl = (r & 3) + 8 * (r >> 2) + 4 * hi;
                        const float dl = 3.0701134573253946f + 12.280453829301578f * ((float)(c0 + mb * 32 + chl) * (1.0f / 2047.0f));
                        const float kv = tpos >= L ? 0.f : acc[nb][mb][r] * __expf(-tn * dl);
                        *(LAS bf16_t*)(T + chl * PITCH + col * 2) = (bf16_t)(cvt_pk_bf16(kv, 0.f) & 0xffffu); }
                }
                LDS_WAIT(); asm volatile("" ::: "memory");
                const size_t i0 = bank ? (size_t)(2 * L - tw - 64) : (size_t)tw;
#pragma unroll
                for (int k = 0; k < 4; ++k) { const int q = F.lane + 64 * k, ch = q >> 3, seg = q & 7;
                    const u32x4 w = *(const LAS u32x4*)(T + ch * PITCH + seg * 16);
                    *(u32x4*)(KF + (size_t)(c0 + mb * 32 + ch) * (2 * L) + i0 + seg * 8) = w; }
                LDS_WAIT(); asm volatile("" ::: "memory");
            }
        }
    }
}

__device__ __forceinline__ void nr_load(const float* src_lat, const float* src_ctx, const bf16_t* X, bool f32in, int r, int lane, f32x4 (&v)[8]) {
    if (f32in) { const float* xr = (r < M_LAT ? src_lat + (size_t)r * D : src_ctx + (size_t)(r - M_LAT) * D) + 8 * lane;
#pragma unroll
        for (int j = 0; j < 4; ++j) { v[2 * j] = *(const f32x4*)(xr + 512 * j); v[2 * j + 1] = *(const f32x4*)(xr + 512 * j + 4); } }
    else { const bf16_t* xr = X + (size_t)r * D + 8 * lane;
#pragma unroll
        for (int j = 0; j < 4; ++j) { const u32x4 w = *(const u32x4*)(xr + 512 * j);
            v[2 * j] = (f32x4){bflo(w.x), bfhi(w.x), bflo(w.y), bfhi(w.y)}; v[2 * j + 1] = (f32x4){bflo(w.z), bfhi(w.z), bflo(w.w), bfhi(w.w)}; } }
}
struct CtxPend { const float* slab; int ks; const float* gate; const float* bias; const float* base32; };
__device__ __forceinline__ void norm_rows(const Fr& F, const float* src_lat, const float* src_ctx, bf16_t* X, bool f32in, int nrows, const float* g, const float* modl, int sh_off, int sc_off, bf16_t* A, const CtxPend cp) {
    int r = F.gw; if (r >= nrows) return;
    f32x4 v[8]; nr_load(src_lat, src_ctx, X, f32in, r, F.lane, v);
    f32x4 ca[8], cb[8]; int ccond = -1;
    for (;;) {
        const int rn = r + F.ngw; const bool more = rn < nrows;
        f32x4 vn[8];
        if (more) { if (cp.base32 && rn >= M_LAT) nr_load(nullptr, cp.base32, X, true, rn, F.lane, vn); else nr_load(src_lat, src_ctx, X, f32in, rn, F.lane, vn); }
        const int cond = r < M_LAT ? (r >> 14) : 2;
        if (cp.slab && r >= M_LAT) {
            const int rc = r - M_LAT;
#pragma unroll
            for (int j = 0; j < 4; ++j) { const int c = 8 * F.lane + 512 * j;
                f32x4 s0 = {0.f, 0.f, 0.f, 0.f}, s1 = s0;
                for (int kc = 0; kc < cp.ks; ++kc) { const float* sp = cp.slab + ((size_t)kc * 512 + rc) * D + c; s0 += *(const f32x4*)sp; s1 += *(const f32x4*)(sp + 4); }
                if (cp.bias) { s0 += *(const f32x4*)(cp.bias + c); s1 += *(const f32x4*)(cp.bias + c + 4); }
                const f32x4 x0 = v[2 * j] + *(const f32x4*)(cp.gate + c) * s0, x1 = v[2 * j + 1] + *(const f32x4*)(cp.gate + c + 4) * s1;
                u32x4 o; o.x = cvt_pk_bf16(x0.x, x0.y); o.y = cvt_pk_bf16(x0.z, x0.w); o.z = cvt_pk_bf16(x1.x, x1.y); o.w = cvt_pk_bf16(x1.z, x1.w);
                *(u32x4*)(X + (size_t)r * D + c) = o;
                v[2 * j] = (f32x4){bflo(o.x), bfhi(o.x), bflo(o.y), bfhi(o.y)}; v[2 * j + 1] = (f32x4){bflo(o.z), bfhi(o.z), bflo(o.w), bfhi(o.w)}; }
        }
        if (cond != ccond) {
            const float* sh = modl + cond * NMOD + sh_off; const float* sc = modl + cond * NMOD + sc_off;
#pragma unroll
            for (int j = 0; j < 4; ++j)
#pragma unroll
                for (int q = 0; q < 2; ++q) { const int c = 8 * F.lane + 512 * j + 4 * q; ca[2 * j + q] = *(const f32x4*)(g + c) * (*(const f32x4*)(sc + c) + 1.0f); cb[2 * j + q] = *(const f32x4*)(sh + c); }
            ccond = cond;
        }
        float ss = 0.f;
#pragma unroll
        for (int j = 0; j < 8; ++j) ss += (v[j].x * v[j].x + v[j].y * v[j].y) + (v[j].z * v[j].z + v[j].w * v[j].w);
        const float rstd = 1.0f / sqrtf(wave_sum(ss) * (1.0f / D) + NORM_EPS);
#pragma unroll
        for (int j = 0; j < 4; ++j) { const int c = 8 * F.lane + 512 * j; f32x4 y[2];
#pragma unroll
            for (int q = 0; q < 2; ++q) y[q] = (v[2 * j + q] * rstd) * ca[2 * j + q] + cb[2 * j + q];
            u32x4 o; o.x = cvt_pk_bf16(y[0].x, y[0].y); o.y = cvt_pk_bf16(y[0].z, y[0].w); o.z = cvt_pk_bf16(y[1].x, y[1].y); o.w = cvt_pk_bf16(y[1].z, y[1].w);
            *(u32x4*)(A + (size_t)r * D + c) = o; }
        if (!more) break;
        r = rn;
#pragma unroll
        for (int j = 0; j < 8; ++j) v[j] = vn[j];
    }
}
__device__ __forceinline__ void final_norm(const Fr& F, const bf16_t* X, const float* g, float* out) {
    int r = F.gw; if (r >= M_LAT) return;
    f32x4 v[8]; nr_load(nullptr, nullptr, X, false, r, F.lane, v);
    f32x4 gv[8];
#pragma unroll
    for (int j = 0; j < 4; ++j)
#pragma unroll
        for (int q = 0; q < 2; ++q) gv[2 * j + q] = *(const f32x4*)(g + 8 * F.lane + 512 * j + 4 * q);
    for (;;) {
        const int rn = r + F.ngw; const bool more = rn < M_LAT;
        f32x4 vn[8];
        if (more) nr_load(nullptr, nullptr, X, false, rn, F.lane, vn);
        float ss = 0.f;
#pragma unroll
        for (int j = 0; j < 8; ++j) ss += (v[j].x * v[j].x + v[j].y * v[j].y) + (v[j].z * v[j].z + v[j].w * v[j].w);
        const float rstd = 1.0f / sqrtf(wave_sum(ss) * (1.0f / D) + NORM_EPS);
#pragma unroll
        for (int j = 0; j < 4; ++j)
#pragma unroll
            for (int q = 0; q < 2; ++q) { const int c = 8 * F.lane + 512 * j + 4 * q; *(f32x4*)(out + (size_t)r * D + c) = (v[2 * j + q] * rstd) * gv[2 * j + q]; }
        if (!more) break;
        r = rn;
#pragma unroll
        for (int j = 0; j < 8; ++j) v[j] = vn[j];
    }
}

struct ZR { u32x4 m, c, p; };
__device__ __forceinline__ ZR zr_load(const bf16_t* zr  , int ld, int col, bool hp, bool hn) {
    const u32x4 z0 = {0u, 0u, 0u, 0u}; ZR z;
    z.m = hp ? *(const u32x4*)(zr - ld + col) : z0; z.c = *(const u32x4*)(zr + col); z.p = hn ? *(const u32x4*)(zr + ld + col) : z0; return z;
}
__device__ __forceinline__ void w8_load(const float* w, int wld, const float* b, int col, float (&wv)[3][8], float (&bv)[8]) {
#pragma unroll
    for (int k = 0; k < 3; ++k) { const f32x4 a = *(const f32x4*)(w + k * wld + col), c = *(const f32x4*)(w + k * wld + col + 4);
        wv[k][0] = a.x; wv[k][1] = a.y; wv[k][2] = a.z; wv[k][3] = a.w; wv[k][4] = c.x; wv[k][5] = c.y; wv[k][6] = c.z; wv[k][7] = c.w; }
    if (b) { const f32x4 a = *(const f32x4*)(b + col), c = *(const f32x4*)(b + col + 4); bv[0] = a.x; bv[1] = a.y; bv[2] = a.z; bv[3] = a.w; bv[4] = c.x; bv[5] = c.y; bv[6] = c.z; bv[7] = c.w; }
    else {
#pragma unroll
        for (int e = 0; e < 8; ++e) bv[e] = 0.f; }
}
__device__ __forceinline__ void conv3_w(const ZR& z, const float (&wv)[3][8], const float (&bv)[8], float (&out)[8]) {
#pragma unroll
    for (int e = 0; e < 8; ++e) out[e] = BFE(z.m, e) * wv[0][e] + BFE(z.c, e) * wv[1][e] + BFE(z.p, e) * wv[2][e] + bv[e];
}
__device__ __forceinline__ void row_pos(int r, int& tpos, int& Ls) { if (r < M_LAT) { Ls = SEQ; tpos = r & (SEQ - 1); } else { Ls = CTXL; tpos = (r - M_LAT) & (CTXL - 1); } }
__device__ __forceinline__ bf16_t* vt_addr(bf16_t* VT, bf16_t* VTC, int r0, int ch) {
    if (r0 < M_LAT) return VT + ((size_t)((r0 >> 14) * D + ch) * SEQ + (r0 & (SEQ - 1)));
    const int q = r0 - M_LAT; return VTC + ((size_t)((q >> 8) * D + ch) * CTXL + (q & (CTXL - 1)));
}
__device__ __forceinline__ u32x4 pack8(const float (&y)[8]) { u32x4 o; o.x = cvt_pk_bf16(y[0], y[1]); o.y = cvt_pk_bf16(y[2], y[3]); o.z = cvt_pk_bf16(y[4], y[5]); o.w = cvt_pk_bf16(y[6], y[7]); return o; }

__device__ __forceinline__ void hy_elem_phase(const Fr& F, const bf16_t* Z, const float* sw, const float* sb, bf16_t* VT, bf16_t* VTC, int nrows) {
    LAS float* T0 = (LAS float*)F.lds;
    int par = 0;
    const int ntiles = (nrows / 64) * 32, tt = F.tid >> 3, cg = F.tid & 7;
    int tile = F.blk; if (tile >= ntiles) return;
    float w1[3][8], b1[8], w2[3][8], b2[8]; int cw = -1;
    ZR za, zb;
    { const int r = (tile >> 5) * 64 + tt, c = (tile & 31) * 64 + 8 * cg; int tpos, Ls; row_pos(r, tpos, Ls); const bf16_t* zr = Z + (size_t)r * (3 * D);
      za = zr_load(zr, 3 * D, D + c, tpos > 0, tpos < Ls - 1); zb = zr_load(zr, 3 * D, 2 * D + c, tpos > 0, tpos < Ls - 1); }
    for (;;) {
        LAS float* T = T0 + par * (64 * 65); par ^= 1;
        const int r0 = (tile >> 5) * 64, c0 = (tile & 31) * 64, c = c0 + 8 * cg;
        const int nt = tile + F.nblk; const bool more = nt < ntiles;
        ZR na = za, nb = zb;
        if (more) { const int r = (nt >> 5) * 64 + tt, cn = (nt & 31) * 64 + 8 * cg; int tpos, Ls; row_pos(r, tpos, Ls); const bf16_t* zr = Z + (size_t)r * (3 * D);
            na = zr_load(zr, 3 * D, D + cn, tpos > 0, tpos < Ls - 1); nb = zr_load(zr, 3 * D, 2 * D + cn, tpos > 0, tpos < Ls - 1); }
        if (c != cw) { w8_load(sw, 3 * D, sb, D + c, w1, b1); w8_load(sw, 3 * D, sb, 2 * D + c, w2, b2); cw = c; }
        float x1[8], vv[8];
        conv3_w(za, w1, b1, x1); conv3_w(zb, w2, b2, vv);
#pragma unroll
        for (int e = 0; e < 8; ++e) T[tt * 65 + 8 * cg + e] = vv[e] * x1[e];
        __syncthreads();
        { const int ch = F.tid >> 3, chunk = F.tid & 7; float y[8];
#pragma unroll
          for (int i = 0; i < 8; ++i) y[i] = T[(8 * chunk + i) * 65 + ch];
          *(u32x4*)(vt_addr(VT, VTC, r0, c0 + ch) + 8 * chunk) = pack8(y); }
        if (!more) break;
        tile = nt; za = na; zb = nb;
    }
}
__device__ __forceinline__ void hy_post_phase(const Fr& F, const bf16_t* Z, const float* sw, const float* sb, bf16_t* VT, bf16_t* VTC, bf16_t* A, int nrows) {
    LAS float* T0 = (LAS float*)F.lds;
    int par = 0;
    const int ntiles = (nrows / 64) * 32, tt = F.tid >> 3, cg = F.tid & 7;
    int tile = F.blk; if (tile >= ntiles) return;
    float w0[3][8], b0[8]; int cw = -1;
    ZR za; u32x4 yv;
    { const int r0 = (tile >> 5) * 64, c0 = (tile & 31) * 64, r = r0 + tt; int tpos, Ls; row_pos(r, tpos, Ls);
      za = zr_load(Z + (size_t)r * (3 * D), 3 * D, c0 + 8 * cg, tpos > 0, tpos < Ls - 1); yv = *(const u32x4*)(vt_addr(VT, VTC, r0, c0 + (F.tid >> 3)) + 8 * (F.tid & 7)); }
    for (;;) {
        LAS float* T = T0 + par * (64 * 65); par ^= 1;
        const int r0 = (tile >> 5) * 64, c0 = (tile & 31) * 64, r = r0 + tt, c = c0 + 8 * cg;
        const int nt = tile + F.nblk; const bool more = nt < ntiles;
        ZR na = za; u32x4 yn = yv;
        if (more) { const int r0n = (nt >> 5) * 64, c0n = (nt & 31) * 64, rn = r0n + tt; int tpos, Ls; row_pos(rn, tpos, Ls);
            na = zr_load(Z + (size_t)rn * (3 * D), 3 * D, c0n + 8 * cg, tpos > 0, tpos < Ls - 1); yn = *(const u32x4*)(vt_addr(VT, VTC, r0n, c0n + (F.tid >> 3)) + 8 * (F.tid & 7)); }
        { const int ch = F.tid >> 3, chunk = F.tid & 7;
#pragma unroll
          for (int i = 0; i < 8; ++i) T[(8 * chunk + i) * 65 + ch] = BFE(yv, i); }
        __syncthreads();
        if (c != cw) { w8_load(sw, 3 * D, sb, c, w0, b0); cw = c; }
        float x0[8], y[8];
        conv3_w(za, w0, b0, x0);
#pragma unroll
        for (int e = 0; e < 8; ++e) y[e] = T[tt * 65 + 8 * cg + e] * x0[e];
        *(u32x4*)(A + (size_t)r * D + c) = pack8(y);
        if (!more) break;
        tile = nt; za = na; yv = yn;
    }
}
struct SC7 { u32x4 gb, gcm, gcc, gcp, xvm, xvc, xvp; };
__device__ __forceinline__ SC7 sc_load(const bf16_t* Z, int r, int c) {
    int tpos, Ls; row_pos(r, tpos, Ls); const bf16_t* zr = Z + (size_t)r * (3 * D); const bool hp = tpos > 0, hn = tpos < Ls - 1; const u32x4 z0 = {0u, 0u, 0u, 0u};
    SC7 s; s.gb = *(const u32x4*)(zr + c); s.gcc = *(const u32x4*)(zr + D + c); s.xvc = *(const u32x4*)(zr + 2 * D + c);
    s.gcm = hp ? *(const u32x4*)(zr - 3 * D + D + c) : z0; s.xvm = hp ? *(const u32x4*)(zr - 3 * D + 2 * D + c) : z0;
    s.gcp = hn ? *(const u32x4*)(zr + 3 * D + D + c) : z0; s.xvp = hn ? *(const u32x4*)(zr + 3 * D + 2 * D + c) : z0; return s;
}
__device__ __forceinline__ void sc_elem_phase(const Fr& F, const bf16_t* Z, const float* cw  , bf16_t* A, int nrows) {
    const size_t nitems = (size_t)nrows * 256, step = (size_t)F.nblk * NTHREADS;
    size_t idx = (size_t)F.blk * NTHREADS + F.tid; if (idx >= nitems) return;
    float wv[3][8], bv[8]; int cl = -1;
    SC7 s = sc_load(Z, (int)(idx >> 8), 8 * (int)(idx & 255));
    for (;;) {
        const int r = (int)(idx >> 8), c = 8 * (int)(idx & 255);
        const size_t nx = idx + step; const bool more = nx < nitems;
        SC7 sn = s; if (more) sn = sc_load(Z, (int)(nx >> 8), 8 * (int)(nx & 255));
        if (c != cl) { w8_load(cw, D, nullptr, c, wv, bv); cl = c; }
        float y[8];
#pragma unroll
        for (int e = 0; e < 8; ++e) { const float pm = BFE(s.gcm, e) * BFE(s.xvm, e), pc = BFE(s.gcc, e) * BFE(s.xvc, e), pp = BFE(s.gcp, e) * BFE(s.xvp, e);
            y[e] = BFE(s.gb, e) * (pm * wv[0][e] + pc * wv[1][e] + pp * wv[2][e]); }
        *(u32x4*)(A + (size_t)r * D + c) = pack8(y);
        if (!more) break;
        idx = nx; s = sn;
    }
}
__device__ __forceinline__ void qk_prep_phase(const Fr& F, const bf16_t* Z  , const float* qg, const float* kg, bf16_t* Q, bf16_t* KALL, bf16_t* VALL) {
    const int p = F.lane;
    constexpr float QSC = 0.088388347648318440f * 1.4426950408889634f;
    const float qg1 = qg[2 * p] * QSC, qg2 = qg[2 * p + 1] * QSC, kg1 = kg[2 * p], kg2 = kg[2 * p + 1];
    const float invf = exp2f(-(float)(p & 31) * (13.287712379549449f / 32.0f));
    int r = F.gw; if (r >= M_ALL) return;
    unsigned w[24];
#pragma unroll
    for (int h = 0; h < 24; ++h) w[h] = *(const unsigned*)(Z + (size_t)r * 3072 + h * HD + 2 * p);
    for (;;) {
        const int rn = r + F.ngw; const bool more = rn < M_ALL;
        unsigned wn[24];
        if (more) {
#pragma unroll
            for (int h = 0; h < 24; ++h) wn[h] = *(const unsigned*)(Z + (size_t)rn * 3072 + h * HD + 2 * p); }
        const bool lat = r < M_LAT; const int b = lat ? (r >> 14) : ((r - M_LAT) >> 8), t = lat ? (r & (SEQ - 1)) : ((r - M_LAT) & (CTXL - 1));
        float cs = 1.f, sn = 0.f;
        if (lat) { const float ang = (float)(p < 32 ? (t >> 6) : (t & 63)) * invf; sn = sinf(ang); cs = cosf(ang); }
        if (lat) {
#pragma unroll
            for (int h = 0; h < NH; ++h) { const float x1 = bflo(w[h]), x2 = bfhi(w[h]);
                const float rstd = 1.0f / sqrtf(wave_sum(x1 * x1 + x2 * x2) * (1.0f / HD) + NORM_EPS);
                const float y1 = x1 * rstd * qg1, y2 = x2 * rstd * qg2;
                *(unsigned*)(Q + (size_t)r * D + h * HD + 2 * p) = cvt_pk_bf16(y1 * cs - y2 * sn, y1 * sn + y2 * cs); }
        }
        const size_t kpos = (size_t)(lat ? t : SEQ + t);
#pragma unroll
        for (int h = 0; h < NKV; ++h) { const float x1 = bflo(w[NH + h]), x2 = bfhi(w[NH + h]);
            const float rstd = 1.0f / sqrtf(wave_sum(x1 * x1 + x2 * x2) * (1.0f / HD) + NORM_EPS);
            const float y1 = x1 * rstd * kg1, y2 = x2 * rstd * kg2;
            const size_t ko = (((size_t)b * NKV + h) * LK + kpos) * HD + 2 * p;
            *(unsigned*)(KALL + ko) = cvt_pk_bf16(y1 * cs - y2 * sn, y1 * sn + y2 * cs);
            *(unsigned*)(VALL + ko) = w[NH + NKV + h]; }
        if (!more) break;
        r = rn;
#pragma unroll
        for (int h = 0; h < 24; ++h) w[h] = wn[h];
    }
}
__device__ __forceinline__ void hy_ctx_conv(const Fr& F, const float* KFC  , const float* skip, bf16_t* VTC  ) {
    LAS float* kp = (LAS float*)(F.lds + F.wave * 4096);
    LAS float* us = kp + 512;
    for (int pr = F.gw; pr < NB * D; pr += F.ngw) {
        const int c = pr & (D - 1);
        const float* kf = KFC + (size_t)c * 512; bf16_t* up = VTC + (size_t)pr * CTXL;
        *(LAS f32x4*)(kp + 4 * F.lane) = *(const f32x4*)(kf + 4 * F.lane); *(LAS f32x4*)(kp + 256 + 4 * F.lane) = *(const f32x4*)(kf + 256 + 4 * F.lane);
        const u32x2 uw = *(const u32x2*)(up + 4 * F.lane);
        *(LAS f32x4*)(us + 4 * F.lane) = (f32x4){bflo(uw.x), bfhi(uw.x), bflo(uw.y), bfhi(uw.y)};
        LDS_WAIT(); asm volatile("" ::: "memory");
        float acc[4] = {0.f, 0.f, 0.f, 0.f};
#pragma unroll 4
        for (int s = 0; s < CTXL; ++s) { const float u = us[s];
#pragma unroll
            for (int q = 0; q < 4; ++q) acc[q] += kp[(F.lane + 64 * q - s) & 511] * u; }
        const float sk = skip[c];
#pragma unroll
        for (int q = 0; q < 4; ++q) { const int t = F.lane + 64 * q; up[t] = (bf16_t)(cvt_pk_bf16(acc[q] + sk * us[t], 0.f) & 0xffffu); }
        LDS_WAIT(); asm volatile("" ::: "memory");
    }
}
#ifndef PROBE_AMP
#define PROBE_AMP 0
#define PROBE_MASK 0ull
#endif
#ifndef PROBE_CYCLES
#define PROBE_CYCLES 0
#endif
#ifndef STAG_GU
#define STAG_GU 0
#define STAG_N 2
#endif
#ifndef STAG_RS
#define STAG_RS 0
#endif
#ifndef EN_DEFAULT
#define EN_DEFAULT 1
#endif
#ifndef EN_PRO
#define EN_PRO EN_DEFAULT
#endif
#ifndef EN_NORM
#define EN_NORM EN_DEFAULT
#endif
#ifndef EN_FILT
#define EN_FILT EN_DEFAULT
#endif
#ifndef EN_G1
#define EN_G1 EN_DEFAULT
#endif
#ifndef EN_HYE
#define EN_HYE EN_DEFAULT
#endif
#ifndef EN_FFT
#define EN_FFT EN_DEFAULT
#endif
#ifndef EN_ATT
#define EN_ATT EN_DEFAULT
#endif
#ifndef EN_G2
#define EN_G2 EN_DEFAULT
#endif
#ifndef EN_G3
#define EN_G3 EN_DEFAULT
#endif
#ifndef EN_G4
#define EN_G4 EN_DEFAULT
#endif
struct Args { const float* in[34]; float* out; unsigned char* ws; int ph_lo, ph_hi; };
static_assert(offsetof(Args, out) == 34 * 8 && offsetof(Args, ws) == 35 * 8, "Args layout");
enum { I_X = 0, I_C, I_CTX, I_CCTX, I_N1G, I_N2G, I_WMOD, I_BMOD, I_FG, I_FU, I_FD, I_HWIN, I_HBIN, I_HSW, I_HSB, I_HFW1, I_HFB1, I_HFW2, I_HFB2, I_HFW3, I_HFB3, I_HFW4, I_HFREQ, I_HSKIP, I_HWOUT, I_HBOUT,
       I_SWIN, I_SCW, I_SWOUT, I_AQKV, I_AQG, I_AKG, I_AWO, I_FING };

__device__ __forceinline__ WSet wset_of(const Fr& F, int layer) {
    const int kind = layer % 3, j = layer / 3; WSet w;
#define IN_(i) ((const float*)(GAS const float*)F.ka[i])
    w.gate = IN_(I_FG) + (size_t)layer * D * DFF; w.up = IN_(I_FU) + (size_t)layer * D * DFF; w.down = IN_(I_FD) + (size_t)layer * DFF * D; w.nin = kind == 2 ? 3072 : 3 * D;
    if (kind == 0) { w.win = IN_(I_HWIN) + (size_t)j * D * 3 * D; w.wout = IN_(I_HWOUT) + (size_t)j * D * D; }
    else if (kind == 1) { w.win = IN_(I_SWIN); w.wout = IN_(I_SWOUT); }
    else { w.win = IN_(I_AQKV); w.wout = IN_(I_AWO); }
#undef IN_
    return w;
}
constexpr int WC1_A = 12000;
constexpr int WC2_A = 10000;
constexpr int WC3_A = 10000;
__device__ __forceinline__ void wconv_idle(const Fr& F, int layer, int nunits, int lo, int hi) {
    int nbusy = nunits % F.nblk; if (nbusy == 0 || F.nblk - nbusy < 8) nbusy = 0;
    if (F.blk < nbusy) return;
    const WSet w = wset_of(F, layer); LAS float* scr = (LAS float*)(F.lds + F.wave * 16384);
    int it = lo + (F.blk - nbusy) * NWAVES + F.wave;
    wconv_part(F, w, F.ws + w_slot_off(layer), scr, it, 1 << 30, (F.nblk - nbusy) * NWAVES, hi);
}
__device__ __forceinline__ void hy_fft_phase(const Fr& F, const bf16_t* KF  , const float* skip, bf16_t* VT  , float* KSP  , bool conv) {
    LAS f32x2* L = (LAS f32x2*)F.lds;
    const int t = F.tid;
    int it1 = WC1_A + F.gw; LAS float* scr = (LAS float*)(F.lds + F.wave * 16384);
#pragma unroll 1
    for (int c = F.blk; c < D; c += F.nblk) {
        float* K = KSP + (size_t)F.blk * (66 * 512);
        unsigned un[16];
        {
            cf v[32]; const bf16_t* kf = KF + (size_t)c * (2 * SEQ); unsigned ut = (unsigned)t; FFT_OPAQUE(ut);
#pragma unroll
            for (int n1 = 0; n1 < 32; ++n1) { const unsigned w = *(const unsigned*)(kf + (1024 * n1 + 2 * ut)); v[n1] = cf{bflo(w), bfhi(w)}; }
            fft_f1(L, t, v); __syncthreads(); fft_f2(L, t); __syncthreads();
            {   unsigned ut = (unsigned)t; FFT_OPAQUE(ut); const bf16_t* up0 = VT + (size_t)c * SEQ;
#pragma unroll
                for (int n1 = 0; n1 < 16; ++n1) un[n1] = *(const unsigned*)(up0 + (1024 * n1 + 2 * ut)); }
            fft_p3<LAS f32x2*, false>(L, t); __syncthreads();
            { float Kz[66]; fft_pair<LAS f32x2*, 0>(L, t, K, Kz); } __syncthreads();
        }
        const float sk = skip[c];
#pragma unroll 1
        for (int b = 0; b < NB; ++b) {
            bf16_t* up = VT + (size_t)(b * D + c) * SEQ;
            unsigned uw[16];
#pragma unroll
            for (int n1 = 0; n1 < 16; ++n1) uw[n1] = un[n1];
            {   cf v[32];
#pragma unroll
                for (int n1 = 0; n1 < 16; ++n1) v[n1] = cf{bflo(uw[n1]), bfhi(uw[n1])};
#pragma unroll
                for (int n1 = 16; n1 < 32; ++n1) v[n1] = cf{0.f, 0.f};
                fft_f1(L, t, v); }
            __syncthreads(); fft_f2(L, t); __syncthreads();
            float Kr[66]; fft_kload(K, t, Kr);
            fft_p3<LAS f32x2*, false>(L, t); __syncthreads();
            fft_pair<LAS f32x2*, 1>(L, t, K, Kr); __syncthreads();
            if (b + 1 < NB) { unsigned ut = (unsigned)t; FFT_OPAQUE(ut); const bf16_t* upn = VT + (size_t)((b + 1) * D + c) * SEQ;
#pragma unroll
                for (int n1 = 0; n1 < 16; ++n1) un[n1] = *(const unsigned*)(upn + (1024 * n1 + 2 * ut)); }
            fft_p3<LAS f32x2*, true>(L, t); __syncthreads(); fft_i2(L, t); __syncthreads();
            {   unsigned ut = (unsigned)t; FFT_OPAQUE(ut);
#pragma unroll
                for (int n1 = 0; n1 < 16; ++n1) uw[n1] = *(const unsigned*)(up + (1024 * n1 + 2 * ut));
                cf v[32]; fft_i1(L, t, v);
#pragma unroll
                for (int n1 = 0; n1 < 16; ++n1) *(unsigned*)(up + (1024 * n1 + 2 * ut)) = cvt_pk_bf16(v[n1].x * (1.0f / 131072.0f) + sk * bflo(uw[n1]), v[n1].y * (1.0f / 131072.0f) + sk * bfhi(uw[n1])); }
        }
        if (conv) {
            __syncthreads();
            { const WSet w1 = wset_of(F, 1); wconv_part(F, w1, F.ws + w_slot_off(1), scr, it1, 1); }
            __syncthreads();
        }
    }
    __syncthreads();
    if (conv) {
        { const WSet w1 = wset_of(F, 1); wconv_part(F, w1, F.ws + w_slot_off(1), scr, it1, 1 << 30); }
        __syncthreads();
    }
}

__device__ __forceinline__ Fr fr_fresh(const Fr& F0) {
    Fr G = F0; int t = threadIdx.x; asm volatile("" : "+v"(t));
    G.tid = t; G.lane = t & 63; G.wave = __builtin_amdgcn_readfirstlane(t >> 6); G.gw = G.blk * NWAVES + G.wave;
    unsigned long long kv = (unsigned long long)__builtin_amdgcn_kernarg_segment_ptr(); asm volatile("" : "+s"(kv));
    G.ka = (const __attribute__((address_space(4))) unsigned long long*)kv; G.ws = (unsigned char*)(GAS unsigned char*)G.ka[35];
    return G;
}
__global__ void __launch_bounds__(NTHREADS, 2) dit_fwd(Args args) {
    extern __shared__ __attribute__((aligned(16))) unsigned char lds_raw[];
    Fr F0;
    F0.lds = (LAS unsigned char*)lds_raw; F0.ldsg = lds_raw;
    F0.tid = threadIdx.x; F0.lane = F0.tid & 63; F0.wave = __builtin_amdgcn_readfirstlane(F0.tid >> 6);
    F0.blk = blockIdx.x; F0.nblk = gridDim.x; F0.gw = F0.blk * NWAVES + F0.wave; F0.ngw = F0.nblk * NWAVES;
    F0.ka = nullptr; F0.ws = args.ws;
    const int lo = args.ph_lo, hi = args.ph_hi;
    if (F0.tid < 4) ((LAS unsigned*)(F0.lds + LDS_BARW))[F0.tid] = 0u;
    __syncthreads();
    XcdBarrier bar; bar.bar = (unsigned*)(args.ws + WS_CTL) + CW_BAR; bar.x = 0; bar.st = (volatile LAS unsigned*)(F0.lds + LDS_BARW);
    if (hi - lo > 1) bar = xcd_barrier_post((unsigned*)(args.ws + WS_CTL) + CW_BAR, (volatile LAS unsigned*)(F0.lds + LDS_BARW));
    int ph = 0;
#if PROBE_AMP
    unsigned long long pr_acc = 0, pr_t0 = __builtin_amdgcn_s_memrealtime();
#define PH_IF if ((pr_t0 = __builtin_amdgcn_s_memrealtime(), true) && ph >= lo && ph < hi) if (Fr F = fr_fresh(F0); true)
#if PROBE_CYCLES
#undef PH_IF
#define PH_IF if ((pr_t0 = (unsigned long long)clock64(), true) && ph >= lo && ph < hi) if (Fr F = fr_fresh(F0); true)
#define PH_END do { if (ph >= lo && ph + 1 < hi) xcd_barrier(bar); if ((PROBE_MASK >> ph) & 1ull) pr_acc += ((unsigned long long)clock64() - pr_t0) / 24ull; ++ph; } while (0)
#else
#define PH_END do { if (ph >= lo && ph + 1 < hi) xcd_barrier(bar); if ((PROBE_MASK >> ph) & 1ull) pr_acc += __builtin_amdgcn_s_memrealtime() - pr_t0; ++ph; } while (0)
#endif
#else
#define PH_IF if (ph >= lo && ph < hi) if (Fr F = fr_fresh(F0); true)
#define PH_END do { if (ph >= lo && ph + 1 < hi) xcd_barrier(bar); ++ph; } while (0)
#endif
#define IN(i) ((const float*)(GAS const float*)F.ka[i])
#define MOD ((float*)(F.ws + WS_MOD))
#define HDN ((float*)(F.ws + WS_HDN))
#define KFC ((float*)(F.ws + WS_KFC))
#define VTC ((bf16_t*)(F.ws + WS_VTC))
#define XRES ((bf16_t*)(F.ws + WS_XRES))
#define XRES_CTX (XRES + (size_t)M_LAT * D)
#define ABUF ((bf16_t*)(F.ws + WS_A))
#define ZBUF ((bf16_t*)(F.ws + WS_Z))
#define WSLOT(l) (F.ws + w_slot_off(l))
#define WGU ((bf16_t*)(WSLOT(layer) + WO_GU))
#define WD ((bf16_t*)(WSLOT(layer) + WO_D))
#define WIN ((bf16_t*)(WSLOT(layer) + WO_IN))
#define WOUT ((bf16_t*)(WSLOT(layer) + WO_OUT))
#define VT ((bf16_t*)(F.ws + WS_VT))
#define KF ((bf16_t*)(F.ws + WS_KF))
#define KALL ((bf16_t*)(F.ws + WS_KALL))
#define VALL ((bf16_t*)(F.ws + WS_VALL))
#define SLAB ((float*)(F.ws + WS_SLAB))
#define MODL (MOD + (size_t)layer * 3 * NMOD)
#define SRC_LAT (layer == 0 ? IN(I_X) : (const float*)nullptr)
#define SRC_CTX (layer == 0 ? IN(I_CTX) : (const float*)nullptr)
#define HY_SW (IN(I_HSW) + (size_t)j * 3 * 3 * D)
#define HY_SB (IN(I_HSB) + (size_t)j * 3 * D)

    PH_IF {
#if EN_PRO
        adaln_phase(F, IN(I_C), IN(I_CCTX), IN(I_WMOD), IN(I_BMOD), MOD);
        hdn_phase(F, IN(I_HFW1), IN(I_HFB1), IN(I_HFW2), IN(I_HFB2), IN(I_HFW3), IN(I_HFB3), IN(I_HFREQ), HDN);
#endif
    }
    PH_END;

#pragma unroll 1
    for (int layer = 0; layer < 4; ++layer) {
        const int kind = layer % 3, j = layer / 3;
        const int rows_n1 = layer <= 2 ? M_ALL : M_LAT;
        const int rows_full = layer <= 1 ? M_ALL : M_LAT;
        const int nin = kind == 2 ? 3072 : 3 * D;
        PH_IF {
#if EN_NORM
            CtxPend cp{nullptr, 0, nullptr, nullptr, nullptr};
            if (layer == 1 || layer == 2) cp = CtxPend{SLAB, 11, MOD + (size_t)(layer - 1) * 3 * NMOD + 2 * NMOD + 5 * D, nullptr, nullptr};
            norm_rows(F, SRC_LAT, SRC_CTX, XRES, layer == 0, rows_n1, IN(I_N1G) + layer * D, MODL, 0, D, ABUF, cp);
            if (layer == 0) { const WSet w = wset_of(F, 0); wconv_layer(F, w, WSLOT(0)); }
#endif
#if EN_FILT
            if (kind == 0) {
                hy_filt_long(F, HDN + (size_t)j * (SEQ + CTXL) * 64, IN(I_HFW4) + (size_t)j * 64 * 2 * D, KF, F.blk, F.nblk);
                if (layer == 0) hy_filt_tiles(F, HDN + ((size_t)j * (SEQ + CTXL) + SEQ) * 64, IN(I_HFW4) + (size_t)j * 64 * 2 * D, KFC, CTXL, F.blk, F.nblk);
                __syncthreads();
            }
#endif
        }
        PH_END;
        PH_IF {
#if EN_G1
            pg8::Gemm g{ABUF, WIN, rows_n1, nin, D, D}; pg8::StaticOrder S; S.init(rows_n1, nin, F.nblk, F.blk);
            pg8::EpiStoreBf16 E{ZBUF, nin, kind == 0 ? IN(I_HBIN) + (size_t)j * 3 * D : nullptr};
            pg8::gemm_phase<pg8::EpiStoreBf16, pg8::StaticOrder>(F.lds, g, S, E, nullptr);
            if (layer <= 1) { const Fr Fi = fr_fresh(F0); const int nu = (rows_n1 / 256) * (nin / 256);
                if (layer == 0) wconv_idle(Fi, 1, nu, 0, WC1_A); else wconv_idle(Fi, 2, nu, WC2_A, wconv_total(3072)); }
#endif
        }
        PH_END;
        if (kind == 0) {
            PH_IF {
#if EN_HYE
                hy_elem_phase(F, ZBUF, HY_SW, HY_SB, VT, VTC, rows_full);
#endif
            }
            PH_END;
            PH_IF {
#if EN_FFT
                hy_fft_phase(F, KF, IN(I_HSKIP) + j * D, VT, (float*)(F.ws + WS_KSP), layer == 0);
#endif
#if EN_HYE
                if (rows_full > M_LAT) hy_ctx_conv(F, KFC, IN(I_HSKIP) + j * D, VTC);
#endif
            }
            PH_END;
            PH_IF {
#if EN_HYE
                hy_post_phase(F, ZBUF, HY_SW, HY_SB, VT, VTC, ABUF, rows_full);
#endif
            }
            PH_END;
        } else if (kind == 1) {
            PH_IF {
#if EN_HYE
                sc_elem_phase(F, ZBUF, IN(I_SCW), ABUF, rows_full);
#endif
            }
            PH_END;
        } else {
            PH_IF {
#if EN_HYE
                qk_prep_phase(F, ZBUF, IN(I_AQG), IN(I_AKG), VT  , KALL, VALL);
#endif
            }
            PH_END;
            PH_IF {
#if EN_ATT
                const float gqm = wave_max(fmaxf(fabsf(IN(I_AQG)[F.lane]), fabsf(IN(I_AQG)[F.lane + 64]))), gkm = wave_max(fmaxf(fabsf(IN(I_AKG)[F.lane]), fabsf(IN(I_AKG)[F.lane + 64])));
                const bool nomax = 16.33f * gqm * gkm < ATT_NOMAX_BOUND;
                int it3 = WC3_A + F.gw;
                for (int unit = F.blk; unit < NB * NH * (SEQ / 256); unit += F.nblk) {
                    const int bk = unit >> 8, b = bk >> 2, kvh = bk & 3, g = (unit >> 6) & 3, qb = unit & 63, h = kvh * 4 + g;
                    const size_t qo = ((size_t)(b * SEQ + qb * 256)) * D + h * HD, ko = ((size_t)b * NKV + kvh) * LK * HD;
                    if (nomax) att::attn_dense_body<att::bf16, true>(VT + qo, KALL + ko, VALL + ko, ABUF + qo, LK, (char*)F.ldsg);
                    else att::attn_dense_body<att::bf16, false>(VT + qo, KALL + ko, VALL + ko, ABUF + qo, LK, (char*)F.ldsg);
                    __syncthreads();
                    {   const Fr Fs = fr_fresh(F0);
                        LAS float* scr2 = (LAS float*)(Fs.lds + 67584 + Fs.wave * 8448);
                        { const WSet w3 = wset_of(Fs, 3); wconv_part(Fs, w3, Fs.ws + w_slot_off(3), scr2, it3, 2); }
                    }
                }
                { const Fr Fe = fr_fresh(F0); LAS float* scr3 = (LAS float*)(Fe.lds + 67584 + Fe.wave * 8448);
                  const WSet w3 = wset_of(Fe, 3); wconv_part(Fe, w3, Fe.ws + w_slot_off(3), scr3, it3, 1 << 30); }
#endif
            }
            PH_END;
        }
        PH_IF {
#if EN_G2
            pg8::Gemm g{ABUF, WOUT, M_LAT, D, D, D}; pg8::StaticOrder S; S.init(M_LAT, D, F.nblk, F.blk);
            const float* bias = kind == 0 ? IN(I_HBOUT) + j * D : nullptr;
            pg8::EpiResid E{SRC_LAT, SRC_CTX, XRES, bias, MODL + 2 * D};
#if STAG_RS
            { const int grp = (F.blk >> 3) & (STAG_N - 1); if (grp) { const unsigned long long t1 = __builtin_amdgcn_s_memrealtime(); while (__builtin_amdgcn_s_memrealtime() - t1 < (unsigned long long)(grp * STAG_RS)) __builtin_amdgcn_s_sleep(2); } }
#endif
            pg8::gemm_phase<pg8::EpiResid, pg8::StaticOrder>(F.lds, g, S, E, nullptr);
            if (rows_full > M_LAT) {
                pg8::Gemm gc{ABUF, WOUT, M_ALL, D, 256, D}; pg8::CtxSplitOrder Sc; Sc.init(D, 8, F.nblk, F.blk);
                pg8::EpiSlab Ec{SLAB};
                pg8::gemm_phase<pg8::EpiSlab, pg8::CtxSplitOrder>(F.lds, gc, Sc, Ec, nullptr);
            }
#endif
        }
        PH_END;
        PH_IF {
#if EN_NORM
            CtxPend cp{nullptr, 0, nullptr, nullptr, nullptr};
            if (rows_full > M_LAT) cp = CtxPend{SLAB, 8, MODL + 2 * NMOD + 2 * D, kind == 0 ? IN(I_HBOUT) + j * D : nullptr, layer == 0 ? IN(I_CTX) : nullptr};
            norm_rows(F, nullptr, nullptr, XRES, false, rows_full, IN(I_N2G) + layer * D, MODL, 3 * D, 4 * D, ABUF, cp);
#endif
        }
        PH_END;
        PH_IF {
#if EN_G3
            pg8::Gemm g{ABUF, WGU, rows_full, 2 * DFF, D, D}; pg8::StaticOrder S; S.init(rows_full, 2 * DFF, F.nblk, F.blk);
            pg8::EpiSwiGLU E{ZBUF, DFF};
#if STAG_GU
            { const int grp = (F.blk >> 3) & (STAG_N - 1); if (grp) { const unsigned long long t1 = __builtin_amdgcn_s_memrealtime(); while (__builtin_amdgcn_s_memrealtime() - t1 < (unsigned long long)(grp * STAG_GU)) __builtin_amdgcn_s_sleep(2); } }
#endif
            pg8::gemm_phase<pg8::EpiSwiGLU, pg8::StaticOrder>(F.lds, g, S, E, nullptr);
            if (layer <= 1) { const Fr Fi = fr_fresh(F0); const int nu = (rows_full / 256) * (2 * DFF / 256);
                if (layer == 0) wconv_idle(Fi, 2, nu, 0, WC2_A); else wconv_idle(Fi, 3, nu, 0, WC3_A); }
#endif
        }
        PH_END;
        PH_IF {
#if EN_G4
            pg8::Gemm g{ZBUF, WD, M_LAT, D, DFF, DFF}; pg8::StaticOrder S; S.init(M_LAT, D, F.nblk, F.blk);
            pg8::EpiResid E{nullptr, nullptr, XRES, nullptr, MODL + 5 * D};
#if STAG_RS
            { const int grp = (F.blk >> 3) & (STAG_N - 1); if (grp) { const unsigned long long t1 = __builtin_amdgcn_s_memrealtime(); while (__builtin_amdgcn_s_memrealtime() - t1 < (unsigned long long)(grp * STAG_RS)) __builtin_amdgcn_s_sleep(2); } }
#endif
            pg8::gemm_phase<pg8::EpiResid, pg8::StaticOrder>(F.lds, g, S, E, nullptr);
            if (rows_full > M_LAT) {
                pg8::Gemm gc{ZBUF, WD, M_ALL, D, 512, DFF}; pg8::CtxSplitOrder Sc; Sc.init(D, 11, F.nblk, F.blk);
                pg8::EpiSlab Ec{SLAB};
                pg8::gemm_phase<pg8::EpiSlab, pg8::CtxSplitOrder>(F.lds, gc, Sc, Ec, nullptr);
            }
#endif
        }
        PH_END;
    }
    PH_IF {
#if EN_NORM
        final_norm(F, XRES, IN(I_FING), (float*)IN(34));
#endif
    }
    PH_END;
#if PROBE_AMP
    { const unsigned long long t1 = __builtin_amdgcn_s_memrealtime(); while (__builtin_amdgcn_s_memrealtime() - t1 < (unsigned long long)PROBE_AMP * pr_acc) __builtin_amdgcn_s_sleep(8); }
#endif
#undef PH_IF
#undef PH_END
}

extern "C" void kernel_launch(void* const* d_in, const int* in_sizes, int n_in, void* d_out, int out_size, void* d_ws, size_t ws_size, hipStream_t stream) {
    static int grid = 0;
    if (grid == 0) {
        if (n_in != 34 || in_sizes[0] != M_LAT * D || out_size != M_LAT * D || ws_size < WS_END) {
            fprintf(stderr, "kernel_launch: shape mismatch: n_in %d in0 %d out %d ws %zu (need >= %zu); nothing launched\n", n_in, n_in > 0 ? in_sizes[0] : -1, out_size, ws_size, (size_t)WS_END); grid = -1; return; }
        int dev = 0, cus = 0, per_cu = 0;
        if (hipGetDevice(&dev) != hipSuccess || hipDeviceGetAttribute(&cus, hipDeviceAttributeMultiprocessorCount, dev) != hipSuccess) { fprintf(stderr, "kernel_launch: device query failed\n"); grid = -1; return; }
        if (hipFuncSetAttribute((const void*)dit_fwd, hipFuncAttributeMaxDynamicSharedMemorySize, LDS_BYTES) != hipSuccess) { fprintf(stderr, "kernel_launch: hipFuncSetAttribute failed\n"); grid = -1; return; }
        if (hipOccupancyMaxActiveBlocksPerMultiprocessor(&per_cu, (const void*)dit_fwd, NTHREADS, LDS_BYTES) != hipSuccess || per_cu < 1) {
            fprintf(stderr, "kernel_launch: occupancy query reports %d workgroups per CU; nothing launched\n", per_cu); (void)hipGetLastError(); grid = -1; return; }
        grid = cus;
    }
    if (grid < 0) return;
    if (hipMemsetAsync((char*)d_ws + WS_CTL, 0, CTL_ZERO_BYTES, stream) != hipSuccess) { fprintf(stderr, "kernel_launch: memset failed\n"); return; }
    Args a{};
    for (int i = 0; i < 34; ++i) a.in[i] = (const float*)d_in[i];
    a.out = (float*)d_out; a.ws = (unsigned char*)d_ws;
#if MK_PER_PHASE_LAUNCH
    for (int p = 0; p < N_PHASES; ++p) { a.ph_lo = p; a.ph_hi = p + 1; hipLaunchKernelGGL(dit_fwd, dim3(grid), dim3(NTHREADS), LDS_BYTES, stream, a); }
#else
    a.ph_lo = 0; a.ph_hi = N_PHASES;
    hipLaunchKernelGGL(dit_fwd, dim3(grid), dim3(NTHREADS), LDS_BYTES, stream, a);
#endif
    const hipError_t le = hipPeekAtLastError();
    if (le != hipSuccess) fprintf(stderr, "kernel_launch: launch failed: %s\n", hipGetErrorName(le));
}
```

```cpp
#include <hip/hip_runtime.h>
#include <cstdio>
#include <cstdint>
#include <cstddef>

#ifndef MK_PER_PHASE_LAUNCH
#define MK_PER_PHASE_LAUNCH 0
#endif

#ifndef EPI_TWICE
#define EPI_TWICE 0
#endif
#ifndef SEGPROBE
#define SEGPROBE 0
#define SEG_EPI 2
#define SEG_AMP 4
#endif
#ifndef RESID_NUP
#define RESID_NUP 0
#endif
#ifndef ATT_VPM
#define ATT_VPM 5
#define ATT_VMASK 0x402
#endif
#ifndef ATT_NOMAX_BOUND
#define ATT_NOMAX_BOUND 90.f
#endif
#define LAS __attribute__((address_space(3)))
#define GAS __attribute__((address_space(1)))
typedef unsigned short bf16_t;
typedef short bf16x8 __attribute__((ext_vector_type(8)));
typedef float f32x4 __attribute__((ext_vector_type(4)));
typedef float f32x2 __attribute__((ext_vector_type(2)));
typedef unsigned u32x4 __attribute__((ext_vector_type(4)));
typedef unsigned u32x2 __attribute__((ext_vector_type(2)));

constexpr int D = 2048, NB = 2, SEQ = 16384, CTXL = 256, DFF = 5632, HD = 128, NH = 16, NKV = 4;
constexpr int M_LAT = NB * SEQ, M_CTX = NB * CTXL, M_ALL = M_LAT + M_CTX;
constexpr int NMOD = 6 * D;
constexpr int LK = SEQ + CTXL;
constexpr float NORM_EPS = 1e-6f;
constexpr int NWAVES = 8, NTHREADS = 512;
constexpr int N_PHASES = 1 + 9 + 7 + 8 + 9 + 1;

constexpr size_t MiB = 1u << 20;
constexpr size_t WS_CTL = 0, CTL_ZERO_BYTES = 1 * MiB;
constexpr size_t WS_MOD = 1 * MiB;
constexpr size_t WS_HDN = 2 * MiB;
constexpr size_t WS_KFC = 11 * MiB;
constexpr size_t WS_VTC = 15 * MiB;
constexpr size_t WS_XRES = 17 * MiB;
constexpr size_t WS_A = 277 * MiB;
constexpr size_t WS_Z = 407 * MiB;
constexpr size_t WS_W = 797 * MiB, W_SLOT = 98 * MiB;
constexpr size_t WO_GU = 0, WO_D = 44 * MiB, WO_IN = 66 * MiB, WO_OUT = 90 * MiB;
constexpr size_t WS_VT = 895 * MiB;
constexpr size_t WS_KF = 1023 * MiB;
constexpr size_t WS_KALL = WS_Z + 200 * MiB, WS_VALL = WS_Z + 240 * MiB;
constexpr size_t WS_SLAB = WS_KF + 128 * MiB;
constexpr size_t WS_KSP = 1279 * MiB;
constexpr size_t WS_W1 = 1319 * MiB;
constexpr size_t WS_END = 1515 * MiB;
__host__ __device__ constexpr size_t w_slot_off(int layer) { return layer == 1 ? WS_W1 : (layer == 2 ? WS_W1 + W_SLOT : WS_W); }
constexpr int CW_BAR = 1024;

__device__ __forceinline__ float bf2f(unsigned short b) { return __uint_as_float(((unsigned)b) << 16); }
__device__ __forceinline__ float bflo(unsigned w) { return __uint_as_float(w << 16); }
__device__ __forceinline__ float bfhi(unsigned w) { return __uint_as_float(w & 0xffff0000u); }
__device__ __forceinline__ unsigned cvt_pk_bf16(float lo, float hi) { unsigned r; asm volatile("v_cvt_pk_bf16_f32 %0, %1, %2" : "=v"(r) : "v"(lo), "v"(hi)); return r; }
__device__ __forceinline__ float wave_sum(float v) {
    v += __int_as_float(__builtin_amdgcn_update_dpp(0, __float_as_int(v), 0xB1, 0xf, 0xf, true));
    v += __int_as_float(__builtin_amdgcn_update_dpp(0, __float_as_int(v), 0x4E, 0xf, 0xf, true));
    v += __int_as_float(__builtin_amdgcn_update_dpp(0, __float_as_int(v), 0x124, 0xf, 0xf, true));
    v += __int_as_float(__builtin_amdgcn_update_dpp(0, __float_as_int(v), 0x128, 0xf, 0xf, true));
    const int i = __float_as_int(v);
    return (__int_as_float(__builtin_amdgcn_readlane(i, 0)) + __int_as_float(__builtin_amdgcn_readlane(i, 16))) + (__int_as_float(__builtin_amdgcn_readlane(i, 32)) + __int_as_float(__builtin_amdgcn_readlane(i, 48)));
}
__device__ __forceinline__ float wave_max(float v) {
    v = fmaxf(v, __int_as_float(__builtin_amdgcn_update_dpp(0, __float_as_int(v), 0xB1, 0xf, 0xf, true)));
    v = fmaxf(v, __int_as_float(__builtin_amdgcn_update_dpp(0, __float_as_int(v), 0x4E, 0xf, 0xf, true)));
    v = fmaxf(v, __int_as_float(__builtin_amdgcn_update_dpp(0, __float_as_int(v), 0x124, 0xf, 0xf, true)));
    v = fmaxf(v, __int_as_float(__builtin_amdgcn_update_dpp(0, __float_as_int(v), 0x128, 0xf, 0xf, true)));
    const int i = __float_as_int(v);
    return fmaxf(fmaxf(__int_as_float(__builtin_amdgcn_readlane(i, 0)), __int_as_float(__builtin_amdgcn_readlane(i, 16))), fmaxf(__int_as_float(__builtin_amdgcn_readlane(i, 32)), __int_as_float(__builtin_amdgcn_readlane(i, 48))));
}
__device__ __forceinline__ float lane_bcast(float v, int k) { return __int_as_float(__builtin_amdgcn_readlane(__float_as_int(v), k)); }
#define LDS_WAIT() asm volatile("s_waitcnt lgkmcnt(0)" ::: "memory")
#define VM_WAIT() asm volatile("s_waitcnt vmcnt(0)" ::: "memory")
#define XB_TMO      128
#define XB_XCNT(j)  (256  + 64 * (j))
#define XB_XSUB(j)  (1280 + 64 * (j))
#define XB_XGEN(j)  (2304 + 64 * (j))
#define XB_TOP      3328
#define XB_TOPGEN   3392
#define XCD_BAR_WORDS 3456
#define XB_SPIN_CAP (1u << 18)

__device__ __forceinline__ unsigned xb_ld(unsigned* p)              { return __hip_atomic_load(p, __ATOMIC_RELAXED, __HIP_MEMORY_SCOPE_AGENT); }
__device__ __forceinline__ unsigned xb_add(unsigned* p, unsigned v) { return __hip_atomic_fetch_add(p, v, __ATOMIC_RELAXED, __HIP_MEMORY_SCOPE_AGENT); }
__device__ __forceinline__ unsigned xb_xcc_id() { return (unsigned)__builtin_amdgcn_s_getreg((3 << 11) | 20) & 0xFu; }
#define XB_SPIN(cond, bar) do { unsigned _sp = 0; while (cond) { __builtin_amdgcn_s_sleep(1); \
    if ((++_sp & 255u) == 0u) { if (xb_ld(&(bar)[XB_TMO])) break; if (_sp > XB_SPIN_CAP) { atomicAdd(&(bar)[XB_TMO], 1u); break; } } } } while (0)

struct XcdBarrier {
    unsigned* bar; unsigned x;
    volatile LAS unsigned* st;
};

__device__ __forceinline__ XcdBarrier xcd_barrier_post(unsigned* bar, volatile LAS unsigned* st) {
    XcdBarrier b; b.bar = bar; b.x = xb_xcc_id(); b.st = st;
    if (threadIdx.x == 0) (void)xb_add(&bar[XB_XCNT(b.x)], 1u);
    return b;
}
__device__ __forceinline__ void xcd_barrier_complete(unsigned* bar, unsigned x, unsigned& nloc, unsigned& nx) {
    const unsigned G = gridDim.x * gridDim.y * gridDim.z;
    unsigned sum, cnt, mine, sp = 0u;
    for (;;) {
        sum = 0u; cnt = 0u; mine = 0u;
#pragma unroll
        for (unsigned j = 0; j < 16; ++j) { const unsigned c = xb_ld(&bar[XB_XCNT(j)]); sum += c; cnt += (c > 0u) ? 1u : 0u; mine = (j == x) ? c : mine; }
        if (sum == G) break;
        __builtin_amdgcn_s_sleep(1);
        if ((++sp & 255u) == 0u) { if (xb_ld(&bar[XB_TMO])) break; if (sp > XB_SPIN_CAP) { atomicAdd(&bar[XB_TMO], 1u); break; } }
    }
    nloc = mine > 0u ? mine : 1u; nx = cnt > 0u ? cnt : 1u;
}

__device__ __forceinline__ void xcd_barrier(const XcdBarrier& b) {
    asm volatile("s_waitcnt vmcnt(0)" ::: "memory");
    __syncthreads();
    if (threadIdx.x == 0) {
        unsigned* bar = b.bar;
        __builtin_amdgcn_s_waitcnt(0);
        unsigned nloc = b.st[0], nx = b.st[1];
        if (nloc == 0u) { xcd_barrier_complete(bar, b.x, nloc, nx); b.st[0] = nloc; b.st[1] = nx; }
        const unsigned old = xb_add(&bar[XB_XSUB(b.x)], 1u);
        const unsigned gen = old / nloc;
        if (old + 1u == (gen + 1u) * nloc) {
            __builtin_amdgcn_fence(__ATOMIC_RELEASE, "agent");
            asm volatile("s_waitcnt vmcnt(0)" ::: "memory");
            const unsigned og = xb_add(&bar[XB_TOP], 1u);
            const unsigned tg = og / nx;
            if (og + 1u == (tg + 1u) * nx) xb_add(&bar[XB_TOPGEN], 1u);
            else XB_SPIN(xb_ld(&bar[XB_TOPGEN]) == tg, bar);
            __builtin_amdgcn_fence(__ATOMIC_ACQUIRE, "agent");
            xb_add(&bar[XB_XGEN(b.x)], 1u);
            asm volatile("s_waitcnt vmcnt(0)" ::: "memory");
        } else {
            XB_SPIN(xb_ld(&bar[XB_XGEN(b.x)]) == gen, bar);
            __builtin_amdgcn_fence(__ATOMIC_ACQUIRE, "agent");
            asm volatile("s_waitcnt vmcnt(0)" ::: "memory");
        }
    }
    __syncthreads();
}
namespace pg8 {
#define PG8_LAS __attribute__((address_space(3)))
typedef unsigned short bf16_t;
typedef short bf16x8 __attribute__((ext_vector_type(8)));
typedef float f32x4 __attribute__((ext_vector_type(4)));
typedef unsigned u32x4 __attribute__((ext_vector_type(4)));
constexpr int BM = 256, BK = 64, HALF = 128, HTB = HALF * BK * 2  , STAGE_BYTES = 8 * HTB, NXCD = 8, WGM = 8;

__host__ __device__ __forceinline__ int lds_byte(int r, int c) { const int st = (r >> 4) * 2 + (c >> 5), rr = r & 15, cc = c & 31, ob = rr * 64 + cc * 2; return st * 1024 + (ob ^ (((ob >> 9) & 1) << 5)); }
__host__ __device__ __forceinline__ void stage_rc(int b, int& R, int& C) { const int st = b / 1024, sb = b % 1024, swz = sb ^ (((sb >> 9) & 1) << 5); R = (st >> 1) * 16 + swz / 64; C = (st & 1) * 32 + (swz % 64) / 2; }
__host__ __device__ __forceinline__ int perm32(int rho) { const int n = rho >> 4, i = rho & 15; return 8 * (i >> 2) + 4 * n + (i & 3); }

struct Unit { int pm, pn, kc; };
struct Gemm { const bf16_t* A; const bf16_t* Bt; int M, N, K, ldk; };

struct StaticOrder {
    int nM, nN, nwg, G, c; float inv_nig;
    __host__ __device__ void init(int M, int N, int G_, int c_) { nM = M / BM; nN = N / BM; nwg = nM * nN; G = G_; c = c_; inv_nig = 1.0f / (float)(WGM * nN); }
    __host__ __device__ bool next(int i, Unit& u) const {
        const int L = i * G + c; if (L >= nwg) return false;
        int wgid = L; { const int q = nwg >> 3, r = nwg & 7, xcd = wgid & 7, off = wgid >> 3; wgid = (xcd < r ? xcd * (q + 1) : r * (q + 1) + (xcd - r) * q) + off; }
        const int nig = WGM * nN, gid = (int)(((float)wgid + 0.5f) * inv_nig), rem = wgid - gid * nig, fm = gid * WGM, gsz = (nM - fm) < WGM ? (nM - fm) : WGM;
        if (gsz == WGM) { u.pm = fm + (rem & 7); u.pn = rem >> 3; }
        else { const int pn = (int)(((float)rem + 0.5f) / (float)gsz); u.pm = fm + rem - pn * gsz; u.pn = pn; }
        u.kc = 0; return true;
    }
    __device__ __forceinline__ void a_ready(const Unit&) const {}
    __device__ __forceinline__ void done(const Unit&) const {}
};
struct CtxSplitOrder {
    int nN, ks, G, c;
    __host__ __device__ void init(int N, int ks_, int G_, int c_) { nN = N / BM; ks = ks_; G = G_; c = c_; }
    __host__ __device__ bool next(int i, Unit& u) const { const int l = i * G + c; if (l >= 2 * nN * ks) return false;
        const int kc = (int)(((float)l + 0.5f) / (float)(2 * nN)), rem = l - kc * 2 * nN, hi = rem >= nN ? 1 : 0; u.kc = kc; u.pm = 128 + hi; u.pn = rem - hi * nN; return true; }
    __device__ __forceinline__ void a_ready(const Unit&) const {}
    __device__ __forceinline__ void done(const Unit&) const {}
};
struct EpiStoreBf16 {
    static constexpr bool PERM = true, AFTER_DRAIN = false; static constexpr int TW = 1;
    bf16_t* O; int ldc; const float* bias;
    __device__ __forceinline__ void operator()(const f32x4 (&acc)[2][2][4][2], const Unit& u, int wr, int wc, int fr, int fq) const {
        const int row0 = u.pm * BM + wr * 64 + fr, col0 = u.pn * BM + wc * 32 + 8 * fq;
        if (!bias) {
#pragma unroll
            for (int ai = 0; ai < 2; ++ai)
#pragma unroll
                for (int m = 0; m < 4; ++m) { bf16_t* rowp = O + (size_t)(row0 + ai * HALF + m * 16) * ldc + col0;
#pragma unroll
                    for (int bj = 0; bj < 2; ++bj) { const f32x4 v0 = acc[ai][bj][m][0], v1 = acc[ai][bj][m][1];
                        u32x4 w; w.x = cvt_pk_bf16(v0[0], v0[1]); w.y = cvt_pk_bf16(v0[2], v0[3]); w.z = cvt_pk_bf16(v1[0], v1[1]); w.w = cvt_pk_bf16(v1[2], v1[3]);
                        *(u32x4*)(rowp + bj * HALF) = w; } }
            return;
        }
        f32x4 bv[2][2];
#pragma unroll
        for (int bj = 0; bj < 2; ++bj)
#pragma unroll
            for (int n = 0; n < 2; ++n) bv[bj][n] = *(const f32x4*)(bias + col0 + bj * HALF + 4 * n);
#pragma unroll
        for (int ai = 0; ai < 2; ++ai)
#pragma unroll
            for (int m = 0; m < 4; ++m) { bf16_t* rowp = O + (size_t)(row0 + ai * HALF + m * 16) * ldc + col0;
#pragma unroll
                for (int bj = 0; bj < 2; ++bj) { const f32x4 v0 = acc[ai][bj][m][0] + bv[bj][0], v1 = acc[ai][bj][m][1] + bv[bj][1];
                    u32x4 w; w.x = cvt_pk_bf16(v0[0], v0[1]); w.y = cvt_pk_bf16(v0[2], v0[3]); w.z = cvt_pk_bf16(v1[0], v1[1]); w.w = cvt_pk_bf16(v1[2], v1[3]);
                    *(u32x4*)(rowp + bj * HALF) = w; } }
    }
};
__device__ __forceinline__ float silu_mul(float g, float u) { return g * u * __builtin_amdgcn_rcpf(1.0f + __builtin_amdgcn_exp2f(g)); }
struct EpiSwiGLU {
    static constexpr bool PERM = true, AFTER_DRAIN = false; static constexpr int TW = 2;
    bf16_t* O; int ldc;
    __device__ __forceinline__ void operator()(const f32x4 (&acc)[2][2][4][2], const Unit& u, int wr, int wc, int fr, int fq) const {
        const int row0 = u.pm * BM + wr * 64 + fr, col0 = u.pn * HALF + wc * 32 + 8 * fq;
#pragma unroll
        for (int ai = 0; ai < 2; ++ai)
#pragma unroll
            for (int m = 0; m < 4; ++m) {
                const f32x4 g0 = acc[ai][0][m][0], g1 = acc[ai][0][m][1], u0 = acc[ai][1][m][0], u1 = acc[ai][1][m][1];
                u32x4 w;
                w.x = cvt_pk_bf16(silu_mul(g0[0], u0[0]), silu_mul(g0[1], u0[1])); w.y = cvt_pk_bf16(silu_mul(g0[2], u0[2]), silu_mul(g0[3], u0[3]));
                w.z = cvt_pk_bf16(silu_mul(g1[0], u1[0]), silu_mul(g1[1], u1[1])); w.w = cvt_pk_bf16(silu_mul(g1[2], u1[2]), silu_mul(g1[3], u1[3]));
                *(u32x4*)(O + (size_t)(row0 + ai * HALF + m * 16) * ldc + col0) = w; }
    }
};
struct EpiResid {
    static constexpr bool PERM = true, AFTER_DRAIN = false; static constexpr int TW = 3;
    const float* base32_lat; const float* base32_ctx; bf16_t* xres; const float* bias; const float* gate;
    __device__ __forceinline__ void operator()(const f32x4 (&acc)[2][2][4][2], const Unit& u, int wr, int wc, int fr, int fq) const {
        int rin0 = wr * 64 + fr; asm volatile("" : "+v"(rin0));
        const int col0 = u.pn * BM + wc * 32 + 8 * fq;
        const int cond = u.pm < 64 ? 0 : (u.pm < 128 ? 1 : 2);
        bf16_t* op = xres + (size_t)u.pm * BM * 2048 + col0;
        const float* gp = gate + cond * 12288 + col0;
        if (RESID_NUP && !base32_lat && !bias) {
            constexpr int NUP = RESID_NUP ? RESID_NUP : 1;
            u32x4 b[NUP][2];
#pragma unroll
            for (int am = 0; am < NUP; ++am)
#pragma unroll
                for (int bj = 0; bj < 2; ++bj) b[am][bj] = *(const u32x4*)(op + (size_t)(rin0 + (am >> 2) * HALF + (am & 3) * 16) * 2048 + bj * HALF);
            f32x4 gv[2][2];
#pragma unroll
            for (int bj = 0; bj < 2; ++bj)
#pragma unroll
                for (int n = 0; n < 2; ++n) gv[bj][n] = *(const f32x4*)(gp + bj * HALF + 4 * n);
            asm volatile("" ::: "memory");
#pragma unroll
            for (int am = 0; am < 8; ++am) { const int ai = am >> 2, m = am & 3, sl = am < NUP ? am : am - NUP;
#pragma unroll
                for (int bj = 0; bj < 2; ++bj) { const u32x4 bb = b[sl][bj];
                    const f32x4 b0 = {bflo(bb.x), bfhi(bb.x), bflo(bb.y), bfhi(bb.y)}, b1 = {bflo(bb.z), bfhi(bb.z), bflo(bb.w), bfhi(bb.w)};
                    const f32x4 v0 = b0 + gv[bj][0] * acc[ai][bj][m][0], v1 = b1 + gv[bj][1] * acc[ai][bj][m][1];
                    u32x4 w; w.x = cvt_pk_bf16(v0[0], v0[1]); w.y = cvt_pk_bf16(v0[2], v0[3]); w.z = cvt_pk_bf16(v1[0], v1[1]); w.w = cvt_pk_bf16(v1[2], v1[3]);
                    *(u32x4*)(op + (size_t)(rin0 + ai * HALF + m * 16) * 2048 + bj * HALF) = w; }
                if (am + NUP < 8) { const int an = am + NUP; asm volatile("" ::: "memory");
#pragma unroll
                    for (int bj = 0; bj < 2; ++bj) b[am][bj] = *(const u32x4*)(op + (size_t)(rin0 + (an >> 2) * HALF + (an & 3) * 16) * 2048 + bj * HALF); }
            }
            return;
        }
        f32x4 gv[2][2], bv[2][2];
#pragma unroll
        for (int bj = 0; bj < 2; ++bj)
#pragma unroll
            for (int n = 0; n < 2; ++n) { gv[bj][n] = *(const f32x4*)(gp + bj * HALF + 4 * n); bv[bj][n] = bias ? *(const f32x4*)(bias + col0 + bj * HALF + 4 * n) : (f32x4){0.f, 0.f, 0.f, 0.f}; }
        if (base32_lat) {
            const float* bp = (u.pm < 128 ? base32_lat + (size_t)u.pm * BM * 2048 : base32_ctx + (size_t)(u.pm - 128) * BM * 2048) + col0;
#pragma unroll
            for (int am = 0; am < 8; ++am) { const int ai = am >> 2, m = am & 3; const size_t ro = (size_t)(rin0 + ai * HALF + m * 16) * 2048;
                f32x4 b[2][2];
#pragma unroll
                for (int bj = 0; bj < 2; ++bj)
#pragma unroll
                    for (int n = 0; n < 2; ++n) b[bj][n] = *(const f32x4*)(bp + ro + bj * HALF + 4 * n);
#pragma unroll
                for (int bj = 0; bj < 2; ++bj) { const f32x4 v0 = b[bj][0] + gv[bj][0] * (acc[ai][bj][m][0] + bv[bj][0]), v1 = b[bj][1] + gv[bj][1] * (acc[ai][bj][m][1] + bv[bj][1]);
                    u32x4 w; w.x = cvt_pk_bf16(v0[0], v0[1]); w.y = cvt_pk_bf16(v0[2], v0[3]); w.z = cvt_pk_bf16(v1[0], v1[1]); w.w = cvt_pk_bf16(v1[2], v1[3]);
                    *(u32x4*)(op + ro + bj * HALF) = w; }
                asm volatile("" ::: "memory"); }
        } else {
            u32x4 b[2][2], bn[2][2];
#pragma unroll
            for (int mm = 0; mm < 2; ++mm)
#pragma unroll
                for (int bj = 0; bj < 2; ++bj) b[mm][bj] = *(const u32x4*)(op + (size_t)(rin0 + mm * 16) * 2048 + bj * HALF);
#pragma unroll
            for (int am = 0; am < 4; ++am) { const int ai = am >> 1, m0 = (am & 1) * 2;
                if (am < 3) { const int ain = (am + 1) >> 1, m0n = ((am + 1) & 1) * 2;
#pragma unroll
                    for (int mm = 0; mm < 2; ++mm)
#pragma unroll
                        for (int bj = 0; bj < 2; ++bj) bn[mm][bj] = *(const u32x4*)(op + (size_t)(rin0 + ain * HALF + (m0n + mm) * 16) * 2048 + bj * HALF); }
#pragma unroll
                for (int mm = 0; mm < 2; ++mm)
#pragma unroll
                    for (int bj = 0; bj < 2; ++bj) { const u32x4 bb = b[mm][bj]; const int m = m0 + mm;
                        const f32x4 b0 = {bflo(bb.x), bfhi(bb.x), bflo(bb.y), bfhi(bb.y)}, b1 = {bflo(bb.z), bfhi(bb.z), bflo(bb.w), bfhi(bb.w)};
                        const f32x4 v0 = b0 + gv[bj][0] * (acc[ai][bj][m][0] + bv[bj][0]), v1 = b1 + gv[bj][1] * (acc[ai][bj][m][1] + bv[bj][1]);
                        u32x4 w; w.x = cvt_pk_bf16(v0[0], v0[1]); w.y = cvt_pk_bf16(v0[2], v0[3]); w.z = cvt_pk_bf16(v1[0], v1[1]); w.w = cvt_pk_bf16(v1[2], v1[3]);
                        *(u32x4*)(op + (size_t)(rin0 + ai * HALF + m * 16) * 2048 + bj * HALF) = w; }
                asm volatile("" ::: "memory");
#pragma unroll
                for (int mm = 0; mm < 2; ++mm)
#pragma unroll
                    for (int bj = 0; bj < 2; ++bj) b[mm][bj] = bn[mm][bj];
            }
        }
    }
};
struct EpiSlab {
    static constexpr bool PERM = false, AFTER_DRAIN = false; static constexpr int TW = 4;
    float* slab;
    __device__ __forceinline__ void operator()(const f32x4 (&acc)[2][2][4][2], const Unit& u, int wr, int wc, int fr, int fq) const {
        float* op = slab + ((size_t)u.kc * 512 + (u.pm - 128) * BM + wr * 64 + fr) * 2048 + u.pn * BM + wc * 32 + 4 * fq;
#pragma unroll
        for (int ai = 0; ai < 2; ++ai)
#pragma unroll
            for (int m = 0; m < 4; ++m)
#pragma unroll
                for (int bj = 0; bj < 2; ++bj)
#pragma unroll
                    for (int n = 0; n < 2; ++n) *(f32x4*)(op + (size_t)(ai * HALF + m * 16) * 2048 + bj * HALF + n * 16) = acc[ai][bj][m][n];
    }
};
template <class Epi, class Sched, bool STAMP = false>
__device__ __forceinline__ void gemm_phase(PG8_LAS unsigned char* lds, const Gemm g, const Sched& S, const Epi& E, unsigned long long* stamps) {
    int tid_ = threadIdx.x; asm volatile("" : "+v"(tid_));
    const int tid = tid_, wid = __builtin_amdgcn_readfirstlane(tid >> 6), lane = tid & 63, wr = wid >> 2, wc = wid & 3, fr = lane & 15, fq = lane >> 4;
    const int K = g.ldk  , nt = g.K / BK; const size_t kchunk = (size_t)g.K * 2;
    int ts_lo = 0, ts_hi = 0, nts = 0; const unsigned long long rt_entry = STAMP ? (unsigned long long)wall_clock64() : 0ull;
#define PG8_STAMP() do { if (STAMP && wid == 0 && nts < 64) { const unsigned long long _c = (unsigned long long)clock64(); \
        ts_lo = (lane == nts) ? (int)(unsigned)_c : ts_lo; ts_hi = (lane == nts) ? (int)(unsigned)(_c >> 32) : ts_hi; ++nts; } } while (0)
    PG8_STAMP();
    unsigned voffA[2], voffB[2];
#pragma unroll
    for (int i = 0; i < 2; ++i) { int R, C; stage_rc(tid * 16 + i * 8192, R, C); const int Rb = Epi::PERM ? ((R & ~31) + perm32(R & 31)) : R;
        voffA[i] = (unsigned)(R * K + C) * 2u; voffB[i] = (unsigned)(Rb * K + C) * 2u; }
    const size_t kstep = (size_t)(BK * 2);
    const size_t hstep = (size_t)HALF * K * 2;
    const size_t tstep = 2 * hstep;
    const unsigned ldsw = (unsigned)wid * 1024u;
    const int aoff = lds_byte(wr * 64 + fr, fq * 8), boff = lds_byte(wc * 32 + fr, fq * 8);
#define PG8_SA(b, h) (((b) * 2 + (h)) * HTB)
#define PG8_SB(b, h) ((4 + (b) * 2 + (h)) * HTB)
#define PG8_STAGE(bufoff, gbase, voff) do { _Pragma("unroll") for (int _i = 0; _i < 2; ++_i) \
        __builtin_amdgcn_global_load_lds((const unsigned*)((const char*)(gbase) + (voff)[_i]), (PG8_LAS unsigned*)(lds + (bufoff) + ldsw + _i * 8192), 16, 0, 0); } while (0)
#define PG8_LDA(dst, b, h) do { _Pragma("unroll") for (int m = 0; m < 4; ++m) _Pragma("unroll") for (int k = 0; k < 2; ++k) dst[m][k] = *(const PG8_LAS bf16x8*)(lds + PG8_SA(b, h) + aoff + m * 2048 + k * 1024); } while (0)
#define PG8_LDB(dst, b, h) do { _Pragma("unroll") for (int n = 0; n < 2; ++n) _Pragma("unroll") for (int k = 0; k < 2; ++k) dst[n][k] = *(const PG8_LAS bf16x8*)(lds + PG8_SB(b, h) + boff + n * 2048 + k * 1024); } while (0)
#define PG8_MMA(ai, bj, At, Bt) do { __builtin_amdgcn_s_setprio(1); _Pragma("unroll") for (int m = 0; m < 4; ++m) _Pragma("unroll") for (int n = 0; n < 2; ++n) _Pragma("unroll") for (int k = 0; k < 2; ++k) \
        acc[ai][bj][m][n] = __builtin_amdgcn_mfma_f32_16x16x32_bf16(Bt[n][k], At[m][k], acc[ai][bj][m][n], 0, 0, 0); __builtin_amdgcn_s_setprio(0); } while (0)
#define PG8_WAIT_V(n) asm volatile("s_waitcnt vmcnt(" #n ")" ::: "memory")
#define PG8_WAIT_L(n) asm volatile("s_waitcnt lgkmcnt(" #n ")" ::: "memory")
#define PG8_BAR __builtin_amdgcn_s_barrier()
#define PG8_SCHED __builtin_amdgcn_sched_barrier(0)
    Unit cur, nxt; int ui = 0;
    if (!S.next(0, cur)) return;
#if SEGPROBE
    unsigned sp_acc = 0, sp_t0 = 0; constexpr bool SPON = (Epi::TW == SEG_EPI);
#define SP_BEGIN(seg) do { if (SPON && SEGPROBE == (seg)) sp_t0 = __builtin_amdgcn_readfirstlane((unsigned)__builtin_amdgcn_s_memrealtime()); } while (0)
#define SP_END(seg) do { if (SPON && SEGPROBE == (seg)) sp_acc = __builtin_amdgcn_readfirstlane(sp_acc + ((unsigned)__builtin_amdgcn_s_memrealtime() - sp_t0)); } while (0)
#else
#define SP_BEGIN(seg) do {} while (0)
#define SP_END(seg) do {} while (0)
#endif
    SP_BEGIN(7); SP_BEGIN(9);
    f32x4 acc[2][2][4][2];
#pragma unroll
    for (int a = 0; a < 2; ++a)
#pragma unroll
        for (int b = 0; b < 2; ++b)
#pragma unroll
            for (int m = 0; m < 4; ++m)
#pragma unroll
                for (int n = 0; n < 2; ++n) acc[a][b][m][n] = (f32x4){0.f, 0.f, 0.f, 0.f};
    bf16x8 At[4][2], B0[2][2], B1[2][2];
    const char* cA = (const char*)g.A + (size_t)cur.pm * tstep + cur.kc * kchunk; const char* cB = (const char*)g.Bt + (size_t)cur.pn * tstep + cur.kc * kchunk;
    S.a_ready(cur);
    PG8_STAGE(PG8_SB(0, 0), cB, voffB); PG8_STAGE(PG8_SA(0, 0), cA, voffA); PG8_STAGE(PG8_SB(0, 1), cB + hstep, voffB); PG8_STAGE(PG8_SA(0, 1), cA + hstep, voffA);
    if (wr == 1) PG8_BAR;
    PG8_WAIT_V(4); PG8_BAR;
    PG8_STAGE(PG8_SB(1, 0), cB + kstep, voffB); PG8_STAGE(PG8_SA(1, 0), cA + kstep, voffA); PG8_STAGE(PG8_SB(1, 1), cB + hstep + kstep, voffB);
    PG8_WAIT_V(6); PG8_BAR;
    PG8_STAMP(); SP_END(7);
    for (;;) {
        const bool has_next = S.next(ui + 1, nxt);
        const char* nA = has_next ? (const char*)g.A + (size_t)nxt.pm * tstep + nxt.kc * kchunk : cA; const char* nB = has_next ? (const char*)g.Bt + (size_t)nxt.pn * tstep + nxt.kc * kchunk : cB;
        if (ui > 0) SP_END(6);
        SP_BEGIN(5);
        for (int t = 0; t < nt; t += 2) {
            const bool last = (t == nt - 2);
            const char* a1 = cA + (size_t)(t + 1) * kstep;
            const char* a2 = last ? nA : cA + (size_t)(t + 2) * kstep; const char* b2 = last ? nB : cB + (size_t)(t + 2) * kstep;
            const char* a3 = a2 + kstep; const char* b3 = b2 + kstep;
            if (last && has_next) S.a_ready(nxt);
            if (last) SP_BEGIN(4);
            PG8_LDB(B0, 0, 0); PG8_SCHED; PG8_LDA(At, 0, 0); PG8_STAGE(PG8_SA(1, 1), a1 + hstep, voffA);
            PG8_WAIT_L(8); PG8_BAR; PG8_WAIT_L(0); PG8_MMA(0, 0, At, B0); PG8_BAR; PG8_SCHED;
            PG8_LDB(B1, 0, 1); PG8_STAGE(PG8_SB(0, 0), b2, voffB);
            PG8_BAR; PG8_WAIT_L(0); PG8_MMA(0, 1, At, B1); PG8_BAR;
            PG8_LDA(At, 0, 1); PG8_STAGE(PG8_SA(0, 0), a2, voffA);
            PG8_BAR; PG8_WAIT_L(0); PG8_MMA(1, 0, At, B0); PG8_BAR; PG8_SCHED;
            PG8_STAGE(PG8_SB(0, 1), b2 + hstep, voffB);
            PG8_WAIT_V(6); PG8_BAR; PG8_MMA(1, 1, At, B1); PG8_BAR;
            PG8_LDB(B0, 1, 0); PG8_SCHED; PG8_LDA(At, 1, 0); PG8_STAGE(PG8_SA(0, 1), a2 + hstep, voffA);
            PG8_WAIT_L(8); PG8_BAR; PG8_WAIT_L(0); PG8_MMA(0, 0, At, B0); PG8_BAR; PG8_SCHED;
            PG8_LDB(B1, 1, 1); PG8_STAGE(PG8_SB(1, 0), b3, voffB);
            PG8_BAR; PG8_WAIT_L(0); PG8_MMA(0, 1, At, B1); PG8_BAR;
            PG8_LDA(At, 1, 1); PG8_STAGE(PG8_SA(1, 0), a3, voffA);
            PG8_BAR; PG8_WAIT_L(0); PG8_MMA(1, 0, At, B0); PG8_BAR; PG8_SCHED;
            PG8_STAGE(PG8_SB(1, 1), b3 + hstep, voffB);
            PG8_WAIT_V(6); PG8_BAR; PG8_MMA(1, 1, At, B1); PG8_BAR;
            if (last) SP_END(4);
        }
        PG8_STAMP(); SP_END(5); SP_BEGIN(1);
        if constexpr (!Epi::AFTER_DRAIN) { E(acc, cur, wr, wc, fr, fq); S.done(cur); }
#if EPI_TWICE
        if constexpr ((EPI_TWICE >> Epi::TW) & 1) { asm volatile("" ::: "memory"); E(acc, cur, wr, wc, fr, fq); }
#endif
        PG8_STAMP(); SP_END(1); SP_BEGIN(6);
        if (!has_next) { SP_BEGIN(8); break; }
#pragma unroll
        for (int a = 0; a < 2; ++a)
#pragma unroll
            for (int b = 0; b < 2; ++b)
#pragma unroll
                for (int m = 0; m < 4; ++m)
#pragma unroll
                    for (int n = 0; n < 2; ++n) acc[a][b][m][n] = (f32x4){0.f, 0.f, 0.f, 0.f};
        cur = nxt; cA = nA; cB = nB; ++ui;
    }
    PG8_WAIT_V(0);
    if (wr == 0) PG8_BAR;
    PG8_BAR;
#if SEGPROBE
    SP_END(8); SP_END(9);
    if (SPON) { const unsigned long long t1 = __builtin_amdgcn_s_memrealtime(); while (__builtin_amdgcn_s_memrealtime() - t1 < (unsigned long long)SEG_AMP * sp_acc) __builtin_amdgcn_s_sleep(8); }
#endif
#undef SP_BEGIN
#undef SP_END
    if constexpr (Epi::AFTER_DRAIN) { E.fused(acc, cur, wr, wc, fr, fq, lds, wid, lane); S.done(cur); }
    PG8_STAMP();
    if (STAMP && wid == 0) { stamps[lane] = lane < nts ? (((unsigned long long)(unsigned)ts_hi << 32) | (unsigned)ts_lo) : 0ull;
        if (lane == 62) stamps[62] = rt_entry; if (lane == 63) stamps[63] = (unsigned long long)wall_clock64(); }
#undef PG8_STAMP
#undef PG8_SA
#undef PG8_SB
#undef PG8_STAGE
#undef PG8_LDA
#undef PG8_LDB
#undef PG8_MMA
#undef PG8_WAIT_V
#undef PG8_WAIT_L
#undef PG8_BAR
#undef PG8_SCHED
}
}
namespace att {
using bf16 = unsigned short;
constexpr int D = 128, NW = 8, QBLK = 32, KVBLK = 64;
constexpr float SCALE = 0.088388347648318440f;
constexpr float THR = 8.f;
constexpr int SDEPTH = 2;
constexpr int LDQ = 2048, LDK = 128, LDO = 2048;
constexpr int NBUF = 3;
constexpr size_t SHM_V = KVBLK * D * 2, SHM_K = KVBLK * D * 2, SHM_ATTN = NBUF * SHM_V + NBUF * SHM_K + NW * 64 * 4;
using bf16x8 = __attribute__((ext_vector_type(8))) short;
using s16x4  = __attribute__((ext_vector_type(4))) short;
using f32x16 = __attribute__((ext_vector_type(16))) float;
using f32x8  = __attribute__((ext_vector_type(8))) float;
using u32x4  = __attribute__((ext_vector_type(4))) unsigned;
#define KSWZ(row, colB) ((row) * 256 + ((colB) ^ (((row) & 7) << 4)))
#define SBAR() __builtin_amdgcn_sched_barrier(0)
__device__ __forceinline__ int crow(int r, int hi) { return (r & 3) + 8 * (r >> 2) + 4 * hi; }
typedef __bf16 bf16x2_t __attribute__((ext_vector_type(2)));
typedef float f32x2_t __attribute__((ext_vector_type(2)));
__device__ __forceinline__ unsigned cvtpk(float lo, float hi) {
  return __builtin_bit_cast(unsigned, __builtin_convertvector((f32x2_t){lo, hi}, bf16x2_t));
}
template <typename TIn> struct Stage;
template <> struct Stage<bf16>  { using T = bf16x8;
  __device__ static __forceinline__ T ld8(const bf16* p) { return *reinterpret_cast<const bf16x8*>(p); }
  __device__ static __forceinline__ bf16x8 tobf(T x) { return x; } };
template <> struct Stage<float> { using T = f32x8;
  __device__ static __forceinline__ T ld8(const float* p) { return *reinterpret_cast<const f32x8*>(p); }
  __device__ static __forceinline__ bf16x8 tobf(T x) {
    u32x4 w = {cvtpk(x[0], x[1]), cvtpk(x[2], x[3]), cvtpk(x[4], x[5]), cvtpk(x[6], x[7])}; return *reinterpret_cast<bf16x8*>(&w); } };

template <bool NOMAX>
__device__ __forceinline__ void partialSM(f32x16& p0, f32x16& p1, float& m_reg, float& mn, float& alpha) {
  if constexpr (!NOMAX) {
    float pmax = p0[0]; for (int r = 1; r < 16; ++r) pmax = fmaxf(pmax, p0[r]); for (int r = 0; r < 16; ++r) pmax = fmaxf(pmax, p1[r]);
    { auto rr = __builtin_amdgcn_permlane32_swap(__float_as_uint(pmax), __float_as_uint(pmax), false, false);
      pmax = fmaxf(__uint_as_float(rr[0]), __uint_as_float(rr[1])); }
    if (__builtin_expect(__all(pmax - m_reg <= THR * 1.4426950408889634f), 1)) { mn = m_reg; alpha = 1.f; }
    else { mn = fmaxf(m_reg, pmax); alpha = __builtin_amdgcn_exp2f(m_reg - mn); m_reg = mn; }
    for (int r = 0; r < 16; ++r) p0[r] -= mn; for (int r = 0; r < 16; ++r) p1[r] -= mn;
  }
  for (int r = 0; r < 16; ++r) p0[r] = __builtin_amdgcn_exp2f(p0[r]);
}
template <bool NOMAX>
__device__ __forceinline__ void finishSM(f32x16& p0, f32x16& p1, float alpha, float& l_reg, bf16x8& pa0, bf16x8& pa1, bf16x8& pa2, bf16x8& pa3) {
  for (int r = 0; r < 16; ++r) p1[r] = __builtin_amdgcn_exp2f(p1[r]);
  float ps = 0; for (int r = 0; r < 16; ++r) ps += p0[r]; for (int r = 0; r < 16; ++r) ps += p1[r];
  { auto rr = __builtin_amdgcn_permlane32_swap(__float_as_uint(ps), __float_as_uint(ps), false, false);
    ps = __uint_as_float(rr[0]) + __uint_as_float(rr[1]); }
  if constexpr (NOMAX) l_reg += ps; else l_reg = l_reg * alpha + ps;
#define PK4(P, BASE, OUT) do { unsigned a0 = cvtpk(P[BASE + 0], P[BASE + 1]), a1 = cvtpk(P[BASE + 2], P[BASE + 3]);   \
    unsigned b0 = cvtpk(P[BASE + 4], P[BASE + 5]), b1 = cvtpk(P[BASE + 6], P[BASE + 7]);                              \
    auto r0 = __builtin_amdgcn_permlane32_swap(a0, b0, false, false); auto r1 = __builtin_amdgcn_permlane32_swap(a1, b1, false, false); \
    u32x4 w = {r0[0], r1[0], r0[1], r1[1]}; OUT = *reinterpret_cast<bf16x8*>(&w); } while (0)
  PK4(p0, 0, pa0); PK4(p0, 8, pa1); PK4(p1, 0, pa2); PK4(p1, 8, pa3);
#undef PK4
}
__device__ __forceinline__ void qkt(f32x16& p0, f32x16& p1, const bf16* Ks, const bf16x8* qr, int r32, int hi) {
  p0 = f32x16{}; p1 = f32x16{};
  for (int d0 = 0; d0 < 8; ++d0) { int cb = (d0 * 16 + hi * 8) * 2;
    bf16x8 b0 = *reinterpret_cast<const bf16x8*>((const char*)Ks + KSWZ(r32, cb));
    bf16x8 b1 = *reinterpret_cast<const bf16x8*>((const char*)Ks + KSWZ(32 + r32, cb));
    p0 = __builtin_amdgcn_mfma_f32_32x32x16_bf16(b0, qr[d0], p0, 0, 0, 0);
    p1 = __builtin_amdgcn_mfma_f32_32x32x16_bf16(b1, qr[d0], p1, 0, 0, 0); }
}
#define PK4S(P, BASE, OUT) do { unsigned a0 = cvtpk(P[BASE + 0], P[BASE + 1]), a1 = cvtpk(P[BASE + 2], P[BASE + 3]);   \
    unsigned b0 = cvtpk(P[BASE + 4], P[BASE + 5]), b1 = cvtpk(P[BASE + 6], P[BASE + 7]);                              \
    auto r0 = __builtin_amdgcn_permlane32_swap(a0, b0, false, false); auto r1 = __builtin_amdgcn_permlane32_swap(a1, b1, false, false); \
    u32x4 w = {r0[0], r1[0], r0[1], r1[1]}; OUT = *reinterpret_cast<bf16x8*>(&w); } while (0)
constexpr int QKPF = 1;
template <int I> __device__ __forceinline__ void sm_slice(f32x16& p0, f32x16& p1, float& psA, float& psB, bf16x8& pa0, bf16x8& pa1, bf16x8& pa2, bf16x8& pa3) {
  if constexpr (I < 8) { p1[2 * I] = __builtin_amdgcn_exp2f(p1[2 * I]); p1[2 * I + 1] = __builtin_amdgcn_exp2f(p1[2 * I + 1]); }
  else if constexpr (I < 10) { constexpr int b = (I - 8) * 8; psA += p0[b] + p0[b + 1]; psB += p0[b + 2] + p0[b + 3]; psA += p0[b + 4] + p0[b + 5]; psB += p0[b + 6] + p0[b + 7]; }
  else if constexpr (I < 12) { constexpr int b = (I - 10) * 8; psA += p1[b] + p1[b + 1]; psB += p1[b + 2] + p1[b + 3]; psA += p1[b + 4] + p1[b + 5]; psB += p1[b + 6] + p1[b + 7]; }
  else if constexpr (I == 12) PK4S(p0, 0, pa0);
  else if constexpr (I == 13) PK4S(p0, 8, pa1);
  else if constexpr (I == 14) PK4S(p1, 0, pa2);
  else PK4S(p1, 8, pa3);
}
template <int D0> __device__ __forceinline__ void qk_sm_step(f32x16& n0, f32x16& n1, const char* Kb, const bf16x8* qr, int r32, int hi, bf16x8 (&k0)[8], bf16x8 (&k1)[8],
                                                             f32x16& p0, f32x16& p1, float& psA, float& psB, bf16x8& pa0, bf16x8& pa1, bf16x8& pa2, bf16x8& pa3) {
  if constexpr (D0 + QKPF < 8) { const int cb = ((D0 + QKPF) * 16 + hi * 8) * 2;
    k0[D0 + QKPF] = *reinterpret_cast<const bf16x8*>(Kb + KSWZ(r32, cb)); k1[D0 + QKPF] = *reinterpret_cast<const bf16x8*>(Kb + KSWZ(32 + r32, cb)); }
  SBAR(); n0 = __builtin_amdgcn_mfma_f32_32x32x16_bf16(k0[D0], qr[D0], n0, 0, 0, 0); sm_slice<2 * D0>(p0, p1, psA, psB, pa0, pa1, pa2, pa3);
  SBAR(); n1 = __builtin_amdgcn_mfma_f32_32x32x16_bf16(k1[D0], qr[D0], n1, 0, 0, 0); sm_slice<2 * D0 + 1>(p0, p1, psA, psB, pa0, pa1, pa2, pa3);
  if constexpr (D0 + 1 < 8) qk_sm_step<D0 + 1>(n0, n1, Kb, qr, r32, hi, k0, k1, p0, p1, psA, psB, pa0, pa1, pa2, pa3);
}
__device__ __forceinline__ void qk_sm(f32x16& n0, f32x16& n1, const bf16* Ks, const bf16x8* qr, int r32, int hi, f32x16& p0, f32x16& p1, float& l_reg,
                                      bf16x8& pa0, bf16x8& pa1, bf16x8& pa2, bf16x8& pa3) {
  n0 = f32x16{}; n1 = f32x16{};
  bf16x8 k0[8], k1[8]; const char* Kb = (const char*)Ks; float psA = 0.f, psB = 0.f;
#pragma unroll
  for (int d0 = 0; d0 < QKPF; ++d0) { const int cb = (d0 * 16 + hi * 8) * 2;
    k0[d0] = *reinterpret_cast<const bf16x8*>(Kb + KSWZ(r32, cb)); k1[d0] = *reinterpret_cast<const bf16x8*>(Kb + KSWZ(32 + r32, cb)); }
  qk_sm_step<0>(n0, n1, Kb, qr, r32, hi, k0, k1, p0, p1, psA, psB, pa0, pa1, pa2, pa3);
  SBAR();
  float ps = psA + psB;
  { auto rr = __builtin_amdgcn_permlane32_swap(__float_as_uint(ps), __float_as_uint(ps), false, false); ps = __uint_as_float(rr[0]) + __uint_as_float(rr[1]); }
  l_reg += ps;
}
#undef PK4S
__device__ __forceinline__ int v_st(int k, int c) { const int kk = (k & ~0xC) | ((k & 4) << 1) | ((k & 8) >> 1); return ((kk >> 3) * 4 + (c >> 5)) * 512 + ((kk & 7) * 32 + (c & 31)) * 2; }
__device__ __forceinline__ int v_rd_base(int lane) { return ((lane & 3) << 3) | (((lane >> 2) & 3) << 6) | (((lane >> 4) & 1) << 5) | (((lane >> 5) & 1) << 8); }
constexpr int v_rd_off(int d0, int ks, int half) { return d0 * 512 + ks * 4096 + half * 2048; }
template <int OFF> __device__ __forceinline__ s16x4 tr_read(int vb) {
  s16x4 r; asm volatile("ds_read_b64_tr_b16 %0, %1 offset:%2" : "=&v"(r) : "v"(vb), "i"(OFF) : "memory"); return r;
}
template <int D0> __device__ __forceinline__ void pv_one(f32x16& od, int vb, bf16x8 pa0, bf16x8 pa1, bf16x8 pa2, bf16x8 pa3) {
  const s16x4 l0 = tr_read<v_rd_off(D0, 0, 0)>(vb), h0 = tr_read<v_rd_off(D0, 0, 1)>(vb), l1 = tr_read<v_rd_off(D0, 1, 0)>(vb), h1 = tr_read<v_rd_off(D0, 1, 1)>(vb);
  const s16x4 l2 = tr_read<v_rd_off(D0, 2, 0)>(vb), h2 = tr_read<v_rd_off(D0, 2, 1)>(vb), l3 = tr_read<v_rd_off(D0, 3, 0)>(vb), h3 = tr_read<v_rd_off(D0, 3, 1)>(vb);
  asm volatile("s_waitcnt lgkmcnt(0)" ::: "memory"); SBAR();
#define PK(L, H) (bf16x8){L[0], L[1], L[2], L[3], H[0], H[1], H[2], H[3]}
  od = __builtin_amdgcn_mfma_f32_32x32x16_bf16(pa0, PK(l0, h0), od, 0, 0, 0);
  od = __builtin_amdgcn_mfma_f32_32x32x16_bf16(pa1, PK(l1, h1), od, 0, 0, 0);
  od = __builtin_amdgcn_mfma_f32_32x32x16_bf16(pa2, PK(l2, h2), od, 0, 0, 0);
  od = __builtin_amdgcn_mfma_f32_32x32x16_bf16(pa3, PK(l3, h3), od, 0, 0, 0);
#undef PK
}
__device__ __forceinline__ void pv_d0(f32x16* o, int vb, bf16x8 pa0, bf16x8 pa1, bf16x8 pa2, bf16x8 pa3) {
  pv_one<0>(o[0], vb, pa0, pa1, pa2, pa3); pv_one<1>(o[1], vb, pa0, pa1, pa2, pa3); pv_one<2>(o[2], vb, pa0, pa1, pa2, pa3); pv_one<3>(o[3], vb, pa0, pa1, pa2, pa3);
}
template <typename TQ, bool NOMAX>
__device__ __forceinline__ void attn_dense_body(const TQ* __restrict__ Qb, const bf16* __restrict__ Kh, const bf16* __restrict__ Vh,
                                                bf16* __restrict__ Ob, int seq, char* lds) {
  using St = Stage<bf16>; using SQ = Stage<TQ>;
  int tid_ = threadIdx.x; asm volatile("" : "+v"(tid_));
  const int tid = tid_, wid = tid >> 6, lane = tid & 63, r32 = lane & 31, hi = lane >> 5;
  bf16* V_lds = (bf16*)lds; bf16* K_lds = (bf16*)(lds + NBUF * SHM_V);
  float* ws = (float*)(lds + NBUF * SHM_V + NBUF * SHM_K) + wid * 64; float* li_l = ws; float* al_l = ws + 32;
  float m_reg = -1e30f, l_reg = 0; f32x16 o[4] = {}; bf16x8 qr[8];
  const TQ* Qw = Qb + (long)(wid * QBLK + r32) * LDQ + hi * 8;
#pragma unroll
  for (int d0 = 0; d0 < 8; ++d0) qr[d0] = SQ::tobf(SQ::ld8(Qw + d0 * 16));
  const int sr = tid >> 4, sc = (tid & 15) * 8, vst0 = v_st(sr, sc), vst1 = v_st(32 + sr, sc);
  const int vb0 = (int)(uintptr_t)V_lds + v_rd_base(lane);
  struct { typename St::T vs0, vs1, ks0, ks1; } sr_[SDEPTH];
  const unsigned lo0 = (unsigned)(sr * LDK + sc) * 2u;
#define UPTR(p) ((const GAS char*)(((unsigned long long)(unsigned)__builtin_amdgcn_readfirstlane((unsigned)((unsigned long long)(p) >> 32)) << 32) | (unsigned long long)(unsigned)__builtin_amdgcn_readfirstlane((unsigned)(unsigned long long)(p))))
#define SLOAD(i, k0) do { const GAS char* vt_ = UPTR((const char*)Vh + (size_t)(k0) * (LDK * 2)); const GAS char* kt_ = UPTR((const char*)Kh + (size_t)(k0) * (LDK * 2)); \
    unsigned lo1_ = lo0; asm volatile("v_add_u32 %0, 0x2000, %0" : "+v"(lo1_));     \
    sr_[i].vs0 = *(const GAS bf16x8*)(vt_ + lo0); sr_[i].vs1 = *(const GAS bf16x8*)(vt_ + lo1_); sr_[i].ks0 = *(const GAS bf16x8*)(kt_ + lo0); sr_[i].ks1 = *(const GAS bf16x8*)(kt_ + lo1_); } while (0)
#define SWRITE(b, i) do { *(bf16x8*)((char*)V_lds + (b) * SHM_V + vst0) = St::tobf(sr_[i].vs0);          \
    *(bf16x8*)((char*)V_lds + (b) * SHM_V + vst1) = St::tobf(sr_[i].vs1); int kc = sc * 2;               \
    *(bf16x8*)((char*)K_lds + (b) * SHM_K + KSWZ(sr, kc)) = St::tobf(sr_[i].ks0);                       \
    *(bf16x8*)((char*)K_lds + (b) * SHM_K + KSWZ(32 + sr, kc)) = St::tobf(sr_[i].ks1); } while (0)
#define SWAIT() do { if constexpr (SDEPTH == 2) asm volatile("s_waitcnt vmcnt(4)" ::: "memory"); else asm volatile("s_waitcnt vmcnt(0)" ::: "memory"); } while (0)
#define RESC(a) do { if constexpr (!NOMAX) if (__any((a) < 1.f)) { if (hi == 0) al_l[r32] = (a); asm volatile("s_waitcnt lgkmcnt(0)" ::: "memory"); \
    for (int d = 0; d < 4; ++d) for (int r = 0; r < 16; ++r) o[d][r] *= al_l[crow(r, hi)]; } } while (0)
  f32x16 pA0, pA1, pB0, pB1; float mnA, mnB, alA, alB; bf16x8 pa0, pa1, pa2, pa3; const int NT = seq / KVBLK;
  constexpr int SE = 0, SO = SDEPTH - 1;
  SLOAD(SE, 0); asm volatile("s_waitcnt vmcnt(0)" ::: "memory"); SWRITE(0, SE); __syncthreads();
  qkt(pA0, pA1, K_lds, qr, r32, hi); partialSM<NOMAX>(pA0, pA1, m_reg, mnA, alA);
  SLOAD(SO, KVBLK); if constexpr (SDEPTH == 2) { if (2 < NT) SLOAD(SE, 2 * KVBLK); }
  SWAIT(); SWRITE(1, SO); __syncthreads();
  if (__builtin_amdgcn_readfirstlane(wid) >= 4) __builtin_amdgcn_s_setprio(1);
  int bp = 0, bc = 1, bn = 2;
#define ROT() do { const int t_ = bp; bp = bc; bc = bn; bn = t_; } while (0)
  for (int j = 1; j + 1 < NT; j += 2) {
    SBAR(); if constexpr (NOMAX) qk_sm(pB0, pB1, (bf16*)((char*)K_lds + bc * SHM_K), qr, r32, hi, pA0, pA1, l_reg, pa0, pa1, pa2, pa3);
    else { qkt(pB0, pB1, (bf16*)((char*)K_lds + bc * SHM_K), qr, r32, hi);
    finishSM<NOMAX>(pA0, pA1, alA, l_reg, pa0, pa1, pa2, pa3); } SBAR();
    SLOAD(SO, (j + SDEPTH) * KVBLK); SBAR();
    pv_d0(o, vb0 + bp * (int)SHM_V, pa0, pa1, pa2, pa3); partialSM<NOMAX>(pB0, pB1, m_reg, mnB, alB);
    SWAIT(); SWRITE(bn, SE);
    RESC(alB); __syncthreads(); ROT();
    SBAR(); if constexpr (NOMAX) qk_sm(pA0, pA1, (bf16*)((char*)K_lds + bc * SHM_K), qr, r32, hi, pB0, pB1, l_reg, pa0, pa1, pa2, pa3);
    else { qkt(pA0, pA1, (bf16*)((char*)K_lds + bc * SHM_K), qr, r32, hi);
    finishSM<NOMAX>(pB0, pB1, alB, l_reg, pa0, pa1, pa2, pa3); } SBAR();
    if (SDEPTH == 1 || j + 3 < NT) SLOAD(SE, (j + 1 + SDEPTH) * KVBLK); SBAR();
    pv_d0(o, vb0 + bp * (int)SHM_V, pa0, pa1, pa2, pa3); partialSM<NOMAX>(pA0, pA1, m_reg, mnA, alA);
    SWAIT(); SWRITE(bn, SO);
    RESC(alA); __syncthreads(); ROT();
  }
  SBAR(); if constexpr (NOMAX) qk_sm(pB0, pB1, (bf16*)((char*)K_lds + bc * SHM_K), qr, r32, hi, pA0, pA1, l_reg, pa0, pa1, pa2, pa3);
    else { qkt(pB0, pB1, (bf16*)((char*)K_lds + bc * SHM_K), qr, r32, hi);
    finishSM<NOMAX>(pA0, pA1, alA, l_reg, pa0, pa1, pa2, pa3); } SBAR();
  pv_d0(o, vb0 + bp * (int)SHM_V, pa0, pa1, pa2, pa3); partialSM<NOMAX>(pB0, pB1, m_reg, mnB, alB);
  RESC(alB);
  finishSM<NOMAX>(pB0, pB1, alB, l_reg, pa0, pa1, pa2, pa3); SBAR();
  pv_d0(o, vb0 + bc * (int)SHM_V, pa0, pa1, pa2, pa3);
#undef ROT
  __builtin_amdgcn_s_setprio(0);
  if (hi == 0) li_l[r32] = l_reg; asm volatile("s_waitcnt lgkmcnt(0)" ::: "memory");
  float rli[16];
#pragma unroll
  for (int r = 0; r < 16; ++r) rli[r] = __builtin_amdgcn_rcpf(li_l[crow(r, hi)]);
  __syncthreads();
  char* st = lds + wid * 8192;
#pragma unroll
  for (int r = 0; r < 16; ++r) { const int orow = crow(r, hi);
#pragma unroll
    for (int d0 = 0; d0 < 4; ++d0) *(bf16*)(st + orow * 256 + (d0 * 32 + r32) * 2) = (bf16)(cvtpk(o[d0][r] * rli[r], 0.f) & 0xffffu); }
  asm volatile("s_waitcnt lgkmcnt(0)" ::: "memory");
  bf16* Ow = Ob + (long)(wid * QBLK) * LDO;
#pragma unroll
  for (int i = 0; i < 8; ++i) { const int orow = 4 * i + (lane >> 4), ch = lane & 15;
    *(u32x4*)(Ow + (long)orow * LDO + ch * 8) = *(const u32x4*)(st + orow * 256 + ch * 16); }
#undef SLOAD
#undef UPTR
#undef SWRITE
#undef SWAIT
#undef RESC
}
}
#define FFT_HD __device__ __forceinline__
#define FFT_DEVICE_ASM 1
#define FFT_K_BF16 1
#define FFT_LD(p, i) ((p)[i])
#define FFT_ST(p, i, v) ((p)[i] = (v))
#ifndef FFT_K_BF16
#define FFT_K_BF16 0
#endif
#ifndef FFT_HD
#define FFT_HD __device__ __forceinline__
#endif
#ifndef FFT_SCHED_DEFINED_EARLY
#define FFT_SCHED_DEFINED_EARLY
#ifndef FFT_SCHED
#define FFT_SCHED() __builtin_amdgcn_sched_barrier(0)
#endif
#endif
#ifndef FFT_OPAQUE
#define FFT_OPAQUE(x) asm volatile("" : "+v"(x))
#endif
#ifndef FFT_LD
#define FFT_LD(p, i) ((p)[i])
#define FFT_ST(p, i, v) ((p)[i] = (v))
#endif
#ifdef FFT_DEVICE_ASM
typedef float cf __attribute__((ext_vector_type(2)));
FFT_HD cf cf_add(cf a, cf b) { return a + b; }
FFT_HD cf cf_sub(cf a, cf b) { return a - b; }
FFT_HD cf cf_conj(cf a) { return cf{a.x, -a.y}; }
FFT_HD cf cf_mul(cf a, cf b) {
    cf t, r; asm("v_pk_mul_f32 %0, %1, %2 op_sel_hi:[0,1]" : "=v"(t) : "v"(a), "v"(b));
    asm("v_pk_fma_f32 %0, %1, %2, %3 op_sel:[1,1,0] op_sel_hi:[1,0,1] neg_lo:[0,1,0]" : "=v"(r) : "v"(a), "v"(b), "v"(t)); return r; }
FFT_HD cf cf_mulc(cf a, cf b) {
    cf t, r; asm("v_pk_mul_f32 %0, %1, %2 op_sel_hi:[0,1] neg_hi:[0,1]" : "=v"(t) : "v"(a), "v"(b));
    asm("v_pk_fma_f32 %0, %1, %2, %3 op_sel:[1,1,0] op_sel_hi:[1,0,1]" : "=v"(r) : "v"(a), "v"(b), "v"(t)); return r; }
#define FFT_PKADD(name, mods) FFT_HD cf name(cf a, cf b) { cf r; asm("v_pk_add_f32 %0, %1, %2 " mods : "=v"(r) : "v"(a), "v"(b)); return r; }
FFT_PKADD(cf_sub_mi, "op_sel:[1,1] op_sel_hi:[0,0] neg_lo:[0,1] neg_hi:[1,0]")
FFT_PKADD(cf_sub_pi, "op_sel:[1,1] op_sel_hi:[0,0] neg_lo:[1,0] neg_hi:[0,1]")
FFT_PKADD(cf_add_conj, "neg_hi:[0,1]")
FFT_PKADD(cf_sub_conj, "neg_lo:[0,1]")
FFT_PKADD(cf_add_mi, "op_sel:[0,1] op_sel_hi:[1,0] neg_hi:[0,1]")
FFT_PKADD(cf_conj_sub_mi, "op_sel:[0,1] op_sel_hi:[1,0] neg_lo:[0,1] neg_hi:[1,1]")
FFT_PKADD(cf_add_pi, "op_sel:[0,1] op_sel_hi:[1,0] neg_lo:[0,1]")
FFT_PKADD(cf_conj_add_pi, "op_sel:[0,1] op_sel_hi:[1,0] neg_hi:[1,0]")
#else
struct __attribute__((aligned(8))) cf { float x, y; };
FFT_HD cf cf_add(cf a, cf b) { return cf{a.x + b.x, a.y + b.y}; }
FFT_HD cf cf_sub(cf a, cf b) { return cf{a.x - b.x, a.y - b.y}; }
FFT_HD cf cf_mul(cf a, cf b) { return cf{a.x * b.x - a.y * b.y, a.x * b.y + a.y * b.x}; }
FFT_HD cf cf_mulc(cf a, cf b) { return cf{a.x * b.x + a.y * b.y, a.y * b.x - a.x * b.y}; }
FFT_HD cf cf_conj(cf a) { return cf{a.x, -a.y}; }
FFT_HD cf cf_sub_mi(cf a, cf b) { return cf{a.y - b.y, b.x - a.x}; }
FFT_HD cf cf_sub_pi(cf a, cf b) { return cf{b.y - a.y, a.x - b.x}; }
FFT_HD cf cf_add_conj(cf a, cf b) { return cf{a.x + b.x, a.y - b.y}; }
FFT_HD cf cf_sub_conj(cf a, cf b) { return cf{a.x - b.x, a.y + b.y}; }
FFT_HD cf cf_add_mi(cf a, cf b) { return cf{a.x + b.y, a.y - b.x}; }
FFT_HD cf cf_conj_sub_mi(cf a, cf b) { return cf{a.x - b.y, -a.y - b.x}; }
FFT_HD cf cf_add_pi(cf a, cf b) { return cf{a.x - b.y, a.y + b.x}; }
FFT_HD cf cf_conj_add_pi(cf a, cf b) { return cf{a.x + b.y, -a.y + b.x}; }
#endif
constexpr int FFT_N = 16384;
constexpr int FFT_LDS_CF = 17904;
constexpr int FFT_LDS_BYTES = FFT_LDS_CF * 8;
FFT_HD int fft_phys(int p) { return p + (p >> 4) + ((p >> 9) << 4); }
#define FFT_CONSTS float fc1 = 0.98078528040323043f, fc2 = 0.92387953251128674f, fc3 = 0.83146961230254524f, fc4 = 0.70710678118654752f, fc5 = 0.55557023301960218f, \
    fc6 = 0.38268343236508978f, fc7 = 0.19509032201612825f; FFT_OPAQUE(fc1); FFT_OPAQUE(fc2); FFT_OPAQUE(fc3); FFT_OPAQUE(fc4); FFT_OPAQUE(fc5); FFT_OPAQUE(fc6); FFT_OPAQUE(fc7)
#define FFT_C32(k) ((k) == 0 ? 1.0f : (k) == 1 ? fc1 : (k) == 2 ? fc2 : (k) == 3 ? fc3 : (k) == 4 ? fc4 : (k) == 5 ? fc5 : (k) == 6 ? fc6 : (k) == 7 ? fc7 : (k) == 8 ? 0.0f : (k) == 9 ? -fc7 : \
    (k) == 10 ? -fc6 : (k) == 11 ? -fc5 : (k) == 12 ? -fc4 : (k) == 13 ? -fc3 : (k) == 14 ? -fc2 : -fc1)
#define FFT_S32(k) ((k) == 0 ? 0.0f : (k) == 1 ? fc7 : (k) == 2 ? fc6 : (k) == 3 ? fc5 : (k) == 4 ? fc4 : (k) == 5 ? fc3 : (k) == 6 ? fc2 : (k) == 7 ? fc1 : (k) == 8 ? 1.0f : (k) == 9 ? fc1 : \
    (k) == 10 ? fc2 : (k) == 11 ? fc3 : (k) == 12 ? fc4 : (k) == 13 ? fc5 : (k) == 14 ? fc6 : fc7)

template <int R, int HALF, bool INV> FFT_HD void dft_stage(cf (&v)[R], float fc1, float fc2, float fc3, float fc4, float fc5, float fc6, float fc7) {
#pragma unroll
    for (int g = 0; g < R; g += 2 * HALF) {
#pragma unroll
        for (int i = 0; i < HALF; ++i) {
            const cf a = v[g + i], b = v[g + i + HALF];
            v[g + i] = cf_add(a, b);
            const int ti = i * (16 / HALF);
            if (ti == 0) v[g + i + HALF] = cf_sub(a, b);
            else if (ti == 8) v[g + i + HALF] = INV ? cf_sub_pi(a, b) : cf_sub_mi(a, b);
            else { const cf w = cf{FFT_C32(ti), FFT_S32(ti)}; const cf d = cf_sub(a, b); v[g + i + HALF] = INV ? cf_mul(d, w) : cf_mulc(d, w); }
        }
    }
    FFT_SCHED();
    if constexpr (HALF > 1) dft_stage<R, HALF / 2, INV>(v, fc1, fc2, fc3, fc4, fc5, fc6, fc7);
}
template <int R, bool INV> FFT_HD void dft_reg(cf (&v)[R]) {
    FFT_CONSTS;
    dft_stage<R, R / 2, INV>(v, fc1, fc2, fc3, fc4, fc5, fc6, fc7);
    cf t[R];
#pragma unroll
    for (int k = 0; k < R; ++k) t[k] = v[k];
#pragma unroll
    for (int k = 0; k < R; ++k) {
        const int r = R == 32 ? (((k & 1) << 4) | ((k & 2) << 2) | (k & 4) | ((k & 8) >> 2) | ((k & 16) >> 4)) : (((k & 1) << 3) | ((k & 2) << 1) | ((k & 4) >> 1) | ((k & 8) >> 3));
        v[k] = t[r];
    }
}
#ifndef FFT_SCHED
#define FFT_SCHED() __builtin_amdgcn_sched_barrier(0)
#endif
#ifndef FFT_SINCOS2PI
#define FFT_SINCOS2PI(frac, s, c) do { (s) = __builtin_amdgcn_sinf(frac); (c) = __builtin_amdgcn_cosf(frac); asm volatile("s_nop 1" : "+v"(s), "+v"(c)); } while (0)
#endif
template <int R> FFT_HD void twiddle_chain(cf (&v)[R], float frac  ) {
    FFT_OPAQUE(frac);
    float s, c; FFT_SINCOS2PI(frac, s, c);
    const cf w = cf{c, s}; cf p = w;
#pragma unroll
    for (int k = 1; k < R; ++k) { v[k] = cf_mul(v[k], p); if (k + 1 < R) p = cf_mul(p, w); if ((k & 7) == 7) FFT_SCHED(); }
}
template <class LP> FFT_HD void fft_f1(LP lds, int t, cf (&v)[32]) {
    dft_reg<32, false>(v);
    twiddle_chain<32>(v, -(float)t * (1.0f / 16384.0f));
    int P1 = t + (t >> 4); FFT_OPAQUE(P1);
#pragma unroll
    for (int k = 0; k < 32; ++k) FFT_ST(lds, P1 + 560 * k, v[k]);
}
template <class LP> FFT_HD void fft_f2(LP lds, int t) {
    int P2 = 560 * (t >> 4) + (t & 15); FFT_OPAQUE(P2);
    cf v[32];
#pragma unroll
    for (int j = 0; j < 32; ++j) v[j] = FFT_LD(lds, P2 + 17 * j);
    dft_reg<32, false>(v);
    twiddle_chain<32>(v, -(float)(t & 15) * (1.0f / 512.0f));
#pragma unroll
    for (int k = 0; k < 32; ++k) FFT_ST(lds, P2 + 17 * k, v[k]);
}
template <class LP, bool INV> FFT_HD void fft_p3(LP lds, int t) {
#pragma unroll
    for (int q = 0; q < 2; ++q) {
        int P3 = 17 * t + 16 * (t >> 5) + 8960 * q; FFT_OPAQUE(P3);
        cf v[16];
#pragma unroll
        for (int j = 0; j < 16; ++j) v[j] = FFT_LD(lds, P3 + j);
        dft_reg<16, INV>(v);
#pragma unroll
        for (int k = 0; k < 16; ++k) FFT_ST(lds, P3 + k, v[k]);
    }
}
FFT_HD int fft_pos(int k) { return 512 * (k & 31) + 16 * ((k >> 5) & 31) + (k >> 10); }
template <class LP, int MODE> FFT_HD void fft_pair(LP lds, int t, float* K, const float (&Kr)[66]) {
    const int m = t & 31, alo = t >> 5; unsigned ut = (unsigned)t; FFT_OPAQUE(ut);
    float fr0 = -(float)(alo + 32 * m) * (1.0f / 32768.0f); FFT_OPAQUE(fr0);
    float s, c; FFT_SINCOS2PI(fr0, s, c);
    cf wh = cf{c, s};
    float k0 = 0.98078528040323043f, k1 = -0.19509032201612825f, k2 = 0.99999529380957619f, k3 = -0.0030679567629659761f; FFT_OPAQUE(k0); FFT_OPAQUE(k1); FFT_OPAQUE(k2); FFT_OPAQUE(k3);
    const cf c1024 = cf{k0, k1};
    const cf c16 = cf{k2, k3};
#pragma unroll
    for (int h = 0; h < 8; ++h) {
#pragma unroll
        for (int e = 0; e < 2; ++e) {
            const int j = 2 * h + e;
            const cf w = e ? cf_mul(wh, c16) : wh;
            const int k = alo + 16 * e + 32 * m + 1024 * h;
            const int a = alo + 16 * e, an = (32 - a) & 31, b1 = a != 0 ? 1 : 0, mn = (32 - m - b1) & 31, b2 = (m + b1) != 0 ? 1 : 0;
            const int pk = 560 * a + 17 * m + h, pn = 560 * an + 17 * mn + 16 - b2 - h;
            const cf zk = FFT_LD(lds, pk), zn = FFT_LD(lds, pn);
            const cf E2 = cf_add_conj(zk, zn), D2 = cf_sub_conj(zk, zn);
            const cf p = cf_mul(w, D2);
            cf xk = cf_add_mi(E2, p), xn = cf_conj_sub_mi(E2, p);
            if (k == 0) { xk = cf{2.0f * (zk.x + zk.y), 0.f}; xn = cf{2.0f * (zk.x - zk.y), 0.f}; }
#if FFT_K_BF16
            if (MODE == 0) { K[512 * (2 * j + 0) + ut] = __uint_as_float(cvt_pk_bf16(xk.x, xk.y)); K[512 * (2 * j + 1) + ut] = __uint_as_float(cvt_pk_bf16(xn.x, xn.y)); }
#else
            if (MODE == 0) { K[512 * (4 * j + 0) + ut] = xk.x; K[512 * (4 * j + 1) + ut] = xk.y; K[512 * (4 * j + 2) + ut] = xn.x; K[512 * (4 * j + 3) + ut] = xn.y; }
#endif
            else {
                const float q0 = Kr[4 * j + 0], q1 = Kr[4 * j + 1], q2 = Kr[4 * j + 2], q3 = Kr[4 * j + 3];
                const cf yk = cf_mul(xk, cf{q0, q1}), yn = cf_mul(xn, cf{q2, q3});
                const cf E = cf_add_conj(yk, yn), Dd = cf_sub_conj(yk, yn);
                const cf O = cf_mulc(Dd, w);
                cf ok = cf_add_pi(E, O), on = cf_conj_add_pi(E, O);
                if (k == 0) ok = cf{yk.x + yn.x, yk.x - yn.x};
                FFT_ST(lds, pk, ok); if (k != 0) FFT_ST(lds, pn, on);
            }
        }
        wh = cf_mul(wh, c1024);
    }
    if (t == 0) {
        const int pk = 8;
        const cf z = FFT_LD(lds, pk);
#if FFT_K_BF16
        if (MODE == 0) { K[512 * 32 + ut] = __uint_as_float(cvt_pk_bf16(2.0f * z.x, -2.0f * z.y)); }
#else
        if (MODE == 0) { K[512 * 64 + ut] = 2.0f * z.x; K[512 * 65 + ut] = -2.0f * z.y; }
#endif
        else { const cf r = cf_mulc(z, cf{Kr[64], Kr[65]}); FFT_ST(lds, pk, (cf{4.0f * r.x, 4.0f * r.y})); }
    }
}
FFT_HD void fft_kload(const float* K, int t, float (&Kr)[66]) {
    unsigned ut = (unsigned)t; FFT_OPAQUE(ut);
#pragma unroll
#if FFT_K_BF16
    for (int i = 0; i < 33; ++i) { const unsigned w = __float_as_uint(K[512 * i + ut]); Kr[2 * i] = bflo(w); Kr[2 * i + 1] = bfhi(w); }
#else
    for (int i = 0; i < 66; ++i) Kr[i] = K[512 * i + ut];
#endif
}
template <class LP> FFT_HD void fft_i2(LP lds, int t) {
    int P2 = 560 * (t >> 4) + (t & 15); FFT_OPAQUE(P2);
    cf v[32];
#pragma unroll
    for (int k = 0; k < 32; ++k) v[k] = FFT_LD(lds, P2 + 17 * k);
    twiddle_chain<32>(v, (float)(t & 15) * (1.0f / 512.0f));
    dft_reg<32, true>(v);
#pragma unroll
    for (int j = 0; j < 32; ++j) FFT_ST(lds, P2 + 17 * j, v[j]);
}
template <class LP> FFT_HD void fft_i1(LP lds, int t, cf (&v)[32]) {
    int P1 = t + (t >> 4); FFT_OPAQUE(P1);
#pragma unroll
    for (int k = 0; k < 32; ++k) v[k] = FFT_LD(lds, P1 + 560 * k);
    twiddle_chain<32>(v, (float)t * (1.0f / 16384.0f));
    dft_reg<32, true>(v);
}
constexpr int LDS_BYTES = 147456;
constexpr int LDS_BARW = LDS_BYTES - 64;

struct Fr {
    LAS unsigned char* lds; unsigned char* ldsg;
    int tid, lane, wave, blk, nblk, gw, ngw;
    const __attribute__((address_space(4))) unsigned long long* ka;
    unsigned char* ws;
};
#define BFE(v, e) (((e) & 1) ? bfhi((v)[(e) >> 1]) : bflo((v)[(e) >> 1]))

struct WSet { const float *gate, *up, *down, *win, *wout; int nin; };
struct WItem { const float* W; bf16_t* WT; int K, N, rbase, k0, n0; float scale; };
__device__ __forceinline__ WItem wconv_lookup(int it, const WSet& w, unsigned char* wslot  ) {
    const int I_G = 32 * (DFF / 32), I_D = (DFF / 64) * (D / 32), I_IN = 32 * (w.nin / 32);
    WItem x; int mode = 0, row_off = 0, r = it; x.scale = 1.0f;
    if (r < I_G) { x.W = w.gate; x.K = D; x.N = DFF; x.WT = (bf16_t*)(wslot + WO_GU); mode = 1; x.scale = -1.4426950408889634f; }
    else if ((r -= I_G) < I_G) { x.W = w.up; x.K = D; x.N = DFF; x.WT = (bf16_t*)(wslot + WO_GU); mode = 1; row_off = 128; x.scale = -0.6931471805599453f; }
    else if ((r -= I_G) < I_D) { x.W = w.down; x.K = DFF; x.N = D; x.WT = (bf16_t*)(wslot + WO_D); }
    else if ((r -= I_D) < I_IN) { x.W = w.win; x.K = D; x.N = w.nin; x.WT = (bf16_t*)(wslot + WO_IN); }
    else { r -= I_IN; x.W = w.wout; x.K = D; x.N = D; x.WT = (bf16_t*)(wslot + WO_OUT); }
    const int nblk = x.N >> 5, kb = (int)(((float)r + 0.5f) * __builtin_amdgcn_rcpf((float)nblk)), nb = r - kb * nblk; x.k0 = 64 * kb; x.n0 = 32 * nb;
    x.rbase = mode ? 256 * (x.n0 >> 7) + (x.n0 & 127) + row_off : x.n0;
    return x;
}
__device__ __forceinline__ void wconv_load(const WItem& x, int lane, f32x4 (&r)[8]) {
    const float* p = x.W + (size_t)(x.k0 + (lane >> 3)) * x.N + x.n0 + 4 * (lane & 7);
#pragma unroll
    for (int i = 0; i < 8; ++i) r[i] = *(const f32x4*)(p + (size_t)(8 * i) * x.N);
}
__device__ __forceinline__ void wconv_store(const WItem& x, int lane, const f32x4 (&r)[8], LAS float* scr) {
    const int c4 = lane & 7, kr = lane >> 3;
#pragma unroll
    for (int i = 0; i < 8; ++i)
#pragma unroll
        for (int e = 0; e < 4; ++e) scr[(4 * c4 + e) * 65 + kr + 8 * i] = r[i][e];
    LDS_WAIT(); asm volatile("" ::: "memory");
#pragma unroll
    for (int j = 0; j < 4; ++j) { const int n = (lane >> 3) + 8 * j; const LAS float* s = scr + n * 65 + 8 * (lane & 7);
        const float sc = x.scale;
        u32x4 o; o.x = cvt_pk_bf16(s[0] * sc, s[1] * sc); o.y = cvt_pk_bf16(s[2] * sc, s[3] * sc); o.z = cvt_pk_bf16(s[4] * sc, s[5] * sc); o.w = cvt_pk_bf16(s[6] * sc, s[7] * sc);
        *(u32x4*)(x.WT + (size_t)(x.rbase + n) * x.K + x.k0 + 8 * (lane & 7)) = o; }
    LDS_WAIT(); asm volatile("" ::: "memory");
}
__device__ __forceinline__ int wconv_total(int nin) { return 2 * 32 * (DFF / 32) + (DFF / 64) * (D / 32) + 32 * (nin / 32) + 32 * (D / 32); }
__device__ __forceinline__ void wconv_part(const Fr& F, const WSet& w, unsigned char* wslot, LAS float* scr, int& it, int nmax) {
    const int total = wconv_total(w.nin);
    if (it >= total || nmax <= 0) return;
    WItem cur = wconv_lookup(it, w, wslot); f32x4 rc[8]; wconv_load(cur, F.lane, rc);
    for (int n = 1;; ++n) {
        const int nx = it + F.ngw; const bool more = nx < total && n < nmax;
        WItem nxt = cur; f32x4 rn[8];
        if (more) { nxt = wconv_lookup(nx, w, wslot); wconv_load(nxt, F.lane, rn); }
        wconv_store(cur, F.lane, rc, scr);
        it = nx;
        if (!more) break;
        cur = nxt;
#pragma unroll
        for (int i = 0; i < 8; ++i) rc[i] = rn[i];
    }
}
__device__ __forceinline__ void wconv_layer(const Fr& F, const WSet& w, unsigned char* wslot) {
    int it = F.gw; wconv_part(F, w, wslot, (LAS float*)(F.lds + F.wave * 16384), it, 1 << 30);
}

__device__ __forceinline__ void adaln_phase(const Fr& F, const float* c, const float* c_ctx, const float* w_mod, const float* b_mod, float* mod) {
    LAS float* sl = (LAS float*)F.lds;
    LAS float* red = sl + 3 * D;
    for (int i = F.tid; i < 3 * D; i += NTHREADS) { const int cnd = i / D, k = i % D; const float x = cnd < 2 ? c[cnd * D + k] : c_ctx[k]; sl[i] = x / (1.0f + __expf(-x)); }
    __syncthreads();
    for (int g = F.blk; g < 192; g += F.nblk) {
        const int layer = g / 48, colg = (g % 48) * 256, col = colg + 4 * F.lane;
        const float* wp = w_mod + (size_t)layer * D * NMOD + col + (size_t)(F.wave * 256) * NMOD;
        f32x4 a0 = {0.f, 0.f, 0.f, 0.f}, a1 = a0, a2 = a0;
#pragma unroll 1
        for (int kb = 0; kb < 256; kb += 16) { f32x4 w[16];
#pragma unroll
            for (int u = 0; u < 16; ++u) w[u] = __builtin_nontemporal_load((const f32x4*)(wp + (size_t)(kb + u) * NMOD));
#pragma unroll
            for (int u = 0; u < 16; ++u) { const int k = F.wave * 256 + kb + u; a0 += w[u] * sl[k]; a1 += w[u] * sl[D + k]; a2 += w[u] * sl[2 * D + k]; } }
        *(LAS f32x4*)(red + (F.wave * 3 + 0) * 256 + 4 * F.lane) = a0; *(LAS f32x4*)(red + (F.wave * 3 + 1) * 256 + 4 * F.lane) = a1; *(LAS f32x4*)(red + (F.wave * 3 + 2) * 256 + 4 * F.lane) = a2;
        __syncthreads();
        for (int o = F.tid; o < 768; o += NTHREADS) { const int cnd = o >> 8, cc = o & 255; float s = 0.f;
#pragma unroll
            for (int w = 0; w < 8; ++w) s += red[(w * 3 + cnd) * 256 + cc];
            mod[((size_t)layer * 3 + cnd) * NMOD + colg + cc] = s + b_mod[layer * NMOD + colg + cc]; }
        __syncthreads();
    }
}

__device__ __forceinline__ void hdn_phase(const Fr& F, const float* w1, const float* b1, const float* w2, const float* b2, const float* w3, const float* b3, const float* freq, float* hdn) {
    const bool split = F.nblk > 192; if (split && F.blk < 192) return;
    const int first = split ? (F.blk - 192) * NWAVES + F.wave : F.gw, stride = split ? (F.nblk - 192) * NWAVES : F.ngw;
#pragma unroll 1
    for (int j = 0; j < 2; ++j) {
        float W1[33], W2[64], W3[64];
#pragma unroll
        for (int q = 0; q < 33; ++q) W1[q] = w1[(j * 33 + q) * 64 + F.lane];
#pragma unroll
        for (int q = 0; q < 64; ++q) { W2[q] = w2[(j * 64 + q) * 64 + F.lane]; W3[q] = w3[(j * 64 + q) * 64 + F.lane]; }
        const float fr2 = freq[j * 64 + F.lane] * 0.15915494309189535f  , B1 = b1[j * 64 + F.lane], B2 = b2[j * 64 + F.lane], B3 = b3[j * 64 + F.lane];
#pragma unroll 1
        for (int tt = first; tt < SEQ + CTXL; tt += stride) {
            const bool ctx = tt >= SEQ; const int t = ctx ? tt - SEQ : tt, L = ctx ? CTXL : SEQ;
            const float tn = (float)t / (float)(L - 1), rev = (float)t / (float)L;
            const int k = F.lane; float z = 0.f;
            if (k == 0) z = tn;
            else if (k <= 32) { const int i = (k - 1) & 15; const float fb = 1e-4f + (float)i * ((15.0f - 1e-4f) / 15.0f); const float a = fb * rev;
                z = k <= 16 ? __builtin_amdgcn_cosf(a) : -__builtin_amdgcn_sinf(a); }
            float acc = B1;
#pragma unroll
            for (int q = 0; q < 33; ++q) acc += lane_bcast(z, q) * W1[q];
            float h = __builtin_amdgcn_sinf(fr2 * acc);
            acc = B2;
#pragma unroll
            for (int q = 0; q < 64; ++q) acc += lane_bcast(h, q) * W2[q];
            h = __builtin_amdgcn_sinf(fr2 * acc);
            acc = B3;
#pragma unroll
            for (int q = 0; q < 64; ++q) acc += lane_bcast(h, q) * W3[q];
            hdn[((size_t)j * (SEQ + CTXL) + tt) * 64 + F.lane] = __builtin_amdgcn_sinf(fr2 * acc);
        }
    }
}

typedef float f32x16_t __attribute__((ext_vector_type(16)));
__device__ __forceinline__ void split8(const float (&v)[8], bf16x8& h, bf16x8& l) {
    u32x4 hw, lw;
#pragma unroll
    for (int i = 0; i < 4; ++i) { const unsigned w = cvt_pk_bf16(v[2 * i], v[2 * i + 1]); hw[i] = w; lw[i] = cvt_pk_bf16(v[2 * i] - bflo(w), v[2 * i + 1] - bfhi(w)); }
    h = *(bf16x8*)&hw; l = *(bf16x8*)&lw;
}
template <typename TK>
__device__ __forceinline__ void hy_filt_tiles(const Fr& F, const float* hdn  , const float* w4  , TK* KF, int L, int first, int stride) {
    const int m = F.lane & 31, hi = F.lane >> 5;
    const int ntiles = ((L + 511) / 512) * 32;
    for (int tile = first; tile < ntiles; tile += stride) {
        const int t0 = (tile >> 5) * 512, c0 = (tile & 31) * 64;
#pragma unroll 1
        for (int bank = 0; bank < 2; ++bank) {
            bf16x8 Ah[2][4], Al[2][4];
#pragma unroll
            for (int mb = 0; mb < 2; ++mb) { const float* wp = w4 + bank * 2048 + c0 + mb * 32 + m + (size_t)(8 * hi) * 4096;
#pragma unroll
                for (int ks = 0; ks < 4; ++ks) { float v[8];
#pragma unroll
                    for (int e = 0; e < 8; ++e) v[e] = wp[(size_t)(16 * ks + e) * 4096];
                    split8(v, Ah[mb][ks], Al[mb][ks]); } }
#pragma unroll 1
            for (int nb = 0; nb < 2; ++nb) {
                const int tpos = t0 + 64 * F.wave + 32 * nb + m, tl = tpos < L ? tpos : L - 1;
                bf16x8 Bh[4], Bl[4];
#pragma unroll
                for (int ks = 0; ks < 4; ++ks) { const float* hp = hdn + (size_t)tl * 64 + 16 * ks + 8 * hi; const f32x4 x0 = *(const f32x4*)hp, x1 = *(const f32x4*)(hp + 4);
                    const float v[8] = {x0.x, x0.y, x0.z, x0.w, x1.x, x1.y, x1.z, x1.w}; split8(v, Bh[ks], Bl[ks]); }
                const float tn = (float)tpos / (float)(L - 1);
#pragma unroll
                for (int mb = 0; mb < 2; ++mb) {
                    f32x16_t acc = {0.f, 0.f, 0.f, 0.f, 0.f, 0.f, 0.f, 0.f, 0.f, 0.f, 0.f, 0.f, 0.f, 0.f, 0.f, 0.f};
#pragma unroll
                    for (int ks = 0; ks < 4; ++ks) { acc = __builtin_amdgcn_mfma_f32_32x32x16_bf16(Ah[mb][ks], Bh[ks], acc, 0, 0, 0);
                        acc = __builtin_amdgcn_mfma_f32_32x32x16_bf16(Ah[mb][ks], Bl[ks], acc, 0, 0, 0); acc = __builtin_amdgcn_mfma_f32_32x32x16_bf16(Al[mb][ks], Bh[ks], acc, 0, 0, 0); }
                    if (tpos < L) {
                        const int cb = c0 + mb * 32 + 4 * hi;
                        TK* dst = KF + (size_t)cb * (2 * L) + (bank ? (tpos > 0 ? 2 * L - tpos : L) : tpos);
#pragma unroll
                        for (int r = 0; r < 16; ++r) { const int mm = (r & 3) + 8 * (r >> 2);
                            const float dl = 3.0701134573253946f + 12.280453829301578f * ((float)(cb + mm) * (1.0f / 2047.0f));
                            const float kv = (bank && tpos == 0) ? 0.f : acc[r] * __expf(-tn * dl);
                            if constexpr (sizeof(TK) == 2) dst[(size_t)mm * (2 * L)] = (bf16_t)(cvt_pk_bf16(kv, 0.f) & 0xffffu); else dst[(size_t)mm * (2 * L)] = kv; }
                    }
                }
            }
        }
    }
}

__device__ __forceinline__ void hy_filt_long(const Fr& F, const float* hdn  , const float* w4  , bf16_t* KF, int first, int stride) {
    constexpr int L = SEQ, PITCH = 144;
    const int m = F.lane & 31, hi = F.lane >> 5;
    LAS unsigned char* T = (LAS unsigned char*)(F.lds + F.wave * 16384);
    const int ntiles = (L / 512) * 32;
#pragma unroll 1
    for (int bank = 0; bank < 2; ++bank) {
        bf16x8 Ah[2][4], Al[2][4]; int c0p = -1;
#pragma unroll 1
        for (int tile = first; tile < ntiles; tile += stride) {
            const int t0 = (tile >> 5) * 512, c0 = (tile & 31) * 64, tw = t0 + 64 * F.wave;
            if (c0 != c0p) { c0p = c0;
#pragma unroll
                for (int mb = 0; mb < 2; ++mb) { const float* wp = w4 + bank * 2048 + c0 + mb * 32 + m + (size_t)(8 * hi) * 4096;
#pragma unroll
                    for (int ks = 0; ks < 4; ++ks) { float v[8];
#pragma unroll
                        for (int e = 0; e < 8; ++e) v[e] = wp[(size_t)(16 * ks + e) * 4096];
                        split8(v, Ah[mb][ks], Al[mb][ks]); } } }
            f32x16_t acc[2][2];
#pragma unroll
            for (int nb = 0; nb < 2; ++nb) {
                const int tpos = tw + 32 * nb + m + bank, tl = tpos < L ? tpos : L - 1;
                bf16x8 Bh[4], Bl[4];
#pragma unroll
                for (int ks = 0; ks < 4; ++ks) { const float* hp = hdn + (size_t)tl * 64 + 16 * ks + 8 * hi; const f32x4 x0 = *(const f32x4*)hp, x1 = *(const f32x4*)(hp + 4);
                    const float v[8] = {x0.x, x0.y, x0.z, x0.w, x1.x, x1.y, x1.z, x1.w}; split8(v, Bh[ks], Bl[ks]); }
#pragma unroll
                for (int mb = 0; mb < 2; ++mb) {
                    f32x16_t a = {0.f, 0.f, 0.f, 0.f, 0.f, 0.f, 0.f, 0.f, 0.f, 0.f, 0.f, 0.f, 0.f, 0.f, 0.f, 0.f};
#pragma unroll
                    for (int ks = 0; ks < 4; ++ks) { a = __builtin_amdgcn_mfma_f32_32x32x16_bf16(Ah[mb][ks], Bh[ks], a, 0, 0, 0);
                        a = __builtin_amdgcn_mfma_f32_32x32x16_bf16(Ah[mb][ks], Bl[ks], a, 0, 0, 0); a = __builtin_amdgcn_mfma_f32_32x32x16_bf16(Al[mb][ks], Bh[ks], a, 0, 0, 0); }
                    acc[nb][mb] = a; }
            }
#pragma unroll
            for (int mb = 0; mb < 2; ++mb) {
#pragma unroll
                for (int nb = 0; nb < 2; ++nb) {
                    const int tpos = tw + 32 * nb + m + bank, col = bank ? 63 - (32 * nb + m) : 32 * nb + m;
                    const float tn = (float)tpos / (float)(L - 1);
#pragma unroll
                    for (int r = 0; r < 16; ++r) { const int chl = (r & 3) + 8 * (r >> 2) + 4 * hi;
                        const float dl = 3.0701134573253946f + 12.280453829301578f * ((float)(c0 + mb * 32 + chl) * (1.0f / 2047.0f));
                        const float kv = tpos >= L ? 0.f : acc[nb][mb][r] * __expf(-tn * dl);
                        *(LAS bf16_t*)(T + chl * PITCH + col * 2) = (bf16_t)(cvt_pk_bf16(kv, 0.f) & 0xffffu); }
                }
                LDS_WAIT(); asm volatile("" ::: "memory");
                const size_t i0 = bank ? (size_t)(2 * L - tw - 64) : (size_t)tw;
#pragma unroll
                for (int k = 0; k < 4; ++k) { const int q = F.lane + 64 * k, ch = q >> 3, seg = q & 7;
                    const u32x4 w = *(const LAS u32x4*)(T + ch * PITCH + seg * 16);
                    *(u32x4*)(KF + (size_t)(c0 + mb * 32 + ch) * (2 * L) + i0 + seg * 8) = w; }
                LDS_WAIT(); asm volatile("" ::: "memory");
            }
        }
    }
}

__device__ __forceinline__ void nr_load(const float* src_lat, const float* src_ctx, const bf16_t* X, bool f32in, int r, int lane, f32x4 (&v)[8]) {
    if (f32in) { const float* xr = (r < M_LAT ? src_lat + (size_t)r * D : src_ctx + (size_t)(r - M_LAT) * D) + 8 * lane;
#pragma unroll
        for (int j = 0; j < 4; ++j) { v[2 * j] = *(const f32x4*)(xr + 512 * j); v[2 * j + 1] = *(const f32x4*)(xr + 512 * j + 4); } }
    else { const bf16_t* xr = X + (size_t)r * D + 8 * lane;
#pragma unroll
        for (int j = 0; j < 4; ++j) { const u32x4 w = *(const u32x4*)(xr + 512 * j);
            v[2 * j] = (f32x4){bflo(w.x), bfhi(w.x), bflo(w.y), bfhi(w.y)}; v[2 * j + 1] = (f32x4){bflo(w.z), bfhi(w.z), bflo(w.w), bfhi(w.w)}; } }
}
struct CtxPend { const float* slab; int ks; const float* gate; const float* bias; const float* base32; };
__device__ __forceinline__ void norm_rows(const Fr& F, const float* src_lat, const float* src_ctx, bf16_t* X, bool f32in, int nrows, const float* g, const float* modl, int sh_off, int sc_off, bf16_t* A, const CtxPend cp) {
    int r = F.gw; if (r >= nrows) return;
    f32x4 v[8]; nr_load(src_lat, src_ctx, X, f32in, r, F.lane, v);
    f32x4 ca[8], cb[8]; int ccond = -1;
    for (;;) {
        const int rn = r + F.ngw; const bool more = rn < nrows;
        f32x4 vn[8];
        if (more) { if (cp.base32 && rn >= M_LAT) nr_load(nullptr, cp.base32, X, true, rn, F.lane, vn); else nr_load(src_lat, src_ctx, X, f32in, rn, F.lane, vn); }
        const int cond = r < M_LAT ? (r >> 14) : 2;
        if (cp.slab && r >= M_LAT) {
            const int rc = r - M_LAT;
#pragma unroll
            for (int j = 0; j < 4; ++j) { const int c = 8 * F.lane + 512 * j;
                f32x4 s0 = {0.f, 0.f, 0.f, 0.f}, s1 = s0;
                for (int kc = 0; kc < cp.ks; ++kc) { const float* sp = cp.slab + ((size_t)kc * 512 + rc) * D + c; s0 += *(const f32x4*)sp; s1 += *(const f32x4*)(sp + 4); }
                if (cp.bias) { s0 += *(const f32x4*)(cp.bias + c); s1 += *(const f32x4*)(cp.bias + c + 4); }
                const f32x4 x0 = v[2 * j] + *(const f32x4*)(cp.gate + c) * s0, x1 = v[2 * j + 1] + *(const f32x4*)(cp.gate + c + 4) * s1;
                u32x4 o; o.x = cvt_pk_bf16(x0.x, x0.y); o.y = cvt_pk_bf16(x0.z, x0.w); o.z = cvt_pk_bf16(x1.x, x1.y); o.w = cvt_pk_bf16(x1.z, x1.w);
                *(u32x4*)(X + (size_t)r * D + c) = o;
                v[2 * j] = (f32x4){bflo(o.x), bfhi(o.x), bflo(o.y), bfhi(o.y)}; v[2 * j + 1] = (f32x4){bflo(o.z), bfhi(o.z), bflo(o.w), bfhi(o.w)}; }
        }
        if (cond != ccond) {
            const float* sh = modl + cond * NMOD + sh_off; const float* sc = modl + cond * NMOD + sc_off;
#pragma unroll
            for (int j = 0; j < 4; ++j)
#pragma unroll
                for (int q = 0; q < 2; ++q) { const int c = 8 * F.lane + 512 * j + 4 * q; ca[2 * j + q] = *(const f32x4*)(g + c) * (*(const f32x4*)(sc + c) + 1.0f); cb[2 * j + q] = *(const f32x4*)(sh + c); }
            ccond = cond;
        }
        float ss = 0.f;
#pragma unroll
        for (int j = 0; j < 8; ++j) ss += (v[j].x * v[j].x + v[j].y * v[j].y) + (v[j].z * v[j].z + v[j].w * v[j].w);
        const float rstd = 1.0f / sqrtf(wave_sum(ss) * (1.0f / D) + NORM_EPS);
#pragma unroll
        for (int j = 0; j < 4; ++j) { const int c = 8 * F.lane + 512 * j; f32x4 y[2];
#pragma unroll
            for (int q = 0; q < 2; ++q) y[q] = (v[2 * j + q] * rstd) * ca[2 * j + q] + cb[2 * j + q];
            u32x4 o; o.x = cvt_pk_bf16(y[0].x, y[0].y); o.y = cvt_pk_bf16(y[0].z, y[0].w); o.z = cvt_pk_bf16(y[1].x, y[1].y); o.w = cvt_pk_bf16(y[1].z, y[1].w);
            *(u32x4*)(A + (size_t)r * D + c) = o; }
        if (!more) break;
        r = rn;
#pragma unroll
        for (int j = 0; j < 8; ++j) v[j] = vn[j];
    }
}
__device__ __forceinline__ void final_norm(const Fr& F, const bf16_t* X, const float* g, float* out) {
    int r = F.gw; if (r >= M_LAT) return;
    f32x4 v[8]; nr_load(nullptr, nullptr, X, false, r, F.lane, v);
    f32x4 gv[8];
#pragma unroll
    for (int j = 0; j < 4; ++j)
#pragma unroll
        for (int q = 0; q < 2; ++q) gv[2 * j + q] = *(const f32x4*)(g + 8 * F.lane + 512 * j + 4 * q);
    for (;;) {
        const int rn = r + F.ngw; const bool more = rn < M_LAT;
        f32x4 vn[8];
        if (more) nr_load(nullptr, nullptr, X, false, rn, F.lane, vn);
        float ss = 0.f;
#pragma unroll
        for (int j = 0; j < 8; ++j) ss += (v[j].x * v[j].x + v[j].y * v[j].y) + (v[j].z * v[j].z + v[j].w * v[j].w);
        const float rstd = 1.0f / sqrtf(wave_sum(ss) * (1.0f / D) + NORM_EPS);
#pragma unroll
        for (int j = 0; j < 4; ++j)
#pragma unroll
            for (int q = 0; q < 2; ++q) { const int c = 8 * F.lane + 512 * j + 4 * q; *(f32x4*)(out + (size_t)r * D + c) = (v[2 * j + q] * rstd) * gv[2 * j + q]; }
        if (!more) break;
        r = rn;
#pragma unroll
        for (int j = 0; j < 8; ++j) v[j] = vn[j];
    }
}

struct ZR { u32x4 m, c, p; };
__device__ __forceinline__ ZR zr_load(const bf16_t* zr  , int ld, int col, bool hp, bool hn) {
    const u32x4 z0 = {0u, 0u, 0u, 0u}; ZR z;
    z.m = hp ? *(const u32x4*)(zr - ld + col) : z0; z.c = *(const u32x4*)(zr + col); z.p = hn ? *(const u32x4*)(zr + ld + col) : z0; return z;
}
__device__ __forceinline__ void w8_load(const float* w, int wld, const float* b, int col, float (&wv)[3][8], float (&bv)[8]) {
#pragma unroll
    for (int k = 0; k < 3; ++k) { const f32x4 a = *(const f32x4*)(w + k * wld + col), c = *(const f32x4*)(w + k * wld + col + 4);
        wv[k][0] = a.x; wv[k][1] = a.y; wv[k][2] = a.z; wv[k][3] = a.w; wv[k][4] = c.x; wv[k][5] = c.y; wv[k][6] = c.z; wv[k][7] = c.w; }
    if (b) { const f32x4 a = *(const f32x4*)(b + col), c = *(const f32x4*)(b + col + 4); bv[0] = a.x; bv[1] = a.y; bv[2] = a.z; bv[3] = a.w; bv[4] = c.x; bv[5] = c.y; bv[6] = c.z; bv[7] = c.w; }
    else {
#pragma unroll
        for (int e = 0; e < 8; ++e) bv[e] = 0.f; }
}
__device__ __forceinline__ void conv3_w(const ZR& z, const float (&wv)[3][8], const float (&bv)[8], float (&out)[8]) {
#pragma unroll
    for (int e = 0; e < 8; ++e) out[e] = BFE(z.m, e) * wv[0][e] + BFE(z.c, e) * wv[1][e] + BFE(z.p, e) * wv[2][e] + bv[e];
}
__device__ __forceinline__ void bi8_load(const float* bi, int col, float (&v)[8]) {
    const f32x4 a = *(const f32x4*)(bi + col), c = *(const f32x4*)(bi + col + 4); v[0] = a.x; v[1] = a.y; v[2] = a.z; v[3] = a.w; v[4] = c.x; v[5] = c.y; v[6] = c.z; v[7] = c.w;
}
__device__ __forceinline__ void bi_fold(const float (&wv)[3][8], const float (&bi)[8], float (&bv)[8]) {
#pragma unroll
    for (int e = 0; e < 8; ++e) bv[e] += bi[e] * (wv[0][e] + wv[1][e] + wv[2][e]);
}
__device__ __forceinline__ void bi_edge(const float (&wv)[3][8], const float (&bi)[8], bool hp, bool hn, float (&out)[8]) {
    if (!hp) {
#pragma unroll
        for (int e = 0; e < 8; ++e) out[e] -= bi[e] * wv[0][e]; }
    if (!hn) {
#pragma unroll
        for (int e = 0; e < 8; ++e) out[e] -= bi[e] * wv[2][e]; }
}
__device__ __forceinline__ void row_pos(int r, int& tpos, int& Ls) { if (r < M_LAT) { Ls = SEQ; tpos = r & (SEQ - 1); } else { Ls = CTXL; tpos = (r - M_LAT) & (CTXL - 1); } }
__device__ __forceinline__ bf16_t* vt_addr(bf16_t* VT, bf16_t* VTC, int r0, int ch) {
    if (r0 < M_LAT) return VT + ((size_t)((r0 >> 14) * D + ch) * SEQ + (r0 & (SEQ - 1)));
    const int q = r0 - M_LAT; return VTC + ((size_t)((q >> 8) * D + ch) * CTXL + (q & (CTXL - 1)));
}
__device__ __forceinline__ u32x4 pack8(const float (&y)[8]) { u32x4 o; o.x = cvt_pk_bf16(y[0], y[1]); o.y = cvt_pk_bf16(y[2], y[3]); o.z = cvt_pk_bf16(y[4], y[5]); o.w = cvt_pk_bf16(y[6], y[7]); return o; }

__device__ __forceinline__ void hy_elem_phase(const Fr& F, const bf16_t* Z, const float* sw, const float* sb, const float* bin, bf16_t* VT, bf16_t* VTC, int nrows) {
    LAS float* T0 = (LAS float*)F.lds;
    int par = 0;
    const int ntiles = (nrows / 64) * 32, tt = F.tid >> 3, cg = F.tid & 7;
    int tile = F.blk; if (tile >= ntiles) return;
    float w1[3][8], b1[8], w2[3][8], b2[8], i1[8], i2[8]; int cw = -1;
    ZR za, zb;
    { const int r = (tile >> 5) * 64 + tt, c = (tile & 31) * 64 + 8 * cg; int tpos, Ls; row_pos(r, tpos, Ls); const bf16_t* zr = Z + (size_t)r * (3 * D);
      za = zr_load(zr, 3 * D, D + c, tpos > 0, tpos < Ls - 1); zb = zr_load(zr, 3 * D, 2 * D + c, tpos > 0, tpos < Ls - 1); }
    for (;;) {
        LAS float* T = T0 + par * (64 * 65); par ^= 1;
        const int r0 = (tile >> 5) * 64, c0 = (tile & 31) * 64, c = c0 + 8 * cg;
        const int nt = tile + F.nblk; const bool more = nt < ntiles;
        ZR na = za, nb = zb;
        if (more) { const int r = (nt >> 5) * 64 + tt, cn = (nt & 31) * 64 + 8 * cg; int tpos, Ls; row_pos(r, tpos, Ls); const bf16_t* zr = Z + (size_t)r * (3 * D);
            na = zr_load(zr, 3 * D, D + cn, tpos > 0, tpos < Ls - 1); nb = zr_load(zr, 3 * D, 2 * D + cn, tpos > 0, tpos < Ls - 1); }
        if (c != cw) { w8_load(sw, 3 * D, sb, D + c, w1, b1); w8_load(sw, 3 * D, sb, 2 * D + c, w2, b2); bi8_load(bin, D + c, i1); bi8_load(bin, 2 * D + c, i2); bi_fold(w1, i1, b1); bi_fold(w2, i2, b2); cw = c; }
        float x1[8], vv[8];
        conv3_w(za, w1, b1, x1); conv3_w(zb, w2, b2, vv);
        { int tpos, Ls; row_pos(r0 + tt, tpos, Ls); const bool hp = tpos > 0, hn = tpos < Ls - 1;
          if (!(hp && hn)) { bi_edge(w1, i1, hp, hn, x1); bi_edge(w2, i2, hp, hn, vv); } }
#pragma unroll
        for (int e = 0; e < 8; ++e) T[tt * 65 + 8 * cg + e] = vv[e] * x1[e];
        __syncthreads();
        { const int ch = F.tid >> 3, chunk = F.tid & 7; float y[8];
#pragma unroll
          for (int i = 0; i < 8; ++i) y[i] = T[(8 * chunk + i) * 65 + ch];
          *(u32x4*)(vt_addr(VT, VTC, r0, c0 + ch) + 8 * chunk) = pack8(y); }
        if (!more) break;
        tile = nt; za = na; zb = nb;
    }
}
__device__ __forceinline__ void hy_post_phase(const Fr& F, const bf16_t* Z, const float* sw, const float* sb, const float* bin, bf16_t* VT, bf16_t* VTC, bf16_t* A, int nrows) {
    LAS float* T0 = (LAS float*)F.lds;
    int par = 0;
    const int ntiles = (nrows / 64) * 32, tt = F.tid >> 3, cg = F.tid & 7;
    int tile = F.blk; if (tile >= ntiles) return;
    float w0[3][8], b0[8], i0[8]; int cw = -1;
    ZR za; u32x4 yv;
    { const int r0 = (tile >> 5) * 64, c0 = (tile & 31) * 64, r = r0 + tt; int tpos, Ls; row_pos(r, tpos, Ls);
      za = zr_load(Z + (size_t)r * (3 * D), 3 * D, c0 + 8 * cg, tpos > 0, tpos < Ls - 1); yv = *(const u32x4*)(vt_addr(VT, VTC, r0, c0 + (F.tid >> 3)) + 8 * (F.tid & 7)); }
    for (;;) {
        LAS float* T = T0 + par * (64 * 65); par ^= 1;
        const int r0 = (tile >> 5) * 64, c0 = (tile & 31) * 64, r = r0 + tt, c = c0 + 8 * cg;
        const int nt = tile + F.nblk; const bool more = nt < ntiles;
        ZR na = za; u32x4 yn = yv;
        if (more) { const int r0n = (nt >> 5) * 64, c0n = (nt & 31) * 64, rn = r0n + tt; int tpos, Ls; row_pos(rn, tpos, Ls);
            na = zr_load(Z + (size_t)rn * (3 * D), 3 * D, c0n + 8 * cg, tpos > 0, tpos < Ls - 1); yn = *(const u32x4*)(vt_addr(VT, VTC, r0n, c0n + (F.tid >> 3)) + 8 * (F.tid & 7)); }
        { const int ch = F.tid >> 3, chunk = F.tid & 7;
#pragma unroll
          for (int i = 0; i < 8; ++i) T[(8 * chunk + i) * 65 + ch] = BFE(yv, i); }
        __syncthreads();
        if (c != cw) { w8_load(sw, 3 * D, sb, c, w0, b0); bi8_load(bin, c, i0); bi_fold(w0, i0, b0); cw = c; }
        float x0[8], y[8];
        conv3_w(za, w0, b0, x0);
        { int tpos, Ls; row_pos(r, tpos, Ls); const bool hp = tpos > 0, hn = tpos < Ls - 1; if (!(hp && hn)) bi_edge(w0, i0, hp, hn, x0); }
#pragma unroll
        for (int e = 0; e < 8; ++e) y[e] = T[tt * 65 + 8 * cg + e] * x0[e];
        *(u32x4*)(A + (size_t)r * D + c) = pack8(y);
        if (!more) break;
        tile = nt; za = na; yv = yn;
    }
}
struct SC7 { u32x4 gb, gcm, gcc, gcp, xvm, xvc, xvp; };
__device__ __forceinline__ SC7 sc_load(const bf16_t* Z, int r, int c) {
    int tpos, Ls; row_pos(r, tpos, Ls); const bf16_t* zr = Z + (size_t)r * (3 * D); const bool hp = tpos > 0, hn = tpos < Ls - 1; const u32x4 z0 = {0u, 0u, 0u, 0u};
    SC7 s; s.gb = *(const u32x4*)(zr + c); s.gcc = *(const u32x4*)(zr + D + c); s.xvc = *(const u32x4*)(zr + 2 * D + c);
    s.gcm = hp ? *(const u32x4*)(zr - 3 * D + D + c) : z0; s.xvm = hp ? *(const u32x4*)(zr - 3 * D + 2 * D + c) : z0;
    s.gcp = hn ? *(const u32x4*)(zr + 3 * D + D + c) : z0; s.xvp = hn ? *(const u32x4*)(zr + 3 * D + 2 * D + c) : z0; return s;
}
__device__ __forceinline__ void sc_elem_phase(const Fr& F, const bf16_t* Z, const float* cw  , bf16_t* A, int nrows) {
    const size_t nitems = (size_t)nrows * 256, step = (size_t)F.nblk * NTHREADS;
    size_t idx = (size_t)F.blk * NTHREADS + F.tid; if (idx >= nitems) return;
    float wv[3][8], bv[8]; int cl = -1;
    SC7 s = sc_load(Z, (int)(idx >> 8), 8 * (int)(idx & 255));
    for (;;) {
        const int r = (int)(idx >> 8), c = 8 * (int)(idx & 255);
        const size_t nx = idx + step; const bool more = nx < nitems;
        SC7 sn = s; if (more) sn = sc_load(Z, (int)(nx >> 8), 8 * (int)(nx & 255));
        if (c != cl) { w8_load(cw, D, nullptr, c, wv, bv); cl = c; }
        float y[8];
#pragma unroll
        for (int e = 0; e < 8; ++e) { const float pm = BFE(s.gcm, e) * BFE(s.xvm, e), pc = BFE(s.gcc, e) * BFE(s.xvc, e), pp = BFE(s.gcp, e) * BFE(s.xvp, e);
            y[e] = BFE(s.gb, e) * (pm * wv[0][e] + pc * wv[1][e] + pp * wv[2][e]); }
        *(u32x4*)(A + (size_t)r * D + c) = pack8(y);
        if (!more) break;
        idx = nx; s = sn;
    }
}
__device__ __forceinline__ void qk_prep_phase(const Fr& F, const bf16_t* Z  , const float* qg, const float* kg, bf16_t* Q, bf16_t* KALL, bf16_t* VALL) {
    const int p = F.lane;
    constexpr float QSC = 0.088388347648318440f * 1.4426950408889634f;
    const float qg1 = qg[2 * p] * QSC, qg2 = qg[2 * p + 1] * QSC, kg1 = kg[2 * p], kg2 = kg[2 * p + 1];
    const float invf2 = exp2f(-(float)(p & 31) * (13.287712379549449f / 32.0f)) * 0.15915494309189535f;
    int r = F.gw; if (r >= M_ALL) return;
    unsigned w[24];
#pragma unroll
    for (int h = 0; h < 24; ++h) w[h] = *(const unsigned*)(Z + (size_t)r * 3072 + h * HD + 2 * p);
    for (;;) {
        const int rn = r + F.ngw; const bool more = rn < M_ALL;
        unsigned wn[24];
        if (more) {
#pragma unroll
            for (int h = 0; h < 24; ++h) wn[h] = *(const unsigned*)(Z + (size_t)rn * 3072 + h * HD + 2 * p); }
        const bool lat = r < M_LAT; const int b = lat ? (r >> 14) : ((r - M_LAT) >> 8), t = lat ? (r & (SEQ - 1)) : ((r - M_LAT) & (CTXL - 1));
        float cs = 1.f, sn = 0.f;
        if (lat) { const float trn = (float)(p < 32 ? (t >> 6) : (t & 63)) * invf2; sn = __builtin_amdgcn_sinf(trn); cs = __builtin_amdgcn_cosf(trn); }
        if (lat) {
#pragma unroll
            for (int h = 0; h < NH; ++h) { const float x1 = bflo(w[h]), x2 = bfhi(w[h]);
                const float rstd = __builtin_amdgcn_rsqf(wave_sum(x1 * x1 + x2 * x2) * (1.0f / HD) + NORM_EPS);
                const float y1 = x1 * rstd * qg1, y2 = x2 * rstd * qg2;
                *(unsigned*)(Q + (size_t)r * D + h * HD + 2 * p) = cvt_pk_bf16(y1 * cs - y2 * sn, y1 * sn + y2 * cs); }
        }
        const size_t kpos = (size_t)(lat ? t : SEQ + t);
#pragma unroll
        for (int h = 0; h < NKV; ++h) { const float x1 = bflo(w[NH + h]), x2 = bfhi(w[NH + h]);
            const float rstd = __builtin_amdgcn_rsqf(wave_sum(x1 * x1 + x2 * x2) * (1.0f / HD) + NORM_EPS);
            const float y1 = x1 * rstd * kg1, y2 = x2 * rstd * kg2;
            const size_t ko = (((size_t)b * NKV + h) * LK + kpos) * HD + 2 * p;
            *(unsigned*)(KALL + ko) = cvt_pk_bf16(y1 * cs - y2 * sn, y1 * sn + y2 * cs);
            *(unsigned*)(VALL + ko) = w[NH + NKV + h]; }
        if (!more) break;
        r = rn;
#pragma unroll
        for (int h = 0; h < 24; ++h) w[h] = wn[h];
    }
}
__device__ __forceinline__ void hy_ctx_conv(const Fr& F, const float* KFC  , const float* skip, bf16_t* VTC  ) {
    LAS float* kp = (LAS float*)(F.lds + F.wave * 4096);
    LAS float* us = kp + 512;
    for (int pr = F.gw; pr < NB * D; pr += F.ngw) {
        const int c = pr & (D - 1);
        const float* kf = KFC + (size_t)c * 512; bf16_t* up = VTC + (size_t)pr * CTXL;
        *(LAS f32x4*)(kp + 4 * F.lane) = *(const f32x4*)(kf + 4 * F.lane); *(LAS f32x4*)(kp + 256 + 4 * F.lane) = *(const f32x4*)(kf + 256 + 4 * F.lane);
        const u32x2 uw = *(const u32x2*)(up + 4 * F.lane);
        *(LAS f32x4*)(us + 4 * F.lane) = (f32x4){bflo(uw.x), bfhi(uw.x), bflo(uw.y), bfhi(uw.y)};
        LDS_WAIT(); asm volatile("" ::: "memory");
        float acc[4] = {0.f, 0.f, 0.f, 0.f};
#pragma unroll 4
        for (int s = 0; s < CTXL; ++s) { const float u = us[s];
#pragma unroll
            for (int q = 0; q < 4; ++q) acc[q] += kp[(F.lane + 64 * q - s) & 511] * u; }
        const float sk = skip[c];
#pragma unroll
        for (int q = 0; q < 4; ++q) { const int t = F.lane + 64 * q; up[t] = (bf16_t)(cvt_pk_bf16(acc[q] + sk * us[t], 0.f) & 0xffffu); }
        LDS_WAIT(); asm volatile("" ::: "memory");
    }
}
#ifndef PROBE_AMP
#define PROBE_AMP 0
#define PROBE_MASK 0ull
#endif
#ifndef PROBE_CYCLES
#define PROBE_CYCLES 0
#endif
#ifndef STAG_GU
#define STAG_GU 0
#define STAG_N 2
#endif
#ifndef STAG_RS
#define STAG_RS 0
#endif
#ifndef EN_DEFAULT
#define EN_DEFAULT 1
#endif
#ifndef EN_PRO
#define EN_PRO EN_DEFAULT
#endif
#ifndef EN_NORM
#define EN_NORM EN_DEFAULT
#endif
#ifndef EN_FILT
#define EN_FILT EN_DEFAULT
#endif
#ifndef EN_G1
#define EN_G1 EN_DEFAULT
#endif
#ifndef EN_HYE
#define EN_HYE EN_DEFAULT
#endif
#ifndef EN_FFT
#define EN_FFT EN_DEFAULT
#endif
#ifndef EN_ATT
#define EN_ATT EN_DEFAULT
#endif
#ifndef EN_G2
#define EN_G2 EN_DEFAULT
#endif
#ifndef EN_G3
#define EN_G3 EN_DEFAULT
#endif
#ifndef EN_G4
#define EN_G4 EN_DEFAULT
#endif
struct Args { const float* in[34]; float* out; unsigned char* ws; int ph_lo, ph_hi; };
static_assert(offsetof(Args, out) == 34 * 8 && offsetof(Args, ws) == 35 * 8, "Args layout");
enum { I_X = 0, I_C, I_CTX, I_CCTX, I_N1G, I_N2G, I_WMOD, I_BMOD, I_FG, I_FU, I_FD, I_HWIN, I_HBIN, I_HSW, I_HSB, I_HFW1, I_HFB1, I_HFW2, I_HFB2, I_HFW3, I_HFB3, I_HFW4, I_HFREQ, I_HSKIP, I_HWOUT, I_HBOUT,
       I_SWIN, I_SCW, I_SWOUT, I_AQKV, I_AQG, I_AKG, I_AWO, I_FING };

__device__ __forceinline__ WSet wset_of(const Fr& F, int layer) {
    const int kind = layer % 3, j = layer / 3; WSet w;
#define IN_(i) ((const float*)(GAS const float*)F.ka[i])
    w.gate = IN_(I_FG) + (size_t)layer * D * DFF; w.up = IN_(I_FU) + (size_t)layer * D * DFF; w.down = IN_(I_FD) + (size_t)layer * DFF * D; w.nin = kind == 2 ? 3072 : 3 * D;
    if (kind == 0) { w.win = IN_(I_HWIN) + (size_t)j * D * 3 * D; w.wout = IN_(I_HWOUT) + (size_t)j * D * D; }
    else if (kind == 1) { w.win = IN_(I_SWIN); w.wout = IN_(I_SWOUT); }
    else { w.win = IN_(I_AQKV); w.wout = IN_(I_AWO); }
#undef IN_
    return w;
}
__device__ __forceinline__ void hy_fft_phase(const Fr& F, const bf16_t* KF  , const float* skip, bf16_t* VT  , float* KSP  , bool conv) {
    LAS f32x2* L = (LAS f32x2*)F.lds;
    const int t = F.tid;
    int it1 = F.gw, it2 = F.gw; LAS float* scr = (LAS float*)(F.lds + F.wave * 16384);
    unsigned kfw[32];
    if (F.blk < D) { const bf16_t* kf = KF + (size_t)F.blk * (2 * SEQ); unsigned ut = (unsigned)t; FFT_OPAQUE(ut);
#pragma unroll
        for (int n1 = 0; n1 < 32; ++n1) kfw[n1] = *(const unsigned*)(kf + (1024 * n1 + 2 * ut)); }
#pragma unroll 1
    for (int c = F.blk; c < D; c += F.nblk) {
        float* K = KSP + (size_t)F.blk * (66 * 512);
        unsigned un[16];
        {
            cf v[32];
#pragma unroll
            for (int n1 = 0; n1 < 32; ++n1) v[n1] = cf{bflo(kfw[n1]), bfhi(kfw[n1])};
            fft_f1(L, t, v); __syncthreads(); fft_f2(L, t); __syncthreads();
            {   unsigned ut = (unsigned)t; FFT_OPAQUE(ut); const bf16_t* up0 = VT + (size_t)c * SEQ;
#pragma unroll
                for (int n1 = 0; n1 < 16; ++n1) un[n1] = *(const unsigned*)(up0 + (1024 * n1 + 2 * ut)); }
            fft_p3<LAS f32x2*, false>(L, t); __syncthreads();
            { float Kz[66]; fft_pair<LAS f32x2*, 0>(L, t, K, Kz); } __syncthreads();
        }
        const float sk = skip[c];
#pragma unroll 1
        for (int b = 0; b < NB; ++b) {
            bf16_t* up = VT + (size_t)(b * D + c) * SEQ;
            unsigned uw[16];
#pragma unroll
            for (int n1 = 0; n1 < 16; ++n1) uw[n1] = un[n1];
            {   cf v[32];
#pragma unroll
                for (int n1 = 0; n1 < 16; ++n1) v[n1] = cf{bflo(uw[n1]), bfhi(uw[n1])};
#pragma unroll
                for (int n1 = 16; n1 < 32; ++n1) v[n1] = cf{0.f, 0.f};
                fft_f1(L, t, v); }
            __syncthreads(); fft_f2(L, t); __syncthreads();
            float Kr[66]; fft_kload(K, t, Kr);
            fft_p3<LAS f32x2*, false>(L, t); __syncthreads();
            fft_pair<LAS f32x2*, 1>(L, t, K, Kr); __syncthreads();
            if (b + 1 < NB) { unsigned ut = (unsigned)t; FFT_OPAQUE(ut); const bf16_t* upn = VT + (size_t)((b + 1) * D + c) * SEQ;
#pragma unroll
                for (int n1 = 0; n1 < 16; ++n1) un[n1] = *(const unsigned*)(upn + (1024 * n1 + 2 * ut)); }
            else if (c + F.nblk < D) { unsigned ut = (unsigned)t; FFT_OPAQUE(ut); const bf16_t* kf = KF + (size_t)(c + F.nblk) * (2 * SEQ);
#pragma unroll
                for (int n1 = 0; n1 < 32; ++n1) kfw[n1] = *(const unsigned*)(kf + (1024 * n1 + 2 * ut)); }
            fft_p3<LAS f32x2*, true>(L, t); __syncthreads(); fft_i2(L, t); __syncthreads();
            {   unsigned ut = (unsigned)t; FFT_OPAQUE(ut);
#pragma unroll
                for (int n1 = 0; n1 < 16; ++n1) uw[n1] = *(const unsigned*)(up + (1024 * n1 + 2 * ut));
                cf v[32]; fft_i1(L, t, v);
#pragma unroll
                for (int n1 = 0; n1 < 16; ++n1) *(unsigned*)(up + (1024 * n1 + 2 * ut)) = cvt_pk_bf16(v[n1].x * (1.0f / 131072.0f) + sk * bflo(uw[n1]), v[n1].y * (1.0f / 131072.0f) + sk * bfhi(uw[n1])); }
        }
        if (conv) {
            __syncthreads();
            { const WSet w1 = wset_of(F, 1); wconv_part(F, w1, F.ws + w_slot_off(1), scr, it1, 2); }
            { const WSet w2 = wset_of(F, 2); wconv_part(F, w2, F.ws + w_slot_off(2), scr, it2, 2); }
            __syncthreads();
        }
    }
    __syncthreads();
    if (conv) {
        { const WSet w1 = wset_of(F, 1); wconv_part(F, w1, F.ws + w_slot_off(1), scr, it1, 1 << 30); }
        { const WSet w2 = wset_of(F, 2); wconv_part(F, w2, F.ws + w_slot_off(2), scr, it2, 1 << 30); }
        __syncthreads();
    }
}

__device__ __forceinline__ Fr fr_fresh(const Fr& F0) {
    Fr G = F0; int t = threadIdx.x; asm volatile("" : "+v"(t));
    G.tid = t; G.lane = t & 63; G.wave = __builtin_amdgcn_readfirstlane(t >> 6); G.gw = G.blk * NWAVES + G.wave;
    unsigned long long kv = (unsigned long long)__builtin_amdgcn_kernarg_segment_ptr(); asm volatile("" : "+s"(kv));
    G.ka = (const __attribute__((address_space(4))) unsigned long long*)kv; G.ws = (unsigned char*)(GAS unsigned char*)G.ka[35];
    return G;
}
__global__ void __launch_bounds__(NTHREADS, 2) dit_fwd(Args args) {
    extern __shared__ __attribute__((aligned(16))) unsigned char lds_raw[];
    Fr F0;
    F0.lds = (LAS unsigned char*)lds_raw; F0.ldsg = lds_raw;
    F0.tid = threadIdx.x; F0.lane = F0.tid & 63; F0.wave = __builtin_amdgcn_readfirstlane(F0.tid >> 6);
    F0.blk = blockIdx.x; F0.nblk = gridDim.x; F0.gw = F0.blk * NWAVES + F0.wave; F0.ngw = F0.nblk * NWAVES;
    F0.ka = nullptr; F0.ws = args.ws;
    const int lo = args.ph_lo, hi = args.ph_hi;
    if (F0.tid < 4) ((LAS unsigned*)(F0.lds + LDS_BARW))[F0.tid] = 0u;
    __syncthreads();
    XcdBarrier bar; bar.bar = (unsigned*)(args.ws + WS_CTL) + CW_BAR; bar.x = 0; bar.st = (volatile LAS unsigned*)(F0.lds + LDS_BARW);
    if (hi - lo > 1) bar = xcd_barrier_post((unsigned*)(args.ws + WS_CTL) + CW_BAR, (volatile LAS unsigned*)(F0.lds + LDS_BARW));
    int ph = 0;
#if PROBE_AMP
    unsigned long long pr_acc = 0, pr_t0 = __builtin_amdgcn_s_memrealtime();
#define PH_IF if ((pr_t0 = __builtin_amdgcn_s_memrealtime(), true) && ph >= lo && ph < hi) if (Fr F = fr_fresh(F0); true)
#if PROBE_CYCLES
#undef PH_IF
#define PH_IF if ((pr_t0 = (unsigned long long)clock64(), true) && ph >= lo && ph < hi) if (Fr F = fr_fresh(F0); true)
#define PH_END do { if (ph >= lo && ph + 1 < hi) xcd_barrier(bar); if ((PROBE_MASK >> ph) & 1ull) pr_acc += ((unsigned long long)clock64() - pr_t0) / 24ull; ++ph; } while (0)
#else
#define PH_END do { if (ph >= lo && ph + 1 < hi) xcd_barrier(bar); if ((PROBE_MASK >> ph) & 1ull) pr_acc += __builtin_amdgcn_s_memrealtime() - pr_t0; ++ph; } while (0)
#endif
#else
#define PH_IF if (ph >= lo && ph < hi) if (Fr F = fr_fresh(F0); true)
#define PH_END do { if (ph >= lo && ph + 1 < hi) xcd_barrier(bar); ++ph; } while (0)
#endif
#define IN(i) ((const float*)(GAS const float*)F.ka[i])
#define MOD ((float*)(F.ws + WS_MOD))
#define HDN ((float*)(F.ws + WS_HDN))
#define KFC ((float*)(F.ws + WS_KFC))
#define VTC ((bf16_t*)(F.ws + WS_VTC))
#define XRES ((bf16_t*)(F.ws + WS_XRES))
#define XRES_CTX (XRES + (size_t)M_LAT * D)
#define ABUF ((bf16_t*)(F.ws + WS_A))
#define ZBUF ((bf16_t*)(F.ws + WS_Z))
#define WSLOT(l) (F.ws + w_slot_off(l))
#define WGU ((bf16_t*)(WSLOT(layer) + WO_GU))
#define WD ((bf16_t*)(WSLOT(layer) + WO_D))
#define WIN ((bf16_t*)(WSLOT(layer) + WO_IN))
#define WOUT ((bf16_t*)(WSLOT(layer) + WO_OUT))
#define VT ((bf16_t*)(F.ws + WS_VT))
#define KF ((bf16_t*)(F.ws + WS_KF))
#define KALL ((bf16_t*)(F.ws + WS_KALL))
#define VALL ((bf16_t*)(F.ws + WS_VALL))
#define SLAB ((float*)(F.ws + WS_SLAB))
#define MODL (MOD + (size_t)layer * 3 * NMOD)
#define SRC_LAT (layer == 0 ? IN(I_X) : (const float*)nullptr)
#define SRC_CTX (layer == 0 ? IN(I_CTX) : (const float*)nullptr)
#define HY_SW (IN(I_HSW) + (size_t)j * 3 * 3 * D)
#define HY_SB (IN(I_HSB) + (size_t)j * 3 * D)

    PH_IF {
#if EN_PRO
        adaln_phase(F, IN(I_C), IN(I_CCTX), IN(I_WMOD), IN(I_BMOD), MOD);
        hdn_phase(F, IN(I_HFW1), IN(I_HFB1), IN(I_HFW2), IN(I_HFB2), IN(I_HFW3), IN(I_HFB3), IN(I_HFREQ), HDN);
#endif
    }
    PH_END;

#pragma unroll 1
    for (int layer = 0; layer < 4; ++layer) {
        const int kind = layer % 3, j = layer / 3;
        const int rows_n1 = layer <= 2 ? M_ALL : M_LAT;
        const int rows_full = layer <= 1 ? M_ALL : M_LAT;
        const int nin = kind == 2 ? 3072 : 3 * D;
        PH_IF {
#if EN_NORM
            CtxPend cp{nullptr, 0, nullptr, nullptr, nullptr};
            if (layer == 1 || layer == 2) cp = CtxPend{SLAB, 11, MOD + (size_t)(layer - 1) * 3 * NMOD + 2 * NMOD + 5 * D, nullptr, nullptr};
            norm_rows(F, SRC_LAT, SRC_CTX, XRES, layer == 0, rows_n1, IN(I_N1G) + layer * D, MODL, 0, D, ABUF, cp);
            if (layer == 0) { const WSet w = wset_of(F, 0); wconv_layer(F, w, WSLOT(0)); }
#endif
#if EN_FILT
            if (kind == 0) {
                hy_filt_long(F, HDN + (size_t)j * (SEQ + CTXL) * 64, IN(I_HFW4) + (size_t)j * 64 * 2 * D, KF, F.blk, F.nblk);
                if (layer == 0) hy_filt_tiles(F, HDN + ((size_t)j * (SEQ + CTXL) + SEQ) * 64, IN(I_HFW4) + (size_t)j * 64 * 2 * D, KFC, CTXL, F.blk, F.nblk);
                __syncthreads();
            }
#endif
        }
        PH_END;
        PH_IF {
#if EN_G1
            pg8::Gemm g{ABUF, WIN, rows_n1, nin, D, D}; pg8::StaticOrder S; S.init(rows_n1, nin, F.nblk, F.blk);
            pg8::EpiStoreBf16 E{ZBUF, nin, nullptr};
            pg8::gemm_phase<pg8::EpiStoreBf16, pg8::StaticOrder>(F.lds, g, S, E, nullptr);
#endif
        }
        PH_END;
        if (kind == 0) {
            PH_IF {
#if EN_HYE
                hy_elem_phase(F, ZBUF, HY_SW, HY_SB, IN(I_HBIN) + (size_t)j * 3 * D, VT, VTC, rows_full);
#endif
            }
            PH_END;
            PH_IF {
#if EN_FFT
                hy_fft_phase(F, KF, IN(I_HSKIP) + j * D, VT, (float*)(F.ws + WS_KSP), layer == 0);
#endif
#if EN_HYE
                if (rows_full > M_LAT) hy_ctx_conv(F, KFC, IN(I_HSKIP) + j * D, VTC);
#endif
            }
            PH_END;
            PH_IF {
#if EN_HYE
                hy_post_phase(F, ZBUF, HY_SW, HY_SB, IN(I_HBIN) + (size_t)j * 3 * D, VT, VTC, ABUF, rows_full);
#endif
            }
            PH_END;
        } else if (kind == 1) {
            PH_IF {
#if EN_HYE
                sc_elem_phase(F, ZBUF, IN(I_SCW), ABUF, rows_full);
#endif
            }
            PH_END;
        } else {
            PH_IF {
#if EN_HYE
                qk_prep_phase(F, ZBUF, IN(I_AQG), IN(I_AKG), VT  , KALL, VALL);
#endif
            }
            PH_END;
            PH_IF {
#if EN_ATT
                const float gqm = wave_max(fmaxf(fabsf(IN(I_AQG)[F.lane]), fabsf(IN(I_AQG)[F.lane + 64]))), gkm = wave_max(fmaxf(fabsf(IN(I_AKG)[F.lane]), fabsf(IN(I_AKG)[F.lane + 64])));
                const bool nomax = 16.33f * gqm * gkm < ATT_NOMAX_BOUND;
                int it3 = F.gw;
                for (int unit = F.blk; unit < NB * NH * (SEQ / 256); unit += F.nblk) {
                    const int bk = unit >> 8, b = bk >> 2, kvh = bk & 3, g = (unit >> 6) & 3, qb = unit & 63, h = kvh * 4 + g;
                    const size_t qo = ((size_t)(b * SEQ + qb * 256)) * D + h * HD, ko = ((size_t)b * NKV + kvh) * LK * HD;
                    if (nomax) att::attn_dense_body<att::bf16, true>(VT + qo, KALL + ko, VALL + ko, ABUF + qo, LK, (char*)F.ldsg);
                    else att::attn_dense_body<att::bf16, false>(VT + qo, KALL + ko, VALL + ko, ABUF + qo, LK, (char*)F.ldsg);
                    __syncthreads();
                    {   const Fr Fs = fr_fresh(F0);
                        LAS float* scr2 = (LAS float*)(Fs.lds + 67584 + Fs.wave * 8448);
                        { const WSet w3 = wset_of(Fs, 3); wconv_part(Fs, w3, Fs.ws + w_slot_off(3), scr2, it3, 2); }
                    }
                }
                { const Fr Fe = fr_fresh(F0); LAS float* scr3 = (LAS float*)(Fe.lds + 67584 + Fe.wave * 8448);
                  const WSet w3 = wset_of(Fe, 3); wconv_part(Fe, w3, Fe.ws + w_slot_off(3), scr3, it3, 1 << 30); }
#endif
            }
            PH_END;
        }
        PH_IF {
#if EN_G2
            pg8::Gemm g{ABUF, WOUT, M_LAT, D, D, D}; pg8::StaticOrder S; S.init(M_LAT, D, F.nblk, F.blk);
            const float* bias = kind == 0 ? IN(I_HBOUT) + j * D : nullptr;
            pg8::EpiResid E{SRC_LAT, SRC_CTX, XRES, bias, MODL + 2 * D};
#if STAG_RS
            { const int grp = (F.blk >> 3) & (STAG_N - 1); if (grp) { const unsigned long long t1 = __builtin_amdgcn_s_memrealtime(); while (__builtin_amdgcn_s_memrealtime() - t1 < (unsigned long long)(grp * STAG_RS)) __builtin_amdgcn_s_sleep(2); } }
#endif
            pg8::gemm_phase<pg8::EpiResid, pg8::StaticOrder>(F.lds, g, S, E, nullptr);
            if (rows_full > M_LAT) {
                pg8::Gemm gc{ABUF, WOUT, M_ALL, D, 256, D}; pg8::CtxSplitOrder Sc; Sc.init(D, 8, F.nblk, F.blk);
                pg8::EpiSlab Ec{SLAB};
                pg8::gemm_phase<pg8::EpiSlab, pg8::CtxSplitOrder>(F.lds, gc, Sc, Ec, nullptr);
            }
#endif
        }
        PH_END;
        PH_IF {
#if EN_NORM
            CtxPend cp{nullptr, 0, nullptr, nullptr, nullptr};
            if (rows_full > M_LAT) cp = CtxPend{SLAB, 8, MODL + 2 * NMOD + 2 * D, kind == 0 ? IN(I_HBOUT) + j * D : nullptr, layer == 0 ? IN(I_CTX) : nullptr};
            norm_rows(F, nullptr, nullptr, XRES, false, rows_full, IN(I_N2G) + layer * D, MODL, 3 * D, 4 * D, ABUF, cp);
#endif
        }
        PH_END;
        PH_IF {
#if EN_G3
            pg8::Gemm g{ABUF, WGU, rows_full, 2 * DFF, D, D}; pg8::StaticOrder S; S.init(rows_full, 2 * DFF, F.nblk, F.blk);
            pg8::EpiSwiGLU E{ZBUF, DFF};
#if STAG_GU
            { const int grp = (F.blk >> 3) & (STAG_N - 1); if (grp) { const unsigned long long t1 = __builtin_amdgcn_s_memrealtime(); while (__builtin_amdgcn_s_memrealtime() - t1 < (unsigned long long)(grp * STAG_GU)) __builtin_amdgcn_s_sleep(2); } }
#endif
            pg8::gemm_phase<pg8::EpiSwiGLU, pg8::StaticOrder>(F.lds, g, S, E, nullptr);
#endif
        }
        PH_END;
        PH_IF {
#if EN_G4
            pg8::Gemm g{ZBUF, WD, M_LAT, D, DFF, DFF}; pg8::StaticOrder S; S.init(M_LAT, D, F.nblk, F.blk);
            pg8::EpiResid E{nullptr, nullptr, XRES, nullptr, MODL + 5 * D};
#if STAG_RS
            { const int grp = (F.blk >> 3) & (STAG_N - 1); if (grp) { const unsigned long long t1 = __builtin_amdgcn_s_memrealtime(); while (__builtin_amdgcn_s_memrealtime() - t1 < (unsigned long long)(grp * STAG_RS)) __builtin_amdgcn_s_sleep(2); } }
#endif
            pg8::gemm_phase<pg8::EpiResid, pg8::StaticOrder>(F.lds, g, S, E, nullptr);
            if (rows_full > M_LAT) {
                pg8::Gemm gc{ZBUF, WD, M_ALL, D, 512, DFF}; pg8::CtxSplitOrder Sc; Sc.init(D, 11, F.nblk, F.blk);
                pg8::EpiSlab Ec{SLAB};
                pg8::gemm_phase<pg8::EpiSlab, pg8::CtxSplitOrder>(F.lds, gc, Sc, Ec, nullptr);
            }
#endif
        }
        PH_END;
    }
    PH_IF {
#if EN_NORM
        final_norm(F, XRES, IN(I_FING), (float*)IN(34));
#endif
    }
    PH_END;
#if PROBE_AMP
    { const unsigned long long t1 = __builtin_amdgcn_s_memrealtime(); while (__builtin_amdgcn_s_memrealtime() - t1 < (unsigned long long)PROBE_AMP * pr_acc) __builtin_amdgcn_s_sleep(8); }
#endif
#undef PH_IF
#undef PH_END
}

extern "C" void kernel_launch(void* const* d_in, const int* in_sizes, int n_in, void* d_out, int out_size, void* d_ws, size_t ws_size, hipStream_t stream) {
    static int grid = 0;
    if (grid == 0) {
        if (n_in != 34 || in_sizes[0] != M_LAT * D || out_size != M_LAT * D || ws_size < WS_END) {
            fprintf(stderr, "kernel_launch: shape mismatch: n_in %d in0 %d out %d ws %zu (need >= %zu); nothing launched\n", n_in, n_in > 0 ? in_sizes[0] : -1, out_size, ws_size, (size_t)WS_END); grid = -1; return; }
        int dev = 0, cus = 0, per_cu = 0;
        if (hipGetDevice(&dev) != hipSuccess || hipDeviceGetAttribute(&cus, hipDeviceAttributeMultiprocessorCount, dev) != hipSuccess) { fprintf(stderr, "kernel_launch: device query failed\n"); grid = -1; return; }
        if (hipFuncSetAttribute((const void*)dit_fwd, hipFuncAttributeMaxDynamicSharedMemorySize, LDS_BYTES) != hipSuccess) { fprintf(stderr, "kernel_launch: hipFuncSetAttribute failed\n"); grid = -1; return; }
        if (hipOccupancyMaxActiveBlocksPerMultiprocessor(&per_cu, (const void*)dit_fwd, NTHREADS, LDS_BYTES) != hipSuccess || per_cu < 1) {
            fprintf(stderr, "kernel_launch: occupancy query reports %d workgroups per CU; nothing launched\n", per_cu); (void)hipGetLastError(); grid = -1; return; }
        grid = cus;
    }
    if (grid < 0) return;
    if (hipMemsetAsync((char*)d_ws + WS_CTL, 0, CTL_ZERO_BYTES, stream) != hipSuccess) { fprintf(stderr, "kernel_launch: memset failed\n"); return; }
    Args a{};
    for (int i = 0; i < 34; ++i) a.in[i] = (const float*)d_in[i];
    a.out = (float*)d_out; a.ws = (unsigned char*)d_ws;
#if MK_PER_PHASE_LAUNCH
    for (int p = 0; p < N_PHASES; ++p) { a.ph_lo = p; a.ph_hi = p + 1; hipLaunchKernelGGL(dit_fwd, dim3(grid), dim3(NTHREADS), LDS_BYTES, stream, a); }
#else
    a.ph_lo = 0; a.ph_hi = N_PHASES;
    hipLaunchKernelGGL(dit_fwd, dim3(grid), dim3(NTHREADS), LDS_BYTES, stream, a);
#endif
    const hipError_t le = hipPeekAtLastError();
    if (le != hipSuccess) fprintf(stderr, "kernel_launch: launch failed: %s\n", hipGetErrorName(le));
}
```
